# Optimizing an MI355X kernel written in HIP

```python
import jax, jax.numpy as jnp
from jax import lax
import numpy as np

D_MODEL = 2048
BATCH = 2
SEQ = 8192
DEPTH = 4
DEC_BATCH = 16
DEC_SEQ = 2048
PAST_LEN = 128

N_TOKEN_MIXERS = 2
ATTN_WINDOWS = ((128, 1), (512, 4), (2048, 16))
N_ATTN_GROUPS = 3
HEADS_PER_GROUP = 6
HEAD_DIM = 128
N_ATTN_HEADS = N_ATTN_GROUPS * HEADS_PER_GROUP
ATTN_WIDTH = N_ATTN_HEADS * HEAD_DIM
QKV_WIDTH = 3 * ATTN_WIDTH
N_FOURIER_GROUPS = 8
FOURIER_GROUP_DIM = D_MODEL // N_FOURIER_GROUPS
D_FF = 4 * D_MODEL
N_ATTN_LAYERS = (DEPTH + 1) // 2
N_FOURIER_LAYERS = DEPTH // 2
N_MOD = 6
RMS_EPS = 1e-6
MASK_VALUE = -1e30

kernel_name = "dilated_attn_fnet_adaln_hybrid_encoder"


def rmsnorm(x, gain):
    xf = x.astype(jnp.float32)
    xf = xf * lax.rsqrt(jnp.mean(xf * xf, axis=-1, keepdims=True) + RMS_EPS)
    return xf.astype(x.dtype) * gain


def ada_norm(x, gain, shift, scale):
    return rmsnorm(x, gain) * (1 + scale[:, None, :]) + shift[:, None, :]


def alibi_slopes():
    h = jnp.arange(1, N_ATTN_HEADS + 1, dtype=jnp.float32)
    return jnp.exp2(-8.0 * h / N_ATTN_HEADS)


def dilated_window_attention(q, k, v, dilation, half, slopes):
    B, S, H, E = q.shape
    blk = dilation * half
    s_pad = -(-S // blk) * blk
    pad = s_pad - S
    n_u = s_pad // dilation
    nb = n_u // half

    def to_sub(t):
        t = jnp.pad(t, ((0, 0), (0, pad), (0, 0), (0, 0)))
        t = t.reshape(B, n_u, dilation, H, E).transpose(0, 2, 1, 3, 4)
        return t.reshape(B, dilation, nb, half, H, E)

    def neighbours(t):
        z = jnp.zeros_like(t[:, :, :1])
        prev = jnp.concatenate([z, t[:, :, :-1]], axis=2)
        nxt = jnp.concatenate([t[:, :, 1:], z], axis=2)
        return jnp.concatenate([prev, t, nxt], axis=3)

    qb = to_sub(q)
    kn = neighbours(to_sub(k))
    vn = neighbours(to_sub(v))

    scores = jnp.einsum('brnqhe,brnkhe->brnhqk', qb, kn,
                        preferred_element_type=jnp.float32) * (E ** -0.5)
    qi = jnp.arange(half)
    kj = jnp.arange(3 * half) - half
    du = kj[None, :] - qi[:, None]
    u_key = jnp.arange(nb)[:, None] * half + kj[None, :]
    pos_key = u_key[None] * dilation + jnp.arange(dilation)[:, None, None]
    key_ok = (u_key[None] >= 0) & (pos_key < S)
    valid = key_ok[:, :, None, :] & (jnp.abs(du) <= half)[None, None]
    dist = (jnp.abs(du) * dilation).astype(jnp.float32)
    scores = scores - slopes[:, None, None] * dist[None]
    scores = jnp.where(valid[None, :, :, None], scores, MASK_VALUE)
    lse = jax.nn.logsumexp(scores, axis=-1)
    p = jnp.exp(scores - lse[..., None])
    out = jnp.einsum('brnhqk,brnkhe->brnqhe', p.astype(vn.dtype), vn)
    out = out.reshape(B, dilation, n_u, H, E).transpose(0, 2, 1, 3, 4).reshape(B, s_pad, H, E)[:, :S]
    lse = lse.transpose(0, 1, 2, 4, 3).reshape(B, dilation, n_u, H)
    lse = lse.transpose(0, 2, 1, 3).reshape(B, s_pad, H)[:, :S]
    return out, lse


def dilated_attention_mixer(h, w_qkv, w_o):
    B, S, _ = h.shape
    qkv = (h @ w_qkv).reshape(B, S, N_ATTN_GROUPS, 3, HEADS_PER_GROUP, HEAD_DIM)
    slopes = alibi_slopes()
    outs, lses = [], []
    for g, (window, dilation) in enumerate(ATTN_WINDOWS):
        half = window // (2 * dilation)
        o, l = dilated_window_attention(qkv[:, :, g, 0], qkv[:, :, g, 1], qkv[:, :, g, 2], dilation, half,
                                        slopes[g * HEADS_PER_GROUP:(g + 1) * HEADS_PER_GROUP])
        outs.append(o)
        lses.append(l)
    alpha = jax.nn.softmax(jnp.stack(lses, axis=0), axis=0)
    mixed = jnp.concatenate([(alpha[g][..., None] * outs[g]).astype(h.dtype)
                             for g in range(N_ATTN_GROUPS)], axis=2)
    return mixed.reshape(B, S, ATTN_WIDTH) @ w_o


def fourier_mixer(h, w_f, b_f):
    B, S, D = h.shape
    hg = h.astype(jnp.float32).reshape(B, S, N_FOURIER_GROUPS, FOURIER_GROUP_DIM)
    mixed = jnp.fft.fft2(hg, axes=(1, 3), norm="ortho").real
    return mixed.reshape(B, S, D).astype(h.dtype) @ w_f + b_f


def sqrelu_mlp(h, w1, b1, w2, b2):
    u = jax.nn.relu(h @ w1 + b1)
    return jnp.square(u) @ w2 + b2


def trunk(x, c, w_ada, b_ada, norm1_g, norm2_g, w_qkv, w_o, w_f, b_f, w1, b1, w2, b2, final_g):
    c_act = jax.nn.silu(c)
    for i in range(DEPTH):
        mod = c_act @ w_ada[i] + b_ada[i]
        sh1, sc1, g1, sh2, sc2, g2 = jnp.split(mod, N_MOD, axis=-1)
        h = ada_norm(x, norm1_g[i], sh1, sc1)
        if i % N_TOKEN_MIXERS == 0:
            y = dilated_attention_mixer(h, w_qkv[i // N_TOKEN_MIXERS], w_o[i // N_TOKEN_MIXERS])
        else:
            y = fourier_mixer(h, w_f[i // N_TOKEN_MIXERS], b_f[i // N_TOKEN_MIXERS])
        x = x + g1[:, None, :] * y
        h = ada_norm(x, norm2_g[i], sh2, sc2)
        x = x + g2[:, None, :] * sqrelu_mlp(h, w1[i], b1[i], w2[i], b2[i])
    return rmsnorm(x, final_g)


def setup_inputs(seed: int = 0) -> dict:
    key = jax.random.key(seed)
    ks = jax.random.split(key, 20)
    f32 = jnp.float32
    n = lambda k, shape, s: jax.random.normal(k, shape, f32) * s
    D = D_MODEL
    return {
        "x_prompt": n(ks[0], (BATCH, SEQ, D), 1.0),
        "x_sample": n(ks[1], (DEC_BATCH, DEC_SEQ, D), 1.0),
        "c_prompt": n(ks[2], (BATCH, D), 1.0),
        "c_sample": n(ks[3], (DEC_BATCH, D), 1.0),
        "w_ada": n(ks[4], (DEPTH, D, N_MOD * D), D ** -0.5),
        "b_ada": n(ks[5], (DEPTH, N_MOD * D), 0.02),
        "norm1_g": 1.0 + n(ks[6], (DEPTH, D), 0.02),
        "norm2_g": 1.0 + n(ks[7], (DEPTH, D), 0.02),
        "w_qkv": n(ks[8], (N_ATTN_LAYERS, D, QKV_WIDTH), D ** -0.5),
        "w_o": n(ks[9], (N_ATTN_LAYERS, ATTN_WIDTH, D), ATTN_WIDTH ** -0.5),
        "w_f": n(ks[10], (N_FOURIER_LAYERS, D, D), D ** -0.5),
        "b_f": n(ks[11], (N_FOURIER_LAYERS, D), 0.02),
        "w1": n(ks[12], (DEPTH, D, D_FF), D ** -0.5),
        "b1": n(ks[13], (DEPTH, D_FF), 0.02),
        "w2": n(ks[14], (DEPTH, D_FF, D), D_FF ** -0.5),
        "b2": n(ks[15], (DEPTH, D), 0.02),
        "final_g": 1.0 + n(ks[16], (D,), 0.02),
    }


def reference(x_prompt, x_sample, c_prompt, c_sample, w_ada, b_ada, norm1_g, norm2_g, w_qkv, w_o,
              w_f, b_f, w1, b1, w2, b2, final_g):
    y_prompt = trunk(x_prompt, c_prompt, w_ada, b_ada, norm1_g, norm2_g, w_qkv, w_o, w_f, b_f,
                     w1, b1, w2, b2, final_g)
    y_sample = trunk(x_sample, c_sample, w_ada, b_ada, norm1_g, norm2_g, w_qkv, w_o, w_f, b_f,
                     w1, b1, w2, b2, final_g)
    return (y_prompt, y_sample)
```

```cpp
#include <hip/hip_runtime.h>
#include <cstdio>
#include <cstdint>

namespace pg8 {
#define PG8_LAS __attribute__((address_space(3)))
typedef unsigned short bf16_t;
typedef short bf16x8 __attribute__((ext_vector_type(8)));
typedef float f32x4 __attribute__((ext_vector_type(4)));
typedef float f32x2 __attribute__((ext_vector_type(2)));
typedef unsigned u32x4 __attribute__((ext_vector_type(4)));
constexpr int BM = 256, BK = 64, HALF = 128, HTB = HALF * BK * 2  , STAGE_BYTES = 8 * HTB, NXCD = 8, WGM = 8;

__host__ __device__ __forceinline__ int lds_byte(int r, int c) { const int st = (r >> 4) * 2 + (c >> 5), rr = r & 15, cc = c & 31, ob = rr * 64 + cc * 2; return st * 1024 + (ob ^ (((ob >> 9) & 1) << 5)); }
__host__ __device__ __forceinline__ void stage_rc(int b, int& R, int& C) { const int st = b / 1024, sb = b % 1024, swz = sb ^ (((sb >> 9) & 1) << 5); R = (st >> 1) * 16 + swz / 64; C = (st & 1) * 32 + (swz % 64) / 2; }
__host__ __device__ __forceinline__ int perm32(int rho) { const int n = rho >> 4, i = rho & 15; return 8 * (i >> 2) + 4 * n + (i & 3); }

struct Unit { int pm, pn; };

struct GemmDesc {
    const char* A; const char* B;
    int lda, ldb, K;
    int nMb, zdiv, pdiv;
    long long sA1, sA2, sB1, sB2;
    long long pB1, pB2;
    __device__ __forceinline__ const char* aptr(const Unit& u) const { const int z = u.pm / nMb, pml = u.pm - z * nMb, z1 = z / zdiv, z2 = z - z1 * zdiv; return A + (long long)pml * (512ll * lda) + z1 * sA1 + z2 * sA2; }
    __device__ __forceinline__ const char* bptr(const Unit& u) const { const int z = u.pm / nMb, z1 = z / zdiv, z2 = z - z1 * zdiv, p1 = u.pn / pdiv, p2 = u.pn - p1 * pdiv; return B + p1 * pB1 + p2 * pB2 + z1 * sB1 + z2 * sB2; }
};
__device__ __forceinline__ GemmDesc plain_gemm(const void* A, const void* B, int lda, int ldb, int K, int nM) { return GemmDesc{(const char*)A, (const char*)B, lda, ldb, K, nM, 1, 1, 0, 0, 0, 0, 512ll * ldb, 0}; }

struct StaticOrder {
    int nM, nN, nwg, G, c;
    __host__ __device__ void init(int nM_, int nN_, int G_, int c_) { nM = nM_; nN = nN_; nwg = nM * nN; G = G_; c = c_; }
    __host__ __device__ bool next(int i, Unit& u) const {
        const long L = (long)i * G + c; if (L >= nwg) return false;
        int wgid = (int)L; { const int q = nwg / NXCD, r = nwg % NXCD, xcd = wgid % NXCD, off = wgid / NXCD; wgid = (xcd < r ? xcd * (q + 1) : r * (q + 1) + (xcd - r) * q) + off; }
        const int nig = WGM * nN, gid = wgid / nig, fm = gid * WGM, gsz = (nM - fm) < WGM ? (nM - fm) : WGM;
        u.pm = fm + ((wgid % nig) % gsz); u.pn = (wgid % nig) / gsz; return true;
    }
    __device__ __forceinline__ void a_ready(const Unit&) const {}
    __device__ __forceinline__ void done(const Unit&) const {}
#ifndef PG8_KROT
#define PG8_KROT 1
#endif
    __device__ __forceinline__ int krot(int nt) const { return PG8_KROT ? 2 * (((c & 7) * (nt >> 1)) >> 3) : 0; }
};

__device__ __forceinline__ unsigned cvt_pk_bf16(float lo, float hi) { unsigned r; asm volatile("v_cvt_pk_bf16_f32 %0, %1, %2" : "=v"(r) : "v"(lo), "v"(hi)); return r; }

template <class Epi, class Sched, bool ALIGN_EPI = false, bool SP2 = false>
__device__ __forceinline__ void gemm_phase(PG8_LAS unsigned char* lds, const GemmDesc g, const Sched& S, const Epi& E) {
    int tid_ = threadIdx.x; asm volatile("" : "+v"(tid_));
    const int tid = tid_, wid = __builtin_amdgcn_readfirstlane(tid >> 6), lane = tid & 63, wr = wid >> 2, wc = wid & 3, fr = lane & 15, fq = lane >> 4;
    const int K = g.K, nt = K / BK;
    unsigned voffA[2], voffB[2];
#pragma unroll
    for (int i = 0; i < 2; ++i) { int R, C; stage_rc(tid * 16 + i * 8192, R, C); const int Rb = Epi::PERM ? ((R & ~31) + perm32(R & 31)) : R;
        voffA[i] = (unsigned)(R * g.lda + C) * 2u; voffB[i] = (unsigned)(Rb * g.ldb + C) * 2u; }
    const size_t kstep = (size_t)(BK * 2);
    const size_t hA = (size_t)HALF * g.lda * 2, hB = (size_t)HALF * g.ldb * 2;
    const unsigned ldsw = (unsigned)wid * 1024u;
    const int aoff = lds_byte(wr * 64 + fr, fq * 8), boff = lds_byte(wc * 32 + fr, fq * 8);
#define PG8_SA(b, h) (((b) * 2 + (h)) * HTB)
#define PG8_SB(b, h) ((4 + (b) * 2 + (h)) * HTB)
#define PG8_STAGE(bufoff, gbase, voff) do { _Pragma("unroll") for (int _i = 0; _i < 2; ++_i) \
        __builtin_amdgcn_global_load_lds((const unsigned*)((const char*)(gbase) + (voff)[_i]), (PG8_LAS unsigned*)(lds + (bufoff) + ldsw + _i * 8192), 16, 0, 0); } while (0)
#define PG8_LDA(dst, b, h) do { _Pragma("unroll") for (int m = 0; m < 4; ++m) _Pragma("unroll") for (int k = 0; k < 2; ++k) dst[m][k] = *(const PG8_LAS bf16x8*)(lds + PG8_SA(b, h) + aoff + m * 2048 + k * 1024); } while (0)
#define PG8_LDB(dst, b, h) do { _Pragma("unroll") for (int n = 0; n < 2; ++n) _Pragma("unroll") for (int k = 0; k < 2; ++k) dst[n][k] = *(const PG8_LAS bf16x8*)(lds + PG8_SB(b, h) + boff + n * 2048 + k * 1024); } while (0)
#define PG8_MMA(ai, bj, At, Bt) do { __builtin_amdgcn_s_setprio(1); _Pragma("unroll") for (int m = 0; m < 4; ++m) _Pragma("unroll") for (int n = 0; n < 2; ++n) _Pragma("unroll") for (int k = 0; k < 2; ++k) \
        acc[ai][bj][m][n] = __builtin_amdgcn_mfma_f32_16x16x32_bf16(Bt[n][k], At[m][k], acc[ai][bj][m][n], 0, 0, 0); __builtin_amdgcn_s_setprio(0); } while (0)
#define PG8_WAIT_V(n) asm volatile("s_waitcnt vmcnt(" #n ")" ::: "memory")
#define PG8_WAIT_L(n) asm volatile("s_waitcnt lgkmcnt(" #n ")" ::: "memory")
#define PG8_BAR __builtin_amdgcn_s_barrier()
#define PG8_SCHED __builtin_amdgcn_sched_barrier(0)
    Unit cur, nxt; int ui = 0;
    if (!S.next(0, cur)) return;
    f32x4 acc[2][2][4][2];
#pragma unroll
    for (int a = 0; a < 2; ++a)
#pragma unroll
        for (int b = 0; b < 2; ++b)
#pragma unroll
            for (int m = 0; m < 4; ++m)
#pragma unroll
                for (int n = 0; n < 2; ++n) acc[a][b][m][n] = (f32x4){0.f, 0.f, 0.f, 0.f};
    bf16x8 At[4][2], B0[2][2], B1[2][2];
    const char* cA = g.aptr(cur); const char* cB = g.bptr(cur);
    const int r0 = S.krot(nt); const size_t roff = (size_t)r0 * kstep;
    S.a_ready(cur);
    if constexpr (SP2) {
        PG8_STAGE(PG8_SB(0, 0), cB + roff, voffB); PG8_STAGE(PG8_SB(0, 1), cB + roff + hB, voffB); PG8_STAGE(PG8_SA(0, 0), cA + roff, voffA); PG8_STAGE(PG8_SA(0, 1), cA + roff + hA, voffA);
        if (wr == 1) PG8_BAR;
        PG8_WAIT_V(2); PG8_BAR;
        PG8_STAGE(PG8_SB(1, 0), cB + roff + kstep, voffB); PG8_STAGE(PG8_SA(1, 0), cA + roff + kstep, voffA); PG8_STAGE(PG8_SB(1, 1), cB + roff + hB + kstep, voffB);
        PG8_WAIT_V(6); PG8_BAR;
    } else {
        PG8_STAGE(PG8_SB(0, 0), cB + roff, voffB); PG8_STAGE(PG8_SA(0, 0), cA + roff, voffA); PG8_STAGE(PG8_SB(0, 1), cB + roff + hB, voffB); PG8_STAGE(PG8_SA(0, 1), cA + roff + hA, voffA);
        if (wr == 1) PG8_BAR;
        PG8_WAIT_V(4); PG8_BAR;
        PG8_STAGE(PG8_SB(1, 0), cB + roff + kstep, voffB); PG8_STAGE(PG8_SA(1, 0), cA + roff + kstep, voffA); PG8_STAGE(PG8_SB(1, 1), cB + roff + hB + kstep, voffB);
        PG8_WAIT_V(6); PG8_BAR;
    }
    for (;;) {
        const bool has_next = S.next(ui + 1, nxt);
        const char* nA = has_next ? g.aptr(nxt) : cA; const char* nB = has_next ? g.bptr(nxt) : cB;
        for (int t = 0; t < nt; t += 2) {
            const bool last = (t == nt - 2);
            int tt = t + r0; if (tt >= nt) tt -= nt; int tt2 = tt + 2; if (tt2 >= nt) tt2 -= nt;
            const char* a1 = cA + (size_t)(tt + 1) * kstep;
            const char* a2 = last ? nA + roff : cA + (size_t)tt2 * kstep; const char* b2 = last ? nB + roff : cB + (size_t)tt2 * kstep;
            const char* a3 = a2 + kstep; const char* b3 = b2 + kstep;
            if (last && has_next) S.a_ready(nxt);
            if constexpr (SP2) {
            PG8_LDB(B0, 0, 0); PG8_LDB(B1, 0, 1); PG8_SCHED; PG8_LDA(At, 0, 0); PG8_STAGE(PG8_SA(1, 1), a1 + hA, voffA);
            PG8_WAIT_V(8); PG8_WAIT_L(0); PG8_BAR; PG8_MMA(0, 0, At, B0); PG8_MMA(0, 1, At, B1); PG8_BAR; PG8_SCHED;
            PG8_LDA(At, 0, 1); PG8_STAGE(PG8_SB(0, 0), b2, voffB); PG8_STAGE(PG8_SB(0, 1), b2 + hB, voffB); PG8_STAGE(PG8_SA(0, 0), a2, voffA);
            PG8_WAIT_V(8); PG8_WAIT_L(0); PG8_BAR; PG8_MMA(1, 0, At, B0); PG8_MMA(1, 1, At, B1); PG8_BAR; PG8_SCHED;
            PG8_LDB(B0, 1, 0); PG8_LDB(B1, 1, 1); PG8_SCHED; PG8_LDA(At, 1, 0); PG8_STAGE(PG8_SA(0, 1), a2 + hA, voffA);
            PG8_WAIT_V(8); PG8_WAIT_L(0); PG8_BAR; PG8_MMA(0, 0, At, B0); PG8_MMA(0, 1, At, B1); PG8_BAR; PG8_SCHED;
            PG8_LDA(At, 1, 1); PG8_STAGE(PG8_SB(1, 0), b3, voffB); PG8_STAGE(PG8_SB(1, 1), b3 + hB, voffB); PG8_STAGE(PG8_SA(1, 0), a3, voffA);
            PG8_WAIT_V(8); PG8_WAIT_L(0); PG8_BAR; PG8_MMA(1, 0, At, B0); PG8_MMA(1, 1, At, B1); PG8_BAR; PG8_SCHED;
            } else {
            PG8_LDB(B0, 0, 0); PG8_SCHED; PG8_LDA(At, 0, 0); PG8_STAGE(PG8_SA(1, 1), a1 + hA, voffA);
            PG8_WAIT_L(8); PG8_BAR; PG8_WAIT_L(0); PG8_MMA(0, 0, At, B0); PG8_BAR; PG8_SCHED;
            PG8_LDB(B1, 0, 1); PG8_STAGE(PG8_SB(0, 0), b2, voffB);
            PG8_BAR; PG8_WAIT_L(0); PG8_MMA(0, 1, At, B1); PG8_BAR;
            PG8_LDA(At, 0, 1); PG8_STAGE(PG8_SA(0, 0), a2, voffA);
            PG8_BAR; PG8_WAIT_L(0); PG8_MMA(1, 0, At, B0); PG8_BAR; PG8_SCHED;
            PG8_STAGE(PG8_SB(0, 1), b2 + hB, voffB);
            PG8_WAIT_V(6); PG8_BAR; PG8_MMA(1, 1, At, B1); PG8_BAR;
            PG8_LDB(B0, 1, 0); PG8_SCHED; PG8_LDA(At, 1, 0); PG8_STAGE(PG8_SA(0, 1), a2 + hA, voffA);
            PG8_WAIT_L(8); PG8_BAR; PG8_WAIT_L(0); PG8_MMA(0, 0, At, B0); PG8_BAR; PG8_SCHED;
            PG8_LDB(B1, 1, 1); PG8_STAGE(PG8_SB(1, 0), b3, voffB);
            PG8_BAR; PG8_WAIT_L(0); PG8_MMA(0, 1, At, B1); PG8_BAR;
            PG8_LDA(At, 1, 1); PG8_STAGE(PG8_SA(1, 0), a3, voffA);
            PG8_BAR; PG8_WAIT_L(0); PG8_MMA(1, 0, At, B0); PG8_BAR; PG8_SCHED;
            PG8_STAGE(PG8_SB(1, 1), b3 + hB, voffB);
            PG8_WAIT_V(6); PG8_BAR; PG8_MMA(1, 1, At, B1); PG8_BAR;
            }
        }
        if constexpr (ALIGN_EPI) { if (wr == 0) PG8_BAR; }
        if constexpr (!Epi::AFTER_DRAIN) { E(acc, cur, wr, wc, fr, fq); S.done(cur); }
        if (!has_next) break;
#pragma unroll
        for (int a = 0; a < 2; ++a)
#pragma unroll
            for (int b = 0; b < 2; ++b)
#pragma unroll
                for (int m = 0; m < 4; ++m)
#pragma unroll
                    for (int n = 0; n < 2; ++n) acc[a][b][m][n] = (f32x4){0.f, 0.f, 0.f, 0.f};
        cur = nxt; cA = nA; cB = nB; ++ui;
        if constexpr (ALIGN_EPI) { if (wr == 1) PG8_BAR; }
    }
    PG8_WAIT_V(0);
    if constexpr (!ALIGN_EPI) { if (wr == 0) PG8_BAR; }
    PG8_BAR;
    if constexpr (Epi::AFTER_DRAIN) { E.fused(acc, cur, wr, wc, fr, fq, lds, wid, lane); S.done(cur); }
#undef PG8_SA
#undef PG8_SB
#undef PG8_STAGE
#undef PG8_LDA
#undef PG8_LDB
#undef PG8_MMA
#undef PG8_WAIT_V
#undef PG8_WAIT_L
#undef PG8_BAR
#undef PG8_SCHED
}
}

constexpr int D = 2048, SEQP = 8192, SEQS = 2048, NBP = 2, NBS = 16, NB = NBP + NBS;
constexpr int MP = NBP * SEQP, MS = NBS * SEQS, M = MP + MS;
constexpr int NH = 18, HD = 128, AW = NH * HD, QKVW = 3 * AW, FF = 4 * D, DEPTH = 4, NMOD = 6;
constexpr float RMS_EPS = 1e-6f, LOG2E = 1.4426950408889634f, LN2 = 0.6931471805599453f;
constexpr int NWAVES = 8;

constexpr size_t MiB = 1u << 20;
constexpr size_t WS_CTL = 0, CTL_ZERO_BYTES = 1 * MiB;
constexpr size_t WS_MOD = 1 * MiB;
constexpr size_t WS_CACT = 5 * MiB;
constexpr size_t WS_LSE = 6 * MiB;
constexpr size_t WS_FC = 10 * MiB;
constexpr size_t WS_G = 11 * MiB;
constexpr size_t WS_W = 12 * MiB;
constexpr size_t WS_WQKV = WS_W, WS_WF = WS_W, WS_WO = WS_W + 27 * MiB, WS_W1 = WS_W + 36 * MiB, WS_W2 = WS_W + 68 * MiB;
constexpr size_t WS_HM = 112 * MiB;
constexpr size_t WS_R = 328 * MiB;
constexpr size_t WS_AO = WS_R + 384 * MiB;
constexpr size_t WS_MODP = WS_AO;
constexpr size_t WS_XB = 1096 * MiB;
constexpr size_t WS_END = 1288 * MiB;
static_assert(WS_W2 + (size_t)D * FF * 2 <= WS_HM && WS_HM + (size_t)M * AW * 2 <= WS_R && WS_R + (size_t)M * FF * 2 <= WS_XB && WS_XB + (size_t)M * D * 2 <= WS_END, "d_ws map");
static_assert((size_t)3 * NH * M * HD * 2 <= WS_XB - WS_R && (size_t)M * 2 * D * 2 <= WS_AO - WS_R && WS_AO + (size_t)M * 2 * D * 2 <= WS_XB, "d_ws map (R)");
constexpr int CW_BAR = 4096;

constexpr int RING_BYTES = 131072;
constexpr int LDSCTL_OFF = RING_BYTES, MISC_OFF = LDSCTL_OFF + 320;
constexpr int LDS_BYTES = 147456;

#define GAS __attribute__((address_space(1)))
#define LAS __attribute__((address_space(3)))
typedef unsigned short bf16;
typedef unsigned v4u __attribute__((ext_vector_type(4)));
typedef unsigned v2u __attribute__((ext_vector_type(2)));
typedef float f32x4 __attribute__((ext_vector_type(4)));
typedef float f32x2 __attribute__((ext_vector_type(2)));
typedef float f32x16 __attribute__((ext_vector_type(16)));
typedef short bf16x8 __attribute__((ext_vector_type(8)));
typedef short s16x4 __attribute__((ext_vector_type(4)));
typedef __bf16 bf16x2_t __attribute__((ext_vector_type(2)));
#define LDS_WAIT() asm volatile("s_waitcnt lgkmcnt(0)" ::: "memory")
__device__ __forceinline__ unsigned pk2(float lo, float hi) { f32x2 v = {lo, hi}; bf16x2_t b = __builtin_convertvector(v, bf16x2_t); return __builtin_bit_cast(unsigned, b); }
__device__ __forceinline__ float bf_lo(unsigned w) { return __builtin_bit_cast(float, w << 16); }
__device__ __forceinline__ float bf_hi(unsigned w) { return __builtin_bit_cast(float, w & 0xffff0000u); }
__device__ __forceinline__ float wave_sum(float v) {
#pragma unroll
    for (int o = 1; o < 64; o <<= 1) v += __shfl_xor(v, o);
    return v;
}
__device__ __forceinline__ int batch_of_tile(int pm) { return pm < 64 ? (pm >> 5) : 2 + ((pm - 64) >> 3); }

namespace pg8 {
#ifndef PG8_NT
#define PG8_NT 1
#endif
#if PG8_NT
#define PG8_ST_STREAM(p, v) __builtin_nontemporal_store((v), (p))
#else
#define PG8_ST_STREAM(p, v) (*(p) = (v))
#endif
struct EpiQKV {
    static constexpr bool PERM = true, AFTER_DRAIN = false;
    bf16_t* O; float qscale;
    __device__ __forceinline__ void operator()(const f32x4 (&acc)[2][2][4][2], const Unit& u, int wr, int wc, int fr, int fq) const {
        const int g = u.pn / 9, j = u.pn - 9 * g, which = j / 3, hp = (j - 3 * which) * 2, sh = 2 * g;
        int sstart, t0, lsh;
        if (u.pm < 64) { sstart = (u.pm >> 5) * SEQP; t0 = (u.pm & 31) * 256; lsh = 13 - sh; } else { const int q = u.pm - 64; sstart = MP + (q >> 3) * SEQS; t0 = (q & 7) * 256; lsh = 11 - sh; }
        const float sc = which == 0 ? qscale : 1.f;
#pragma unroll
        for (int ai = 0; ai < 2; ++ai)
#pragma unroll
            for (int m = 0; m < 4; ++m) { const int t = t0 + ai * HALF + wr * 64 + m * 16 + fr, prow = sstart + ((t & ((1 << sh) - 1)) << lsh) + (t >> sh);
#pragma unroll
                for (int bj = 0; bj < 2; ++bj) { const int head = g * 6 + hp + bj;
                    bf16_t* dst = O + ((size_t)(which * NH + head) * M + prow) * HD + wc * 32 + 8 * fq;
                    const f32x4 v0 = acc[ai][bj][m][0] * sc, v1 = acc[ai][bj][m][1] * sc;
                    u32x4 w; w.x = cvt_pk_bf16(v0[0], v0[1]); w.y = cvt_pk_bf16(v0[2], v0[3]); w.z = cvt_pk_bf16(v1[0], v1[1]); w.w = cvt_pk_bf16(v1[2], v1[3]);
                    PG8_ST_STREAM((u32x4*)dst, w); } }
    }
};
struct EpiRes {
    static constexpr bool PERM = true, AFTER_DRAIN = false;
    const float* xin_p; const float* xin_s; bf16_t* xb; const float* bias; const float* gate;
    __device__ __forceinline__ void operator()(const f32x4 (&acc)[2][2][4][2], const Unit& u, int wr, int wc, int fr, int fq) const {
        const int b = batch_of_tile(u.pm), col0 = u.pn * BM + wc * 32 + 8 * fq, row0 = u.pm * BM + wr * 64 + fr;
        const float* gp = gate + (size_t)b * (NMOD * D) + col0;
        f32x4 gv[2][2], bv[2][2];
#pragma unroll
        for (int bj = 0; bj < 2; ++bj)
#pragma unroll
            for (int n = 0; n < 2; ++n) { gv[bj][n] = *(const f32x4*)(gp + bj * HALF + 4 * n); bv[bj][n] = bias ? *(const f32x4*)(bias + col0 + bj * HALF + 4 * n) : (f32x4){0.f, 0.f, 0.f, 0.f}; }
#pragma unroll
        for (int ai = 0; ai < 2; ++ai)
#pragma unroll
            for (int m = 0; m < 4; ++m) { const int row = row0 + ai * HALF + m * 16; bf16_t* xo = xb + (size_t)row * D + col0;
#pragma unroll
                for (int bj = 0; bj < 2; ++bj) { f32x4 x0, x1;
                    if (xin_p) { const float* xi = (row < MP ? xin_p + (size_t)row * D : xin_s + (size_t)(row - MP) * D) + col0 + bj * HALF; x0 = *(const f32x4*)xi; x1 = *(const f32x4*)(xi + 4); }
                    else { const u32x4 w = *(const u32x4*)(xo + bj * HALF);
                        x0 = (f32x4){__builtin_bit_cast(float, w.x << 16), __builtin_bit_cast(float, w.x & 0xffff0000u), __builtin_bit_cast(float, w.y << 16), __builtin_bit_cast(float, w.y & 0xffff0000u)};
                        x1 = (f32x4){__builtin_bit_cast(float, w.z << 16), __builtin_bit_cast(float, w.z & 0xffff0000u), __builtin_bit_cast(float, w.w << 16), __builtin_bit_cast(float, w.w & 0xffff0000u)}; }
                    const f32x4 v0 = x0 + gv[bj][0] * (acc[ai][bj][m][0] + bv[bj][0]), v1 = x1 + gv[bj][1] * (acc[ai][bj][m][1] + bv[bj][1]);
                    u32x4 o; o.x = cvt_pk_bf16(v0[0], v0[1]); o.y = cvt_pk_bf16(v0[2], v0[3]); o.z = cvt_pk_bf16(v1[0], v1[1]); o.w = cvt_pk_bf16(v1[2], v1[3]);
                    *(u32x4*)(xo + bj * HALF) = o; } }
    }
};
template <int ACT> struct EpiBf16 {
    static constexpr bool PERM = true, AFTER_DRAIN = false;
    bf16_t* O; int ldc; const float* bias; int row_base;
    __device__ __forceinline__ void operator()(const f32x4 (&acc)[2][2][4][2], const Unit& u, int wr, int wc, int fr, int fq) const {
        const int row0 = row_base + u.pm * BM + wr * 64 + fr, col0 = u.pn * BM + wc * 32 + 8 * fq;
        f32x4 bv[2][2];
#pragma unroll
        for (int bj = 0; bj < 2; ++bj)
#pragma unroll
            for (int n = 0; n < 2; ++n) bv[bj][n] = bias ? *(const f32x4*)(bias + col0 + bj * HALF + 4 * n) : (f32x4){0.f, 0.f, 0.f, 0.f};
#pragma unroll
        for (int ai = 0; ai < 2; ++ai)
#pragma unroll
            for (int m = 0; m < 4; ++m) { bf16_t* rowp = O + (size_t)(row0 + ai * HALF + m * 16) * ldc + col0;
#pragma unroll
                for (int bj = 0; bj < 2; ++bj) { f32x4 v0 = acc[ai][bj][m][0] + bv[bj][0], v1 = acc[ai][bj][m][1] + bv[bj][1];
                    if (ACT == 1) {
#pragma unroll
                        for (int e = 0; e < 4; ++e) { const float a = fmaxf(v0[e], 0.f), b = fmaxf(v1[e], 0.f); v0[e] = a * a; v1[e] = b * b; } }
                    u32x4 w; w.x = cvt_pk_bf16(v0[0], v0[1]); w.y = cvt_pk_bf16(v0[2], v0[3]); w.z = cvt_pk_bf16(v1[0], v1[1]); w.w = cvt_pk_bf16(v1[2], v1[3]);
                    PG8_ST_STREAM((u32x4*)(rowp + bj * HALF), w); } }
    }
};
struct EpiZT {
    static constexpr bool PERM = true, AFTER_DRAIN = false;
    bf16_t* ZT; int seq0, S, N2;
    __device__ __forceinline__ void operator()(const f32x4 (&acc)[2][2][4][2], const Unit& u, int wr, int wc, int fr, int fq) const {
        const int part = u.pm & 1, z = u.pm >> 1, b = z >> 3, g = z & 7;
        bf16_t* base = ZT + (size_t)4096 * (seq0 + b * S) + ((size_t)(g * 256 + wr * 64 + fr) * N2 + u.pn) * 512 + part * 256 + wc * 32 + 8 * fq;
#pragma unroll
        for (int ai = 0; ai < 2; ++ai)
#pragma unroll
            for (int m = 0; m < 4; ++m) { bf16_t* rowp = base + (size_t)(ai * HALF + m * 16) * N2 * 512;
#pragma unroll
                for (int bj = 0; bj < 2; ++bj) { const f32x4 v0 = acc[ai][bj][m][0], v1 = acc[ai][bj][m][1];
                    u32x4 w; w.x = cvt_pk_bf16(v0[0], v0[1]); w.y = cvt_pk_bf16(v0[2], v0[3]); w.z = cvt_pk_bf16(v1[0], v1[1]); w.w = cvt_pk_bf16(v1[2], v1[3]);
                    PG8_ST_STREAM((u32x4*)(rowp + bj * HALF), w); } }
    }
};
struct EpiAO {
    static constexpr bool PERM = true, AFTER_DRAIN = false;
    bf16_t* AO; int seq0, S, N2;
    __device__ __forceinline__ void operator()(const f32x4 (&acc)[2][2][4][2], const Unit& u, int wr, int wc, int fr, int fq) const {
        const int part = u.pm & 1, b = u.pm >> 1, n2 = u.pn >> 3, cb = u.pn & 7;
        bf16_t* base = AO + (size_t)4096 * (seq0 + b * S) + ((size_t)(part * 256 + wr * 64 + fr) * N2 + n2) * 2048 + cb * 256 + wc * 32 + 8 * fq;
#pragma unroll
        for (int ai = 0; ai < 2; ++ai)
#pragma unroll
            for (int m = 0; m < 4; ++m) { bf16_t* rowp = base + (size_t)(ai * HALF + m * 16) * N2 * 2048;
#pragma unroll
                for (int bj = 0; bj < 2; ++bj) { const f32x4 v0 = acc[ai][bj][m][0], v1 = acc[ai][bj][m][1];
                    u32x4 w; w.x = cvt_pk_bf16(v0[0], v0[1]); w.y = cvt_pk_bf16(v0[2], v0[3]); w.z = cvt_pk_bf16(v1[0], v1[1]); w.w = cvt_pk_bf16(v1[2], v1[3]);
                    PG8_ST_STREAM((u32x4*)(rowp + bj * HALF), w); } }
    }
};
}

#ifndef PG8_SP2
#define PG8_SP2 true
#endif
#ifndef PG8_ALIGN
#define PG8_ALIGN true
#endif

#define XB_TMO      128
#define XB_XCNT(j)  (256  + 64 * (j))
#define XB_XSUB(j)  (1280 + 64 * (j))
#define XB_XGEN(j)  (2304 + 64 * (j))
#define XB_TOP      3328
#define XB_TOPGEN   3392
#define XCD_BAR_WORDS 3456
#define XB_SPIN_CAP (1u << 18)

__device__ __forceinline__ unsigned xb_ld(unsigned* p)              { return __hip_atomic_load(p, __ATOMIC_RELAXED, __HIP_MEMORY_SCOPE_AGENT); }
__device__ __forceinline__ unsigned xb_add(unsigned* p, unsigned v) { return __hip_atomic_fetch_add(p, v, __ATOMIC_RELAXED, __HIP_MEMORY_SCOPE_AGENT); }
__device__ __forceinline__ unsigned xb_xcc_id() { return (unsigned)__builtin_amdgcn_s_getreg((3 << 11) | 20) & 0xFu; }
#define XB_SPIN(cond, bar) do { unsigned _sp = 0; while (cond) { __builtin_amdgcn_s_sleep(1); \
    if ((++_sp & 255u) == 0u) { if (xb_ld(&(bar)[XB_TMO])) break; if (_sp > XB_SPIN_CAP) { atomicAdd(&(bar)[XB_TMO], 1u); break; } } } } while (0)

struct XcdBarrier {
    unsigned* bar; unsigned x;
    volatile LAS unsigned* st;
};

__device__ __forceinline__ XcdBarrier xcd_barrier_post(unsigned* bar, volatile LAS unsigned* st) {
    XcdBarrier b; b.bar = bar; b.x = xb_xcc_id(); b.st = st;
    if (threadIdx.x == 0) (void)xb_add(&bar[XB_XCNT(b.x)], 1u);
    return b;
}
__device__ __forceinline__ void xcd_barrier_complete(unsigned* bar, unsigned x, unsigned& nloc, unsigned& nx) {
    const unsigned G = gridDim.x * gridDim.y * gridDim.z;
    unsigned sum, cnt, mine, sp = 0u;
    for (;;) {
        sum = 0u; cnt = 0u; mine = 0u;
#pragma unroll
        for (unsigned j = 0; j < 16; ++j) { const unsigned c = xb_ld(&bar[XB_XCNT(j)]); sum += c; cnt += (c > 0u) ? 1u : 0u; mine = (j == x) ? c : mine; }
        if (sum == G) break;
        __builtin_amdgcn_s_sleep(1);
        if ((++sp & 255u) == 0u) { if (xb_ld(&bar[XB_TMO])) break; if (sp > XB_SPIN_CAP) { atomicAdd(&bar[XB_TMO], 1u); break; } }
    }
    nloc = mine > 0u ? mine : 1u; nx = cnt > 0u ? cnt : 1u;
}

__device__ __forceinline__ void xcd_barrier(const XcdBarrier& b) {
    asm volatile("s_waitcnt vmcnt(0)" ::: "memory");
    __syncthreads();
    if (threadIdx.x == 0) {
        unsigned* bar = b.bar;
        __builtin_amdgcn_s_waitcnt(0);
        unsigned nloc = b.st[0], nx = b.st[1];
        if (nloc == 0u) { xcd_barrier_complete(bar, b.x, nloc, nx); b.st[0] = nloc; b.st[1] = nx; }
        const unsigned old = xb_add(&bar[XB_XSUB(b.x)], 1u);
        const unsigned gen = old / nloc;
        if (old + 1u == (gen + 1u) * nloc) {
            __builtin_amdgcn_fence(__ATOMIC_RELEASE, "agent");
            asm volatile("s_waitcnt vmcnt(0)" ::: "memory");
            const unsigned og = xb_add(&bar[XB_TOP], 1u);
            const unsigned tg = og / nx;
            if (og + 1u == (tg + 1u) * nx) xb_add(&bar[XB_TOPGEN], 1u);
            else XB_SPIN(xb_ld(&bar[XB_TOPGEN]) == tg, bar);
            __builtin_amdgcn_fence(__ATOMIC_ACQUIRE, "agent");
            xb_add(&bar[XB_XGEN(b.x)], 1u);
            asm volatile("s_waitcnt vmcnt(0)" ::: "memory");
        } else {
            XB_SPIN(xb_ld(&bar[XB_XGEN(b.x)]) == gen, bar);
            __builtin_amdgcn_fence(__ATOMIC_ACQUIRE, "agent");
            asm volatile("s_waitcnt vmcnt(0)" ::: "memory");
        }
    }
    __syncthreads();
}


__device__ __forceinline__ void transpose_item(const float* W, int K, int N, bf16* WT, LAS float* scr, int item, int lane) {
    const int nblk = N / 32, kb = item / nblk, nb = item % nblk, k0 = 64 * kb, n0 = 32 * nb;
#pragma unroll 8
    for (int i = 0; i < 32; ++i) { const int kk = 2 * i + (lane >> 5); scr[kk * 33 + (lane & 31)] = W[(size_t)(k0 + kk) * N + n0 + (lane & 31)]; }
    LDS_WAIT(); asm volatile("" ::: "memory");
    const int c = lane & 7;
#pragma unroll
    for (int j = 0; j < 4; ++j) { const int n = (lane >> 3) + 8 * j; const LAS float* s = scr + (8 * c) * 33 + n;
        v4u o; o.x = pk2(s[0 * 33], s[1 * 33]); o.y = pk2(s[2 * 33], s[3 * 33]); o.z = pk2(s[4 * 33], s[5 * 33]); o.w = pk2(s[6 * 33], s[7 * 33]);
        *(GAS v4u*)(WT + (size_t)(n0 + n) * K + k0 + 8 * c) = o; }
    LDS_WAIT(); asm volatile("" ::: "memory");
}

__device__ __forceinline__ void norm_chunk(const float* xrow0, bf16* hrow0, const float* gain, const float* shift, const float* scale, int lane) {
    f32x4 A[8], B[8];
#pragma unroll
    for (int j = 0; j < 8; ++j) { const int col = 4 * lane + 256 * j; const f32x4 gn = *(const f32x4*)(gain + col), sc = *(const f32x4*)(scale + col); A[j] = gn * (sc + 1.0f); B[j] = *(const f32x4*)(shift + col); }
    for (int rr = 0; rr < 8; ++rr) {
        const GAS f32x4* xr = (const GAS f32x4*)(xrow0 + (size_t)rr * D) + lane;
        f32x4 v[8]; float ss = 0.f;
#pragma unroll
        for (int j = 0; j < 8; ++j) { v[j] = xr[64 * j]; ss += (v[j].x * v[j].x + v[j].y * v[j].y) + (v[j].z * v[j].z + v[j].w * v[j].w); }
        const float rstd = 1.0f / sqrtf(wave_sum(ss) * (1.0f / D) + RMS_EPS);
        GAS v2u* o8 = (GAS v2u*)(hrow0 + (size_t)rr * D) + lane;
#pragma unroll
        for (int j = 0; j < 8; ++j) { const f32x4 y = (v[j] * rstd) * A[j] + B[j]; v2u w; w.x = pk2(y.x, y.y); w.y = pk2(y.z, y.w); o8[64 * j] = w; }
    }
}

__device__ __forceinline__ void norm_chunk_b(const bf16* xrow0, bf16* hrow0, const float* gain, const float* shift, const float* scale, int lane) {
    f32x4 A[4][2], B[4][2];
#pragma unroll
    for (int j = 0; j < 4; ++j)
#pragma unroll
        for (int e = 0; e < 2; ++e) { const int col = 8 * lane + 512 * j + 4 * e; const f32x4 gn = *(const f32x4*)(gain + col), sc = *(const f32x4*)(scale + col); A[j][e] = gn * (sc + 1.0f); B[j][e] = *(const f32x4*)(shift + col); }
    for (int rr = 0; rr < 8; ++rr) {
        const GAS v4u* xr = (const GAS v4u*)(xrow0 + (size_t)rr * D) + lane;
        f32x4 v[4][2]; float ss = 0.f;
#pragma unroll
        for (int j = 0; j < 4; ++j) { const v4u w = xr[64 * j];
            v[j][0] = (f32x4){bf_lo(w.x), bf_hi(w.x), bf_lo(w.y), bf_hi(w.y)}; v[j][1] = (f32x4){bf_lo(w.z), bf_hi(w.z), bf_lo(w.w), bf_hi(w.w)};
#pragma unroll
            for (int e = 0; e < 2; ++e) ss += (v[j][e].x * v[j][e].x + v[j][e].y * v[j][e].y) + (v[j][e].z * v[j][e].z + v[j][e].w * v[j][e].w); }
        const float rstd = 1.0f / sqrtf(wave_sum(ss) * (1.0f / D) + RMS_EPS);
        GAS v4u* o16 = (GAS v4u*)(hrow0 + (size_t)rr * D) + lane;
#pragma unroll
        for (int j = 0; j < 4; ++j) { const f32x4 y0 = (v[j][0] * rstd) * A[j][0] + B[j][0], y1 = (v[j][1] * rstd) * A[j][1] + B[j][1];
            v4u w; w.x = pk2(y0.x, y0.y); w.y = pk2(y0.z, y0.w); w.z = pk2(y1.x, y1.y); w.w = pk2(y1.z, y1.w); o16[64 * j] = w; }
    }
}

__device__ __forceinline__ unsigned vimg_off(unsigned row, unsigned ch) { return 256u * row + 16u * (ch ^ (((row & 3) << 2) | ((row >> 2) & 3))); }
__device__ __forceinline__ s16x4 vtr(LAS unsigned char* p) { return __builtin_bit_cast(s16x4, __builtin_amdgcn_ds_read_tr16_b64_v4i16((LAS s16x4*)p)); }
#define MFMA32(a, b, c) __builtin_amdgcn_mfma_f32_32x32x16_bf16((a), (b), (c), 0, 0, 0)

__device__ __forceinline__ void attn_wave_unit(int w, LAS unsigned char* vl, const bf16* QKV, bf16* mixed, float* lse, int lane_in) {
    int lane = lane_in; asm volatile("" : "+v"(lane));
    const int n = lane & 31, h = lane >> 5;
    const int g = w / 9216; int w1 = w - g * 9216;
    int hh, w3, lsh, sstart;
    if (w1 < 3072) { const int bb = w1 / 1536, w2 = w1 - bb * 1536; hh = w2 >> 8; w3 = w2 & 255; sstart = bb * SEQP; lsh = 13 - 2 * g; }
    else { w1 -= 3072; const int bb = w1 / 384, w2 = w1 - bb * 384; hh = w2 >> 6; w3 = w2 & 63; sstart = MP + bb * SEQS; lsh = 11 - 2 * g; }
    const int head = g * 6 + hh, L = 1 << lsh, pos0 = w3 * 32, r = pos0 >> lsh, u0 = pos0 & (L - 1), seqlo = sstart + (r << lsh);
    const bf16* Qh = QKV + ((size_t)(0 * NH + head) * M + seqlo) * HD;
    const bf16* Kh = QKV + ((size_t)(1 * NH + head) * M + seqlo) * HD;
    const bf16* Vh = QKV + ((size_t)(2 * NH + head) * M + seqlo) * HD;
#define ATT_LDK(dst, kb) do { int ku_ = u0 - 64 + 32 * (kb) + n; ku_ = ku_ < 0 ? 0 : (ku_ > L - 1 ? L - 1 : ku_); const GAS bf16x8* kp_ = (const GAS bf16x8*)(Kh + (size_t)ku_ * HD + 8 * h); \
        _Pragma("unroll") for (int ks = 0; ks < 8; ++ks) dst[ks] = kp_[2 * ks]; } while (0)
#define ATT_LDV(dst, kb) do { _Pragma("unroll") for (int i = 0; i < 8; ++i) { int ku_ = u0 - 64 + 32 * (kb) + (lane >> 4) + 4 * i; ku_ = ku_ < 0 ? 0 : (ku_ > L - 1 ? L - 1 : ku_); \
        dst[i] = *(const GAS v4u*)(Vh + (size_t)ku_ * HD + 8 * (lane & 15)); } } while (0)
    bf16x8 qf[8], kfa[8], kfb[8];
    { const GAS bf16x8* qp = (const GAS bf16x8*)(Qh + (size_t)(u0 + n) * HD + 8 * h);
#pragma unroll
      for (int ks = 0; ks < 8; ++ks) qf[ks] = qp[2 * ks]; }
    ATT_LDK(kfa, 0);
    const float slope2 = exp2f(-8.0f * (float)(head + 1) / 18.0f) * (float)(1 << (2 * g)) * LOG2E;
    f32x16 s[5];
#pragma unroll
    for (int kb = 0; kb < 5; ++kb) {
        asm volatile("" ::: "memory");
        if (kb + 1 < 5) { if (kb & 1) ATT_LDK(kfa, kb + 1); else ATT_LDK(kfb, kb + 1); }
        asm volatile("" ::: "memory");
        f32x16 acc;
#pragma unroll
        for (int i = 0; i < 16; ++i) acc[i] = 0.f;
#pragma unroll
        for (int ks = 0; ks < 8; ++ks) acc = (kb & 1) ? MFMA32(kfb[ks], qf[ks], acc) : MFMA32(kfa[ks], qf[ks], acc);
#pragma unroll
        for (int i = 0; i < 16; ++i) {
            const int krow = (i & 3) + 8 * (i >> 2) + 4 * h, kuu = u0 - 64 + 32 * kb + krow, du = -64 + 32 * kb + krow - n;
            bool ok = (unsigned)kuu < (unsigned)L;
            if (kb == 0) ok = ok && (du >= -64);
            if (kb == 4) ok = ok && (du <= 64);
            s[kb][i] = ok ? acc[i] - slope2 * fabsf((float)du) : -1e30f;
        }
    }
    v4u vra[8], vrb[8];
    ATT_LDV(vra, 0);
    float mx = -1e30f;
#pragma unroll
    for (int kb = 0; kb < 5; ++kb)
#pragma unroll
        for (int i = 0; i < 16; ++i) mx = fmaxf(mx, s[kb][i]);
    mx = fmaxf(mx, __shfl_xor(mx, 32));
    float lsum = 0.f;
    v4u pw[5][2];
#pragma unroll
    for (int kb = 0; kb < 5; ++kb)
#pragma unroll
        for (int s2 = 0; s2 < 2; ++s2) { float p[8];
#pragma unroll
            for (int e = 0; e < 8; ++e) { p[e] = __builtin_amdgcn_exp2f(s[kb][8 * s2 + e] - mx); lsum += p[e]; }
            pw[kb][s2].x = pk2(p[0], p[1]); pw[kb][s2].y = pk2(p[2], p[3]); pw[kb][s2].z = pk2(p[4], p[5]); pw[kb][s2].w = pk2(p[6], p[7]); }
    lsum += __shfl_xor(lsum, 32);
    f32x16 o[4];
#pragma unroll
    for (int c = 0; c < 4; ++c)
#pragma unroll
        for (int i = 0; i < 16; ++i) o[c][i] = 0.f;
    const unsigned q4 = (lane & 15) >> 2, p4 = lane & 3, blk = (lane >> 4) & 1;
#pragma unroll
    for (int kb = 0; kb < 5; ++kb) {
#pragma unroll
        for (int i = 0; i < 8; ++i) { const unsigned row = (lane >> 4) + 4 * i; *(LAS v4u*)(vl + vimg_off(row, lane & 15)) = (kb & 1) ? vrb[i] : vra[i]; }
        asm volatile("s_waitcnt lgkmcnt(0)" ::: "memory");
        if (kb + 1 < 5) { if (kb & 1) ATT_LDV(vra, kb + 1); else ATT_LDV(vrb, kb + 1); }
        asm volatile("" ::: "memory");
#pragma unroll
        for (int s2 = 0; s2 < 2; ++s2) {
            const bf16x8 pf = __builtin_bit_cast(bf16x8, pw[kb][s2]);
#pragma unroll
            for (int c = 0; c < 4; ++c) {
                const unsigned ch = 4 * c + 2 * blk + (p4 >> 1);
                const s16x4 lo = vtr(vl + vimg_off(16 * s2 + 0 + 4 * h + q4, ch) + 8 * (p4 & 1));
                const s16x4 hi = vtr(vl + vimg_off(16 * s2 + 8 + 4 * h + q4, ch) + 8 * (p4 & 1));
                const bf16x8 vf = __builtin_shufflevector(lo, hi, 0, 1, 2, 3, 4, 5, 6, 7);
                o[c] = MFMA32(vf, pf, o[c]);
            }
        }
        asm volatile("s_waitcnt lgkmcnt(0)" ::: "memory");
    }
#undef ATT_LDK
#undef ATT_LDV
    const float inv = 1.0f / lsum;
    const int mrow = sstart + ((u0 + n) << (2 * g)) + r;
    bf16* op = mixed + (size_t)mrow * AW + head * HD + 4 * h;
#pragma unroll
    for (int c = 0; c < 4; ++c)
#pragma unroll
        for (int k4 = 0; k4 < 4; ++k4) { v2u wv; wv.x = pk2(o[c][4 * k4 + 0] * inv, o[c][4 * k4 + 1] * inv); wv.y = pk2(o[c][4 * k4 + 2] * inv, o[c][4 * k4 + 3] * inv);
            *(GAS v2u*)(op + 32 * c + 8 * k4) = wv; }
    if (h == 0) lse[(size_t)mrow * NH + head] = (mx + __builtin_amdgcn_logf(lsum)) * LN2;
}

template <int N2> __device__ __forceinline__ void fbc_item(const bf16* AOb, bf16* outb, int k1, int cg, LAS float* tw, int lane) {
    constexpr int S = 256 * N2; constexpr float scale = (N2 == 32) ? 0.17677669529663687f : 0.35355339059327373f;
    for (int idx = lane; idx < N2 * N2; idx += 64) { const int n2 = idx / N2, k2 = idx % N2; const float ph = (float)((n2 * (k1 + 256 * k2)) & (S - 1)) * (1.0f / S);
        *(LAS f32x2*)(tw + 2 * idx) = (f32x2){__builtin_amdgcn_cosf(ph) * scale, __builtin_amdgcn_sinf(ph) * scale}; }
    asm volatile("s_waitcnt lgkmcnt(0)" ::: "memory");
    for (int ch = 0; ch < 2; ++ch) {
        const int col = (cg * 2 + ch) * 256 + lane * 4;
        const GAS v2u* pr = (const GAS v2u*)(AOb + ((size_t)k1 * N2) * 2048 + col);
        const GAS v2u* pi = (const GAS v2u*)(AOb + ((size_t)(256 + k1) * N2) * 2048 + col);
        f32x4 acc[N2];
#pragma unroll
        for (int k2 = 0; k2 < N2; ++k2) acc[k2] = (f32x4){0.f, 0.f, 0.f, 0.f};
#pragma unroll 2
        for (int n2 = 0; n2 < N2; ++n2) {
            const v2u r = pr[(size_t)n2 * 512], im = pi[(size_t)n2 * 512];
            const f32x4 xr = {bf_lo(r.x), bf_hi(r.x), bf_lo(r.y), bf_hi(r.y)}, xi = {bf_lo(im.x), bf_hi(im.x), bf_lo(im.y), bf_hi(im.y)};
#pragma unroll
            for (int k2 = 0; k2 < N2; ++k2) { const f32x2 cs = *(const LAS f32x2*)(tw + 2 * (n2 * N2 + k2)); acc[k2] += xr * cs.x + xi * cs.y; }
        }
#pragma unroll
        for (int k2 = 0; k2 < N2; ++k2) { v2u w; w.x = pk2(acc[k2].x, acc[k2].y); w.y = pk2(acc[k2].z, acc[k2].w); *(GAS v2u*)(outb + (size_t)(k1 + 256 * k2) * D + col) = w; }
    }
    asm volatile("s_waitcnt lgkmcnt(0)" ::: "memory");
}

struct Args { const float* in[17]; float* out; unsigned char* ws; };
typedef const Args __attribute__((address_space(4)))* KArgs;
__device__ __forceinline__ KArgs kargs() { KArgs p = (KArgs)__builtin_amdgcn_kernarg_segment_ptr(); asm volatile("" : "+s"(p)); return p; }
__global__ void __launch_bounds__(NWAVES * 64, 2) fwd(Args args) {
    extern __shared__ __attribute__((aligned(16))) unsigned char lds_raw[];
    LAS unsigned char* lds = (LAS unsigned char*)lds_raw;
    const int wave = __builtin_amdgcn_readfirstlane((int)threadIdx.x >> 6), G = gridDim.x;
#define FRESH_TID(name) int name = threadIdx.x; asm volatile("" : "+v"(name))
    const int gw = blockIdx.x * NWAVES + wave, NGW = G * NWAVES;
    unsigned* ctl = (unsigned*)(kargs()->ws + WS_CTL);
    { FRESH_TID(tid); for (int u = tid; u < (LDS_BYTES - LDSCTL_OFF) / 4; u += NWAVES * 64) ((LAS unsigned*)(lds + LDSCTL_OFF))[u] = 0u; }
    __syncthreads();
    (void)xcd_barrier_post(ctl + CW_BAR, (volatile LAS unsigned*)(lds + MISC_OFF) + 8);
#define GRID_BAR() do { XcdBarrier bar_; bar_.bar = (unsigned*)(kargs()->ws + WS_CTL) + CW_BAR; bar_.x = xb_xcc_id(); bar_.st = (volatile LAS unsigned*)(lds + MISC_OFF) + 8; xcd_barrier(bar_); } while (0)

#define KA() kargs()
#define WSP(off) (KA()->ws + (off))
    LAS float* scr = (LAS float*)(lds + wave * 16384);

    { FRESH_TID(tid); const float* c_p = KA()->in[2]; const float* c_s = KA()->in[3]; float* cact = (float*)WSP(WS_CACT);
    for (int idx = blockIdx.x * (NWAVES * 64) + tid; idx < D * 20; idx += G * NWAVES * 64) {
        const int k = idx / 20, b = idx - 20 * k; float v = 0.f;
        if (b < NBP) v = c_p[b * D + k]; else if (b < NB) v = c_s[(b - NBP) * D + k];
        cact[idx] = v / (1.0f + __expf(-v));
    } }
    GRID_BAR();

    {
        FRESH_TID(tid_); const int lane = tid_ & 63;
        const float* w_ada = KA()->in[4]; float* modp = (float*)WSP(WS_MODP); const float* cact = (const float*)WSP(WS_CACT);
        bf16* FC = (bf16*)WSP(WS_FC); bf16* GM = (bf16*)WSP(WS_G);
        constexpr int N_MOD = DEPTH * 48 * 8, N_G = 64, N_FC = 32, N_ALL = N_MOD + N_G + N_FC;
        for (int it = gw; it < N_ALL; it += NGW) {
            if (it < N_MOD) {
#ifndef SKIP_MOD
                const int kseg = it & 7, cb = (it >> 3) % 48, layer = it / 384, col = cb * 256 + lane * 4;
                f32x4 acc[NB];
#pragma unroll
                for (int b = 0; b < NB; ++b) acc[b] = (f32x4){0.f, 0.f, 0.f, 0.f};
                const float* wp = w_ada + ((size_t)layer * D + kseg * 256) * (NMOD * D) + col;
                const float* cbase = cact + (kseg * 256) * 20;
#pragma unroll 4
                for (int k = 0; k < 256; ++k) {
                    const f32x4 wv = *(const GAS f32x4*)(wp + (size_t)k * (NMOD * D));
                    const GAS f32x4* cp = (const GAS f32x4*)(cbase + k * 20);
                    const f32x4 c0 = cp[0], c1 = cp[1], c2 = cp[2], c3 = cp[3]; const f32x2 c4 = *(const GAS f32x2*)(cp + 4);
                    acc[0] += wv * c0.x; acc[1] += wv * c0.y; acc[2] += wv * c0.z; acc[3] += wv * c0.w;
                    acc[4] += wv * c1.x; acc[5] += wv * c1.y; acc[6] += wv * c1.z; acc[7] += wv * c1.w;
                    acc[8] += wv * c2.x; acc[9] += wv * c2.y; acc[10] += wv * c2.z; acc[11] += wv * c2.w;
                    acc[12] += wv * c3.x; acc[13] += wv * c3.y; acc[14] += wv * c3.z; acc[15] += wv * c3.w;
                    acc[16] += wv * c4.x; acc[17] += wv * c4.y;
                }
#pragma unroll
                for (int b = 0; b < NB; ++b) *(GAS f32x4*)(modp + (((size_t)kseg * DEPTH + layer) * NB + b) * (NMOD * D) + col) = acc[b];
#endif
            } else if (it < N_MOD + N_G) {
                const int r = it - N_MOD;
#pragma unroll 2
                for (int i = 0; i < 8; ++i) { const int e0 = r * 4096 + i * 512 + lane * 8, row = e0 >> 9, c0 = e0 & 511, part = row >> 8, k1 = row & 255, cpart = c0 >> 8; float f[8];
#pragma unroll
                    for (int e = 0; e < 8; ++e) { const int n1 = (c0 + e) & 255; const float ph = (float)((k1 * n1) & 255) * (1.0f / 256.0f), cs = __builtin_amdgcn_cosf(ph), sn = __builtin_amdgcn_sinf(ph);
                        f[e] = (part == cpart ? cs : (part == 0 ? sn : -sn)) * 0.0625f; }
                    v4u o; o.x = pk2(f[0], f[1]); o.y = pk2(f[2], f[3]); o.z = pk2(f[4], f[5]); o.w = pk2(f[6], f[7]);
                    *(GAS v4u*)(GM + e0) = o; }
            } else {
                const int r = it - N_MOD - N_G;
#pragma unroll 2
                for (int i = 0; i < 8; ++i) { const int e0 = r * 4096 + i * 512 + lane * 8, row = e0 >> 8, c0 = e0 & 255, part = row >> 8, j = row & 255; float f[8];
#pragma unroll
                    for (int e = 0; e < 8; ++e) { const float ph = (float)((j * (c0 + e)) & 255) * (1.0f / 256.0f);
                        f[e] = (part ? -__builtin_amdgcn_sinf(ph) : __builtin_amdgcn_cosf(ph)) * 0.0625f; }
                    v4u o; o.x = pk2(f[0], f[1]); o.y = pk2(f[2], f[3]); o.z = pk2(f[4], f[5]); o.w = pk2(f[6], f[7]);
                    *(GAS v4u*)(FC + e0) = o; }
            }
        }
    }
    GRID_BAR();
    { FRESH_TID(tid); const float* b_ada = KA()->in[5]; float* mod = (float*)WSP(WS_MOD); const float* modp = (const float*)WSP(WS_MODP);
      constexpr int NV = DEPTH * NB * (NMOD * D) / 4;
      for (int i = blockIdx.x * (NWAVES * 64) + tid; i < NV; i += G * NWAVES * 64) {
          const int layer = i / (NB * (NMOD * D) / 4), col4 = i % ((NMOD * D) / 4);
          f32x4 v = ((const GAS f32x4*)(b_ada + (size_t)layer * (NMOD * D)))[col4];
#pragma unroll
          for (int ks = 0; ks < 8; ++ks) v += ((const GAS f32x4*)modp)[(size_t)ks * NV + i];
          ((GAS f32x4*)mod)[i] = v; } }
    GRID_BAR();

#ifndef REP_W1
#define REP_W1 1
#endif
#ifndef REP_QKV
#define REP_QKV 1
#endif
#ifndef REP_N
#define REP_N 1
#endif
#ifndef REP_AT
#define REP_AT 1
#endif
#ifndef REP_FB
#define REP_FB 1
#endif
#ifndef REP_F1A
#define REP_F1A 1
#endif
    for (int l = 0; l < DEPTH; ++l) {
        const bool is_attn = (l & 1) == 0; const int l2 = l >> 1;
#define MODL() ((const float*)WSP(WS_MOD) + (size_t)l * NB * (NMOD * D))
        for (int rep_ = 0; rep_ < REP_N; ++rep_) {
            FRESH_TID(tid_); const int lane = tid_ & 63;
            const float* w_qkv = KA()->in[8]; const float* w_o = KA()->in[9]; const float* w_f = KA()->in[10]; const float* w1 = KA()->in[12]; const float* w2 = KA()->in[14];
            bf16* WQKV = (bf16*)WSP(WS_WQKV); bf16* WF = (bf16*)WSP(WS_WF); bf16* WO = (bf16*)WSP(WS_WO); bf16* W1 = (bf16*)WSP(WS_W1); bf16* W2 = (bf16*)WSP(WS_W2);
            const int I_A = is_attn ? (D / 64) * (QKVW / 32) : (D / 64) * (D / 32), I_B = is_attn ? (AW / 64) * (D / 32) : 0, I_1 = (D / 64) * (FF / 32), I_2 = (FF / 64) * (D / 32);
            const int NIT = I_A + I_B + I_1 + I_2;
            for (int it = gw; it < NIT; it += NGW) {
                int r = it;
                if (r < I_A) { if (is_attn) transpose_item(w_qkv + (size_t)l2 * D * QKVW, D, QKVW, WQKV, scr, r, lane); else transpose_item(w_f + (size_t)l2 * D * D, D, D, WF, scr, r, lane); continue; } r -= I_A;
                if (r < I_B) { transpose_item(w_o + (size_t)l2 * AW * D, AW, D, WO, scr, r, lane); continue; } r -= I_B;
                if (r < I_1) { transpose_item(w1 + (size_t)l * D * FF, D, FF, W1, scr, r, lane); continue; } r -= I_1;
                transpose_item(w2 + (size_t)l * FF * D, FF, D, W2, scr, r, lane);
            }
            const float* x_p = KA()->in[0]; const float* x_s = KA()->in[1]; const bf16* XB = (const bf16*)WSP(WS_XB); const float* norm1_g = KA()->in[6]; const float* modl = MODL(); bf16* HM = (bf16*)WSP(WS_HM);
            for (int it = gw; it < M / 8; it += NGW) {
                const int row0 = it * 8, b = batch_of_tile(row0 >> 8);
                const float* mb = modl + (size_t)b * (NMOD * D);
                if (l == 0) norm_chunk(row0 < MP ? x_p + (size_t)row0 * D : x_s + (size_t)(row0 - MP) * D, HM + (size_t)row0 * D, norm1_g + l * D, mb, mb + D, lane);
                else norm_chunk_b(XB + (size_t)row0 * D, HM + (size_t)row0 * D, norm1_g + l * D, mb, mb + D, lane);
            }
        }
        GRID_BAR();
        if (is_attn) {
            for (int rep_ = 0; rep_ < REP_QKV; ++rep_) { pg8::GemmDesc g = pg8::plain_gemm(WSP(WS_HM), WSP(WS_WQKV), D, D, D, M / 256); pg8::StaticOrder S; S.init(M / 256, QKVW / 256, G, (int)blockIdx.x);
              pg8::EpiQKV E{(bf16*)WSP(WS_R), 0.08838834764831845f * LOG2E};
              pg8::gemm_phase<pg8::EpiQKV, pg8::StaticOrder, PG8_ALIGN, PG8_SP2>(lds, g, S, E); }
            GRID_BAR();
#ifndef SKIP_ATTN
            { FRESH_TID(tid_); const bf16* RB = (const bf16*)WSP(WS_R); bf16* HM = (bf16*)WSP(WS_HM); float* lse = (float*)WSP(WS_LSE);
              for (int rep_ = 0; rep_ < REP_AT; ++rep_) for (int w = gw; w < 27648; w += NGW) attn_wave_unit(w, lds + wave * 8192, RB, HM, lse, tid_ & 63); }
#endif
            GRID_BAR();
            { FRESH_TID(tid_); const int lane = tid_ & 63; bf16* HM = (bf16*)WSP(WS_HM); const float* lse = (const float*)WSP(WS_LSE);
            for (int m = gw; m < M; m += NGW) {
                const float* lr = lse + (size_t)m * NH;
#pragma unroll
                for (int i = 0; i < 5; ++i) { const int c = lane + 64 * i;
                    if (c < AW / 8) { const int head = c >> 4, hh = head % 6; const float l0 = lr[hh], l1 = lr[6 + hh], l2v = lr[12 + hh], mxl = fmaxf(l0, fmaxf(l1, l2v));
                        const float e0 = __expf(l0 - mxl), e1 = __expf(l1 - mxl), e2 = __expf(l2v - mxl), al = (head < 6 ? e0 : (head < 12 ? e1 : e2)) / (e0 + e1 + e2);
                        GAS v4u* p = (GAS v4u*)(HM + (size_t)m * AW) + c; const v4u v = *p; v4u o;
                        o.x = pk2(bf_lo(v.x) * al, bf_hi(v.x) * al); o.y = pk2(bf_lo(v.y) * al, bf_hi(v.y) * al); o.z = pk2(bf_lo(v.z) * al, bf_hi(v.z) * al); o.w = pk2(bf_lo(v.w) * al, bf_hi(v.w) * al);
                        *p = o; } }
            } }
            GRID_BAR();
            { pg8::GemmDesc g = pg8::plain_gemm(WSP(WS_HM), WSP(WS_WO), AW, AW, AW, M / 256); pg8::StaticOrder S; S.init(M / 256, D / 256, G, (int)blockIdx.x);
              pg8::EpiRes E{(l == 0) ? KA()->in[0] : nullptr, (l == 0) ? KA()->in[1] : nullptr, (bf16*)WSP(WS_XB), nullptr, MODL() + 2 * D};
              pg8::gemm_phase<pg8::EpiRes, pg8::StaticOrder, PG8_ALIGN, PG8_SP2>(lds, g, S, E); }
        } else {
            for (int rep_ = 0; rep_ < REP_F1A; ++rep_) { pg8::GemmDesc g{(const char*)WSP(WS_FC), (const char*)WSP(WS_HM), 256, (SEQP / 256) * D, 256, 2, 8, 1, 0, 0, (long long)SEQP * D * 2, 512, (long long)D * 2, 0}; pg8::StaticOrder S; S.init(NBP * 8 * 2, SEQP / 256, G, (int)blockIdx.x);
              pg8::EpiZT E{(bf16*)WSP(WS_R), 0, SEQP, SEQP / 256};
              pg8::gemm_phase<pg8::EpiZT, pg8::StaticOrder, PG8_ALIGN, PG8_SP2>(lds, g, S, E); }
            for (int rep_ = 0; rep_ < REP_F1A; ++rep_) { pg8::GemmDesc g{(const char*)WSP(WS_FC), (const char*)((bf16*)WSP(WS_HM) + (size_t)MP * D), 256, (SEQS / 256) * D, 256, 2, 8, 1, 0, 0, (long long)SEQS * D * 2, 512, (long long)D * 2, 0}; pg8::StaticOrder S; S.init(NBS * 8 * 2, SEQS / 256, G, (int)blockIdx.x);
              pg8::EpiZT E{(bf16*)WSP(WS_R), MP, SEQS, SEQS / 256};
              pg8::gemm_phase<pg8::EpiZT, pg8::StaticOrder, PG8_ALIGN, PG8_SP2>(lds, g, S, E); }
            GRID_BAR();
            for (int rep_ = 0; rep_ < REP_F1A; ++rep_) { constexpr int N2 = SEQP / 256; pg8::GemmDesc g{(const char*)WSP(WS_G), (const char*)WSP(WS_R), 512, N2 * 512, 512, 2, 1, 8, 0, 0, (long long)4096 * SEQP * 2, 0, 1024, (long long)256 * N2 * 1024};
              pg8::StaticOrder S; S.init(NBP * 2, N2 * 8, G, (int)blockIdx.x);
              pg8::EpiAO E{(bf16*)WSP(WS_AO), 0, SEQP, N2};
              pg8::gemm_phase<pg8::EpiAO, pg8::StaticOrder, PG8_ALIGN, PG8_SP2>(lds, g, S, E); }
            for (int rep_ = 0; rep_ < REP_F1A; ++rep_) { constexpr int N2 = SEQS / 256; pg8::GemmDesc g{(const char*)WSP(WS_G), (const char*)((bf16*)WSP(WS_R) + (size_t)4096 * MP), 512, N2 * 512, 512, 2, 1, 8, 0, 0, (long long)4096 * SEQS * 2, 0, 1024, (long long)256 * N2 * 1024};
              pg8::StaticOrder S; S.init(NBS * 2, N2 * 8, G, (int)blockIdx.x);
              pg8::EpiAO E{(bf16*)WSP(WS_AO), MP, SEQS, N2};
              pg8::gemm_phase<pg8::EpiAO, pg8::StaticOrder, PG8_ALIGN, PG8_SP2>(lds, g, S, E); }
            GRID_BAR();
            for (int rep_ = 0; rep_ < REP_FB; ++rep_) { FRESH_TID(tid_); const int lane = tid_ & 63; const bf16* AO = (const bf16*)WSP(WS_AO); bf16* HM = (bf16*)WSP(WS_HM); LAS float* tw = (LAS float*)(lds + wave * 8192);
              for (int it = gw; it < NBP * 256 * 4; it += NGW) { const int b = it >> 10, k1 = (it >> 2) & 255, cg = it & 3;
                  fbc_item<SEQP / 256>(AO + (size_t)4096 * (b * SEQP), HM + (size_t)(b * SEQP) * D, k1, cg, tw, lane); }
              for (int it = gw; it < NBS * 256 * 4; it += NGW) { const int b = it >> 10, k1 = (it >> 2) & 255, cg = it & 3;
                  fbc_item<SEQS / 256>(AO + (size_t)4096 * (MP + b * SEQS), HM + (size_t)(MP + b * SEQS) * D, k1, cg, tw, lane); } }
            GRID_BAR();
            { pg8::GemmDesc g = pg8::plain_gemm(WSP(WS_HM), WSP(WS_WF), D, D, D, M / 256); pg8::StaticOrder S; S.init(M / 256, D / 256, G, (int)blockIdx.x);
              pg8::EpiRes E{nullptr, nullptr, (bf16*)WSP(WS_XB), KA()->in[11] + (size_t)l2 * D, MODL() + 2 * D};
              pg8::gemm_phase<pg8::EpiRes, pg8::StaticOrder, PG8_ALIGN, PG8_SP2>(lds, g, S, E); }
        }
        GRID_BAR();
        for (int rep_ = 0; rep_ < REP_N; ++rep_) { FRESH_TID(tid_); const int lane = tid_ & 63; const bf16* XB = (const bf16*)WSP(WS_XB); const float* norm2_g = KA()->in[7]; const float* modl = MODL(); bf16* HM = (bf16*)WSP(WS_HM);
        for (int it = gw; it < M / 8; it += NGW) {
            const int row0 = it * 8, b = batch_of_tile(row0 >> 8);
            const float* mb = modl + (size_t)b * (NMOD * D) + 3 * D;
            norm_chunk_b(XB + (size_t)row0 * D, HM + (size_t)row0 * D, norm2_g + l * D, mb, mb + D, lane);
        } }
        GRID_BAR();
        for (int rep_ = 0; rep_ < REP_W1; ++rep_) { pg8::GemmDesc g = pg8::plain_gemm(WSP(WS_HM), WSP(WS_W1), D, D, D, M / 256); pg8::StaticOrder S; S.init(M / 256, FF / 256, G, (int)blockIdx.x);
          pg8::EpiBf16<1> E{(bf16*)WSP(WS_R), FF, KA()->in[13] + (size_t)l * FF, 0};
          pg8::gemm_phase<pg8::EpiBf16<1>, pg8::StaticOrder, PG8_ALIGN, PG8_SP2>(lds, g, S, E); }
        GRID_BAR();
#ifdef PROBE_W2
        { pg8::GemmDesc g = pg8::plain_gemm(WSP(WS_R), WSP(WS_W2), FF, FF, FF, M / 256); pg8::StaticOrder S; S.init(M / 256, D / 256, G, (int)blockIdx.x);
          pg8::EpiBf16<0> E{(bf16*)WSP(WS_END), D, nullptr, 0};
          pg8::gemm_phase<pg8::EpiBf16<0>, pg8::StaticOrder, PG8_ALIGN, PG8_SP2>(lds, g, S, E); }
#endif
        { pg8::GemmDesc g = pg8::plain_gemm(WSP(WS_R), WSP(WS_W2), FF, FF, FF, M / 256); pg8::StaticOrder S; S.init(M / 256, D / 256, G, (int)blockIdx.x);
          pg8::EpiRes E{nullptr, nullptr, (bf16*)WSP(WS_XB), KA()->in[15] + (size_t)l * D, MODL() + 5 * D};
          pg8::gemm_phase<pg8::EpiRes, pg8::StaticOrder, PG8_ALIGN, PG8_SP2>(lds, g, S, E); }
        GRID_BAR();
    }
    FRESH_TID(tid_); const int lane = tid_ & 63; float* yout = KA()->out; const bf16* XB = (const bf16*)WSP(WS_XB); const float* final_g = KA()->in[16];
    for (int m = gw; m < M; m += NGW) {
        const GAS v4u* xr = (const GAS v4u*)(XB + (size_t)m * D) + lane;
        f32x4 v[4][2]; float ss = 0.f;
#pragma unroll
        for (int j = 0; j < 4; ++j) { const v4u w = xr[64 * j];
            v[j][0] = (f32x4){bf_lo(w.x), bf_hi(w.x), bf_lo(w.y), bf_hi(w.y)}; v[j][1] = (f32x4){bf_lo(w.z), bf_hi(w.z), bf_lo(w.w), bf_hi(w.w)};
#pragma unroll
            for (int e = 0; e < 2; ++e) ss += (v[j][e].x * v[j][e].x + v[j][e].y * v[j][e].y) + (v[j][e].z * v[j][e].z + v[j][e].w * v[j][e].w); }
        const float rstd = 1.0f / sqrtf(wave_sum(ss) * (1.0f / D) + RMS_EPS);
#pragma unroll
        for (int j = 0; j < 4; ++j)
#pragma unroll
            for (int e = 0; e < 2; ++e) { const int col = 8 * lane + 512 * j + 4 * e; *(GAS f32x4*)(yout + (size_t)m * D + col) = (v[j][e] * rstd) * *(const f32x4*)(final_g + col); }
    }
}

extern "C" void kernel_launch(void* const* d_in, const int* in_sizes, int n_in, void* d_out, int out_size, void* d_ws, size_t ws_size, hipStream_t stream) {
    static int grid = 0;
    if (grid == 0) {
        if (n_in != 17 || out_size != M * D || ws_size < WS_END) { fprintf(stderr, "kernel_launch: unexpected shapes (n_in %d, out %d, ws %zu < %zu); nothing launched\n", n_in, out_size, ws_size, (size_t)WS_END); grid = -1; return; }
        int dev = 0, cus = 0, per_cu = 0;
        if (hipGetDevice(&dev) != hipSuccess || hipDeviceGetAttribute(&cus, hipDeviceAttributeMultiprocessorCount, dev) != hipSuccess) { grid = -1; return; }
        if (hipFuncSetAttribute((const void*)fwd, hipFuncAttributeMaxDynamicSharedMemorySize, LDS_BYTES) != hipSuccess) { fprintf(stderr, "kernel_launch: hipFuncSetAttribute failed\n"); grid = -1; return; }
        if (hipOccupancyMaxActiveBlocksPerMultiprocessor(&per_cu, (const void*)fwd, NWAVES * 64, LDS_BYTES) != hipSuccess || per_cu < 1)
            fprintf(stderr, "kernel_launch: note: occupancy query reports %d workgroups per CU\n", per_cu);
        (void)hipGetLastError();
        grid = cus;
    }
    if (grid < 0) return;
    if (hipMemsetAsync((char*)d_ws + WS_CTL, 0, CTL_ZERO_BYTES, stream) != hipSuccess) { fprintf(stderr, "kernel_launch: hipMemsetAsync failed\n"); return; }
    Args a{};
    for (int i = 0; i < 17; ++i) a.in[i] = (const float*)d_in[i];
    a.out = (float*)d_out; a.ws = (unsigned char*)d_ws;
    hipLaunchKernelGGL(fwd, dim3(grid), dim3(NWAVES * 64), LDS_BYTES, stream, a);
    const hipError_t le = hipPeekAtLastError();
    if (le != hipSuccess) fprintf(stderr, "kernel_launch: launch failed: %s\n", hipGetErrorName(le));
}
```

```cpp
#include <hip/hip_runtime.h>
#include <cstdio>
#include <cstdint>

namespace pg8 {
#define PG8_LAS __attribute__((address_space(3)))
typedef unsigned short bf16_t;
typedef short bf16x8 __attribute__((ext_vector_type(8)));
typedef float f32x4 __attribute__((ext_vector_type(4)));
typedef float f32x2 __attribute__((ext_vector_type(2)));
typedef unsigned u32x4 __attribute__((ext_vector_type(4)));
constexpr int BM = 256, BK = 64, HALF = 128, HTB = HALF * BK * 2  , STAGE_BYTES = 8 * HTB, NXCD = 8, WGM = 8;

__host__ __device__ __forceinline__ int lds_byte(int r, int c) { const int st = (r >> 4) * 2 + (c >> 5), rr = r & 15, cc = c & 31, ob = rr * 64 + cc * 2; return st * 1024 + (ob ^ (((ob >> 9) & 1) << 5)); }
__host__ __device__ __forceinline__ void stage_rc(int b, int& R, int& C) { const int st = b / 1024, sb = b % 1024, swz = sb ^ (((sb >> 9) & 1) << 5); R = (st >> 1) * 16 + swz / 64; C = (st & 1) * 32 + (swz % 64) / 2; }
__host__ __device__ __forceinline__ int perm32(int rho) { const int n = rho >> 4, i = rho & 15; return 8 * (i >> 2) + 4 * n + (i & 3); }

struct Unit { int pm, pn; };

struct GemmDesc {
    const char* A; const char* B;
    int lda, ldb, K;
    int nMb, zdiv, pdiv;
    long long sA1, sA2, sB1, sB2;
    long long pB1, pB2;
    __device__ __forceinline__ const char* aptr(const Unit& u) const { const int z = u.pm / nMb, pml = u.pm - z * nMb, z1 = z / zdiv, z2 = z - z1 * zdiv; return A + (long long)pml * (512ll * lda) + z1 * sA1 + z2 * sA2; }
    __device__ __forceinline__ const char* bptr(const Unit& u) const { const int z = u.pm / nMb, z1 = z / zdiv, z2 = z - z1 * zdiv, p1 = u.pn / pdiv, p2 = u.pn - p1 * pdiv; return B + p1 * pB1 + p2 * pB2 + z1 * sB1 + z2 * sB2; }
};
__device__ __forceinline__ GemmDesc plain_gemm(const void* A, const void* B, int lda, int ldb, int K, int nM) { return GemmDesc{(const char*)A, (const char*)B, lda, ldb, K, nM, 1, 1, 0, 0, 0, 0, 512ll * ldb, 0}; }

struct StaticOrder {
    int nM, nN, nwg, G, c;
    __host__ __device__ void init(int nM_, int nN_, int G_, int c_) { nM = nM_; nN = nN_; nwg = nM * nN; G = G_; c = c_; }
    __host__ __device__ bool next(int i, Unit& u) const {
        const long L = (long)i * G + c; if (L >= nwg) return false;
        int wgid = (int)L; { const int q = nwg / NXCD, r = nwg % NXCD, xcd = wgid % NXCD, off = wgid / NXCD; wgid = (xcd < r ? xcd * (q + 1) : r * (q + 1) + (xcd - r) * q) + off; }
        const int nig = WGM * nN, gid = wgid / nig, fm = gid * WGM, gsz = (nM - fm) < WGM ? (nM - fm) : WGM;
        u.pm = fm + ((wgid % nig) % gsz); u.pn = (wgid % nig) / gsz; return true;
    }
    __device__ __forceinline__ void a_ready(const Unit&) const {}
    __device__ __forceinline__ void done(const Unit&) const {}
#ifndef PG8_KROT
#define PG8_KROT 1
#endif
    __device__ __forceinline__ int krot(int nt) const { return PG8_KROT ? 2 * (((c & 7) * (nt >> 1)) >> 3) : 0; }
};

__device__ __forceinline__ unsigned cvt_pk_bf16(float lo, float hi) { unsigned r; asm volatile("v_cvt_pk_bf16_f32 %0, %1, %2" : "=v"(r) : "v"(lo), "v"(hi)); return r; }

template <class Epi, class Sched, bool ALIGN_EPI = false, bool SP2 = false>
__device__ __forceinline__ void gemm_phase(PG8_LAS unsigned char* lds, const GemmDesc g, const Sched& S, const Epi& E) {
    int tid_ = threadIdx.x; asm volatile("" : "+v"(tid_));
    const int tid = tid_, wid = __builtin_amdgcn_readfirstlane(tid >> 6), lane = tid & 63, wr = wid >> 2, wc = wid & 3, fr = lane & 15, fq = lane >> 4;
    const int K = g.K, nt = K / BK;
    unsigned voffA[2], voffB[2];
#pragma unroll
    for (int i = 0; i < 2; ++i) { int R, C; stage_rc(tid * 16 + i * 8192, R, C); const int Rb = Epi::PERM ? ((R & ~31) + perm32(R & 31)) : R;
        voffA[i] = (unsigned)(R * g.lda + C) * 2u; voffB[i] = (unsigned)(Rb * g.ldb + C) * 2u; }
    const size_t kstep = (size_t)(BK * 2);
    const size_t hA = (size_t)HALF * g.lda * 2, hB = (size_t)HALF * g.ldb * 2;
    const unsigned ldsw = (unsigned)wid * 1024u;
    const int aoff = lds_byte(wr * 64 + fr, fq * 8), boff = lds_byte(wc * 32 + fr, fq * 8);
#define PG8_SA(b, h) (((b) * 2 + (h)) * HTB)
#define PG8_SB(b, h) ((4 + (b) * 2 + (h)) * HTB)
#define PG8_STAGE(bufoff, gbase, voff) do { _Pragma("unroll") for (int _i = 0; _i < 2; ++_i) \
        __builtin_amdgcn_global_load_lds((const unsigned*)((const char*)(gbase) + (voff)[_i]), (PG8_LAS unsigned*)(lds + (bufoff) + ldsw + _i * 8192), 16, 0, 0); } while (0)
#define PG8_LDA(dst, b, h) do { _Pragma("unroll") for (int m = 0; m < 4; ++m) _Pragma("unroll") for (int k = 0; k < 2; ++k) dst[m][k] = *(const PG8_LAS bf16x8*)(lds + PG8_SA(b, h) + aoff + m * 2048 + k * 1024); } while (0)
#define PG8_LDB(dst, b, h) do { _Pragma("unroll") for (int n = 0; n < 2; ++n) _Pragma("unroll") for (int k = 0; k < 2; ++k) dst[n][k] = *(const PG8_LAS bf16x8*)(lds + PG8_SB(b, h) + boff + n * 2048 + k * 1024); } while (0)
#define PG8_MMA(ai, bj, At, Bt) do { __builtin_amdgcn_s_setprio(1); _Pragma("unroll") for (int m = 0; m < 4; ++m) _Pragma("unroll") for (int n = 0; n < 2; ++n) _Pragma("unroll") for (int k = 0; k < 2; ++k) \
        acc[ai][bj][m][n] = __builtin_amdgcn_mfma_f32_16x16x32_bf16(Bt[n][k], At[m][k], acc[ai][bj][m][n], 0, 0, 0); __builtin_amdgcn_s_setprio(0); } while (0)
#define PG8_WAIT_V(n) asm volatile("s_waitcnt vmcnt(" #n ")" ::: "memory")
#define PG8_WAIT_L(n) asm volatile("s_waitcnt lgkmcnt(" #n ")" ::: "memory")
#define PG8_BAR __builtin_amdgcn_s_barrier()
#define PG8_SCHED __builtin_amdgcn_sched_barrier(0)
    Unit cur, nxt; int ui = 0;
    if (!S.next(0, cur)) return;
    f32x4 acc[2][2][4][2];
#pragma unroll
    for (int a = 0; a < 2; ++a)
#pragma unroll
        for (int b = 0; b < 2; ++b)
#pragma unroll
            for (int m = 0; m < 4; ++m)
#pragma unroll
                for (int n = 0; n < 2; ++n) acc[a][b][m][n] = (f32x4){0.f, 0.f, 0.f, 0.f};
    bf16x8 At[4][2], B0[2][2], B1[2][2];
    const char* cA = g.aptr(cur); const char* cB = g.bptr(cur);
    const int r0 = S.krot(nt); const size_t roff = (size_t)r0 * kstep;
    S.a_ready(cur);
    if constexpr (SP2) {
        PG8_STAGE(PG8_SB(0, 0), cB + roff, voffB); PG8_STAGE(PG8_SB(0, 1), cB + roff + hB, voffB); PG8_STAGE(PG8_SA(0, 0), cA + roff, voffA); PG8_STAGE(PG8_SA(0, 1), cA + roff + hA, voffA);
        if (wr == 1) PG8_BAR;
        PG8_WAIT_V(2); PG8_BAR;
        PG8_STAGE(PG8_SB(1, 0), cB + roff + kstep, voffB); PG8_STAGE(PG8_SA(1, 0), cA + roff + kstep, voffA); PG8_STAGE(PG8_SB(1, 1), cB + roff + hB + kstep, voffB);
        PG8_WAIT_V(6); PG8_BAR;
    } else {
        PG8_STAGE(PG8_SB(0, 0), cB + roff, voffB); PG8_STAGE(PG8_SA(0, 0), cA + roff, voffA); PG8_STAGE(PG8_SB(0, 1), cB + roff + hB, voffB); PG8_STAGE(PG8_SA(0, 1), cA + roff + hA, voffA);
        if (wr == 1) PG8_BAR;
        PG8_WAIT_V(4); PG8_BAR;
        PG8_STAGE(PG8_SB(1, 0), cB + roff + kstep, voffB); PG8_STAGE(PG8_SA(1, 0), cA + roff + kstep, voffA); PG8_STAGE(PG8_SB(1, 1), cB + roff + hB + kstep, voffB);
        PG8_WAIT_V(6); PG8_BAR;
    }
    for (;;) {
        const bool has_next = S.next(ui + 1, nxt);
        const char* nA = has_next ? g.aptr(nxt) : cA; const char* nB = has_next ? g.bptr(nxt) : cB;
        for (int t = 0; t < nt; t += 2) {
            const bool last = (t == nt - 2);
            int tt = t + r0; if (tt >= nt) tt -= nt; int tt2 = tt + 2; if (tt2 >= nt) tt2 -= nt;
            const char* a1 = cA + (size_t)(tt + 1) * kstep;
            const char* a2 = last ? nA + roff : cA + (size_t)tt2 * kstep; const char* b2 = last ? nB + roff : cB + (size_t)tt2 * kstep;
            const char* a3 = a2 + kstep; const char* b3 = b2 + kstep;
            if (last && has_next) S.a_ready(nxt);
            if constexpr (SP2) {
            PG8_LDB(B0, 0, 0); PG8_LDB(B1, 0, 1); PG8_SCHED; PG8_LDA(At, 0, 0); PG8_STAGE(PG8_SA(1, 1), a1 + hA, voffA);
            PG8_WAIT_V(8); PG8_WAIT_L(0); PG8_BAR; PG8_MMA(0, 0, At, B0); PG8_MMA(0, 1, At, B1); PG8_BAR; PG8_SCHED;
            PG8_LDA(At, 0, 1); PG8_STAGE(PG8_SB(0, 0), b2, voffB); PG8_STAGE(PG8_SB(0, 1), b2 + hB, voffB); PG8_STAGE(PG8_SA(0, 0), a2, voffA);
            PG8_WAIT_V(8); PG8_WAIT_L(0); PG8_BAR; PG8_MMA(1, 0, At, B0); PG8_MMA(1, 1, At, B1); PG8_BAR; PG8_SCHED;
            PG8_LDB(B0, 1, 0); PG8_LDB(B1, 1, 1); PG8_SCHED; PG8_LDA(At, 1, 0); PG8_STAGE(PG8_SA(0, 1), a2 + hA, voffA);
            PG8_WAIT_V(8); PG8_WAIT_L(0); PG8_BAR; PG8_MMA(0, 0, At, B0); PG8_MMA(0, 1, At, B1); PG8_BAR; PG8_SCHED;
            PG8_LDA(At, 1, 1); PG8_STAGE(PG8_SB(1, 0), b3, voffB); PG8_STAGE(PG8_SB(1, 1), b3 + hB, voffB); PG8_STAGE(PG8_SA(1, 0), a3, voffA);
            PG8_WAIT_V(8); PG8_WAIT_L(0); PG8_BAR; PG8_MMA(1, 0, At, B0); PG8_MMA(1, 1, At, B1); PG8_BAR; PG8_SCHED;
            } else {
            PG8_LDB(B0, 0, 0); PG8_SCHED; PG8_LDA(At, 0, 0); PG8_STAGE(PG8_SA(1, 1), a1 + hA, voffA);
            PG8_WAIT_L(8); PG8_BAR; PG8_WAIT_L(0); PG8_MMA(0, 0, At, B0); PG8_BAR; PG8_SCHED;
            PG8_LDB(B1, 0, 1); PG8_STAGE(PG8_SB(0, 0), b2, voffB);
            PG8_BAR; PG8_WAIT_L(0); PG8_MMA(0, 1, At, B1); PG8_BAR;
            PG8_LDA(At, 0, 1); PG8_STAGE(PG8_SA(0, 0), a2, voffA);
            PG8_BAR; PG8_WAIT_L(0); PG8_MMA(1, 0, At, B0); PG8_BAR; PG8_SCHED;
            PG8_STAGE(PG8_SB(0, 1), b2 + hB, voffB);
            PG8_WAIT_V(6); PG8_BAR; PG8_MMA(1, 1, At, B1); PG8_BAR;
            PG8_LDB(B0, 1, 0); PG8_SCHED; PG8_LDA(At, 1, 0); PG8_STAGE(PG8_SA(0, 1), a2 + hA, voffA);
            PG8_WAIT_L(8); PG8_BAR; PG8_WAIT_L(0); PG8_MMA(0, 0, At, B0); PG8_BAR; PG8_SCHED;
            PG8_LDB(B1, 1, 1); PG8_STAGE(PG8_SB(1, 0), b3, voffB);
            PG8_BAR; PG8_WAIT_L(0); PG8_MMA(0, 1, At, B1); PG8_BAR;
            PG8_LDA(At, 1, 1); PG8_STAGE(PG8_SA(1, 0), a3, voffA);
            PG8_BAR; PG8_WAIT_L(0); PG8_MMA(1, 0, At, B0); PG8_BAR; PG8_SCHED;
            PG8_STAGE(PG8_SB(1, 1), b3 + hB, voffB);
            PG8_WAIT_V(6); PG8_BAR; PG8_MMA(1, 1, At, B1); PG8_BAR;
            }
        }
        if constexpr (ALIGN_EPI) { if (wr == 0) PG8_BAR; }
        if constexpr (!Epi::AFTER_DRAIN) { E(acc, cur, wr, wc, fr, fq); S.done(cur); }
        if (!has_next) break;
#pragma unroll
        for (int a = 0; a < 2; ++a)
#pragma unroll
            for (int b = 0; b < 2; ++b)
#pragma unroll
                for (int m = 0; m < 4; ++m)
#pragma unroll
                    for (int n = 0; n < 2; ++n) acc[a][b][m][n] = (f32x4){0.f, 0.f, 0.f, 0.f};
        cur = nxt; cA = nA; cB = nB; ++ui;
        if constexpr (ALIGN_EPI) { if (wr == 1) PG8_BAR; }
    }
    PG8_WAIT_V(0);
    if constexpr (!ALIGN_EPI) { if (wr == 0) PG8_BAR; }
    PG8_BAR;
    if constexpr (Epi::AFTER_DRAIN) { E.fused(acc, cur, wr, wc, fr, fq, lds, wid, lane); S.done(cur); }
#undef PG8_SA
#undef PG8_SB
#undef PG8_STAGE
#undef PG8_LDA
#undef PG8_LDB
#undef PG8_MMA
#undef PG8_WAIT_V
#undef PG8_WAIT_L
#undef PG8_BAR
#undef PG8_SCHED
}
}

constexpr int D = 2048, SEQP = 8192, SEQS = 2048, NBP = 2, NBS = 16, NB = NBP + NBS;
constexpr int MP = NBP * SEQP, MS = NBS * SEQS, M = MP + MS;
constexpr int NH = 18, HD = 128, AW = NH * HD, QKVW = 3 * AW, FF = 4 * D, DEPTH = 4, NMOD = 6;
constexpr float RMS_EPS = 1e-6f, LOG2E = 1.4426950408889634f, LN2 = 0.6931471805599453f;
constexpr int NWAVES = 8;

constexpr size_t MiB = 1u << 20;
constexpr size_t WS_CTL = 0, CTL_ZERO_BYTES = 1 * MiB;
constexpr size_t WS_MOD = 1 * MiB;
constexpr size_t WS_CACT = 5 * MiB;
constexpr size_t WS_LSE = 6 * MiB;
constexpr size_t WS_FC = 10 * MiB;
constexpr size_t WS_G = 11 * MiB;
constexpr size_t WS_W = 12 * MiB;
constexpr size_t WS_WQKV = WS_W, WS_WF = WS_W, WS_WO = WS_W + 27 * MiB, WS_W1 = WS_W + 36 * MiB, WS_W2 = WS_W + 68 * MiB;
constexpr size_t WS_HM = 112 * MiB;
constexpr size_t WS_R = 328 * MiB;
constexpr size_t WS_AO = WS_R + 384 * MiB;
constexpr size_t WS_MODP = WS_AO;
constexpr size_t WS_XB = 1096 * MiB;
constexpr size_t WS_END = 1288 * MiB;
static_assert(WS_W2 + (size_t)D * FF * 2 <= WS_HM && WS_HM + (size_t)M * AW * 2 <= WS_R && WS_R + (size_t)M * FF * 2 <= WS_XB && WS_XB + (size_t)M * D * 2 <= WS_END, "d_ws map");
static_assert((size_t)3 * NH * M * HD * 2 <= WS_XB - WS_R && (size_t)M * 2 * D * 2 <= WS_AO - WS_R && WS_AO + (size_t)M * 2 * D * 2 <= WS_XB, "d_ws map (R)");
constexpr int CW_BAR = 4096;

constexpr int RING_BYTES = 131072;
constexpr int LDS_BYTES = 147456;
constexpr int LDSCTL_OFF = LDS_BYTES - 512, MISC_OFF = LDSCTL_OFF + 320;
constexpr int SCR2_OFF = 65536, SCR2_STRIDE = 8448;
static_assert(SCR2_OFF + 8 * SCR2_STRIDE <= LDSCTL_OFF, "LDS map");

#define GAS __attribute__((address_space(1)))
#define LAS __attribute__((address_space(3)))
typedef unsigned short bf16;
typedef unsigned v4u __attribute__((ext_vector_type(4)));
typedef unsigned v2u __attribute__((ext_vector_type(2)));
typedef float f32x4 __attribute__((ext_vector_type(4)));
typedef float f32x2 __attribute__((ext_vector_type(2)));
typedef float f32x16 __attribute__((ext_vector_type(16)));
typedef short bf16x8 __attribute__((ext_vector_type(8)));
typedef short s16x4 __attribute__((ext_vector_type(4)));
typedef __bf16 bf16x2_t __attribute__((ext_vector_type(2)));
#define LDS_WAIT() asm volatile("s_waitcnt lgkmcnt(0)" ::: "memory")
__device__ __forceinline__ unsigned pk2(float lo, float hi) { f32x2 v = {lo, hi}; bf16x2_t b = __builtin_convertvector(v, bf16x2_t); return __builtin_bit_cast(unsigned, b); }
__device__ __forceinline__ float bf_lo(unsigned w) { return __builtin_bit_cast(float, w << 16); }
__device__ __forceinline__ float bf_hi(unsigned w) { return __builtin_bit_cast(float, w & 0xffff0000u); }
__device__ __forceinline__ float wave_sum(float v) {
#pragma unroll
    for (int o = 1; o < 64; o <<= 1) v += __shfl_xor(v, o);
    return v;
}
__device__ __forceinline__ int batch_of_tile(int pm) { return pm < 64 ? (pm >> 5) : 2 + ((pm - 64) >> 3); }

namespace pg8 {
#ifndef PG8_NT
#define PG8_NT 0
#endif
#if PG8_NT
#define PG8_ST_STREAM(p, v) __builtin_nontemporal_store((v), (p))
#else
#define PG8_ST_STREAM(p, v) (*(p) = (v))
#endif
struct EpiQKV {
    static constexpr bool PERM = true, AFTER_DRAIN = false;
    bf16_t* O; float qscale;
    __device__ __forceinline__ void operator()(const f32x4 (&acc)[2][2][4][2], const Unit& u, int wr, int wc, int fr, int fq) const {
        const int g = u.pn / 9, j = u.pn - 9 * g, which = j / 3, hp = (j - 3 * which) * 2, sh = 2 * g;
        int sstart, t0, lsh;
        if (u.pm < 64) { sstart = (u.pm >> 5) * SEQP; t0 = (u.pm & 31) * 256; lsh = 13 - sh; } else { const int q = u.pm - 64; sstart = MP + (q >> 3) * SEQS; t0 = (q & 7) * 256; lsh = 11 - sh; }
        const float sc = which == 0 ? qscale : 1.f;
#pragma unroll
        for (int ai = 0; ai < 2; ++ai)
#pragma unroll
            for (int m = 0; m < 4; ++m) { const int t = t0 + ai * HALF + wr * 64 + m * 16 + fr, prow = sstart + ((t & ((1 << sh) - 1)) << lsh) + (t >> sh);
#pragma unroll
                for (int bj = 0; bj < 2; ++bj) { const int head = g * 6 + hp + bj;
                    bf16_t* dst = O + ((size_t)(which * NH + head) * M + prow) * HD + wc * 32 + 8 * fq;
                    const f32x4 v0 = acc[ai][bj][m][0] * sc, v1 = acc[ai][bj][m][1] * sc;
                    u32x4 w; w.x = cvt_pk_bf16(v0[0], v0[1]); w.y = cvt_pk_bf16(v0[2], v0[3]); w.z = cvt_pk_bf16(v1[0], v1[1]); w.w = cvt_pk_bf16(v1[2], v1[3]);
                    PG8_ST_STREAM((u32x4*)dst, w); } }
    }
};
struct EpiRes {
    static constexpr bool PERM = true, AFTER_DRAIN = false;
    const float* xin_p; const float* xin_s; bf16_t* xb; const float* bias; const float* gate;
    __device__ __forceinline__ void operator()(const f32x4 (&acc)[2][2][4][2], const Unit& u, int wr, int wc, int fr, int fq) const {
        const int b = batch_of_tile(u.pm), col0 = u.pn * BM + wc * 32 + 8 * fq, row0 = u.pm * BM + wr * 64 + fr;
        const float* gp = gate + (size_t)b * (NMOD * D) + col0;
        f32x4 gv[2][2], bv[2][2];
#pragma unroll
        for (int bj = 0; bj < 2; ++bj)
#pragma unroll
            for (int n = 0; n < 2; ++n) { gv[bj][n] = *(const f32x4*)(gp + bj * HALF + 4 * n); bv[bj][n] = bias ? *(const f32x4*)(bias + col0 + bj * HALF + 4 * n) : (f32x4){0.f, 0.f, 0.f, 0.f}; }
#pragma unroll
        for (int ai = 0; ai < 2; ++ai)
#pragma unroll
            for (int m = 0; m < 4; ++m) { const int row = row0 + ai * HALF + m * 16; bf16_t* xo = xb + (size_t)row * D + col0;
#pragma unroll
                for (int bj = 0; bj < 2; ++bj) { f32x4 x0, x1;
                    if (xin_p) { const float* xi = (row < MP ? xin_p + (size_t)row * D : xin_s + (size_t)(row - MP) * D) + col0 + bj * HALF; x0 = *(const f32x4*)xi; x1 = *(const f32x4*)(xi + 4); }
                    else { const u32x4 w = *(const u32x4*)(xo + bj * HALF);
                        x0 = (f32x4){__builtin_bit_cast(float, w.x << 16), __builtin_bit_cast(float, w.x & 0xffff0000u), __builtin_bit_cast(float, w.y << 16), __builtin_bit_cast(float, w.y & 0xffff0000u)};
                        x1 = (f32x4){__builtin_bit_cast(float, w.z << 16), __builtin_bit_cast(float, w.z & 0xffff0000u), __builtin_bit_cast(float, w.w << 16), __builtin_bit_cast(float, w.w & 0xffff0000u)}; }
                    const f32x4 v0 = x0 + gv[bj][0] * (acc[ai][bj][m][0] + bv[bj][0]), v1 = x1 + gv[bj][1] * (acc[ai][bj][m][1] + bv[bj][1]);
                    u32x4 o; o.x = cvt_pk_bf16(v0[0], v0[1]); o.y = cvt_pk_bf16(v0[2], v0[3]); o.z = cvt_pk_bf16(v1[0], v1[1]); o.w = cvt_pk_bf16(v1[2], v1[3]);
                    *(u32x4*)(xo + bj * HALF) = o; } }
    }
};
template <int ACT> struct EpiBf16 {
    static constexpr bool PERM = true, AFTER_DRAIN = false;
    bf16_t* O; int ldc; const float* bias; int row_base;
    __device__ __forceinline__ void operator()(const f32x4 (&acc)[2][2][4][2], const Unit& u, int wr, int wc, int fr, int fq) const {
        const int row0 = row_base + u.pm * BM + wr * 64 + fr, col0 = u.pn * BM + wc * 32 + 8 * fq;
        f32x4 bv[2][2];
#pragma unroll
        for (int bj = 0; bj < 2; ++bj)
#pragma unroll
            for (int n = 0; n < 2; ++n) bv[bj][n] = bias ? *(const f32x4*)(bias + col0 + bj * HALF + 4 * n) : (f32x4){0.f, 0.f, 0.f, 0.f};
#pragma unroll
        for (int ai = 0; ai < 2; ++ai)
#pragma unroll
            for (int m = 0; m < 4; ++m) { bf16_t* rowp = O + (size_t)(row0 + ai * HALF + m * 16) * ldc + col0;
#pragma unroll
                for (int bj = 0; bj < 2; ++bj) { f32x4 v0 = acc[ai][bj][m][0] + bv[bj][0], v1 = acc[ai][bj][m][1] + bv[bj][1];
                    if (ACT == 1) {
#pragma unroll
                        for (int e = 0; e < 4; ++e) { const float a = fmaxf(v0[e], 0.f), b = fmaxf(v1[e], 0.f); v0[e] = a * a; v1[e] = b * b; } }
                    u32x4 w; w.x = cvt_pk_bf16(v0[0], v0[1]); w.y = cvt_pk_bf16(v0[2], v0[3]); w.z = cvt_pk_bf16(v1[0], v1[1]); w.w = cvt_pk_bf16(v1[2], v1[3]);
                    PG8_ST_STREAM((u32x4*)(rowp + bj * HALF), w); } }
    }
};
struct EpiZT {
    static constexpr bool PERM = true, AFTER_DRAIN = false;
    bf16_t* ZT; int seq0, S, N2;
    __device__ __forceinline__ void operator()(const f32x4 (&acc)[2][2][4][2], const Unit& u, int wr, int wc, int fr, int fq) const {
        const int part = u.pm & 1, z = u.pm >> 1, b = z >> 3, g = z & 7;
        bf16_t* base = ZT + (size_t)4096 * (seq0 + b * S) + ((size_t)(g * 256 + wr * 64 + fr) * N2 + u.pn) * 512 + part * 256 + wc * 32 + 8 * fq;
#pragma unroll
        for (int ai = 0; ai < 2; ++ai)
#pragma unroll
            for (int m = 0; m < 4; ++m) { bf16_t* rowp = base + (size_t)(ai * HALF + m * 16) * N2 * 512;
#pragma unroll
                for (int bj = 0; bj < 2; ++bj) { const f32x4 v0 = acc[ai][bj][m][0], v1 = acc[ai][bj][m][1];
                    u32x4 w; w.x = cvt_pk_bf16(v0[0], v0[1]); w.y = cvt_pk_bf16(v0[2], v0[3]); w.z = cvt_pk_bf16(v1[0], v1[1]); w.w = cvt_pk_bf16(v1[2], v1[3]);
                    PG8_ST_STREAM((u32x4*)(rowp + bj * HALF), w); } }
    }
};
struct EpiAO {
    static constexpr bool PERM = true, AFTER_DRAIN = false;
    bf16_t* AO; int seq0, S, N2;
    __device__ __forceinline__ void operator()(const f32x4 (&acc)[2][2][4][2], const Unit& u, int wr, int wc, int fr, int fq) const {
        const int part = u.pm & 1, b = u.pm >> 1, n2 = u.pn >> 3, cb = u.pn & 7;
        bf16_t* base = AO + (size_t)4096 * (seq0 + b * S) + ((size_t)(part * 256 + wr * 64 + fr) * N2 + n2) * 2048 + cb * 256 + wc * 32 + 8 * fq;
#pragma unroll
        for (int ai = 0; ai < 2; ++ai)
#pragma unroll
            for (int m = 0; m < 4; ++m) { bf16_t* rowp = base + (size_t)(ai * HALF + m * 16) * N2 * 2048;
#pragma unroll
                for (int bj = 0; bj < 2; ++bj) { const f32x4 v0 = acc[ai][bj][m][0], v1 = acc[ai][bj][m][1];
                    u32x4 w; w.x = cvt_pk_bf16(v0[0], v0[1]); w.y = cvt_pk_bf16(v0[2], v0[3]); w.z = cvt_pk_bf16(v1[0], v1[1]); w.w = cvt_pk_bf16(v1[2], v1[3]);
                    PG8_ST_STREAM((u32x4*)(rowp + bj * HALF), w); } }
    }
};
}

#ifndef PG8_SP2
#define PG8_SP2 true
#endif
#ifndef PG8_ALIGN
#define PG8_ALIGN true
#endif

#define XB_TMO      128
#define XB_XCNT(j)  (256  + 64 * (j))
#define XB_XSUB(j)  (1280 + 64 * (j))
#define XB_XGEN(j)  (2304 + 64 * (j))
#define XB_TOP      3328
#define XB_TOPGEN   3392
#define XCD_BAR_WORDS 3456
#define XB_SPIN_CAP (1u << 18)

__device__ __forceinline__ unsigned xb_ld(unsigned* p)              { return __hip_atomic_load(p, __ATOMIC_RELAXED, __HIP_MEMORY_SCOPE_AGENT); }
__device__ __forceinline__ unsigned xb_add(unsigned* p, unsigned v) { return __hip_atomic_fetch_add(p, v, __ATOMIC_RELAXED, __HIP_MEMORY_SCOPE_AGENT); }
__device__ __forceinline__ unsigned xb_xcc_id() { return (unsigned)__builtin_amdgcn_s_getreg((3 << 11) | 20) & 0xFu; }
#define XB_SPIN(cond, bar) do { unsigned _sp = 0; while (cond) { __builtin_amdgcn_s_sleep(1); \
    if ((++_sp & 255u) == 0u) { if (xb_ld(&(bar)[XB_TMO])) break; if (_sp > XB_SPIN_CAP) { atomicAdd(&(bar)[XB_TMO], 1u); break; } } } } while (0)

struct XcdBarrier {
    unsigned* bar; unsigned x;
    volatile LAS unsigned* st;
};

__device__ __forceinline__ XcdBarrier xcd_barrier_post(unsigned* bar, volatile LAS unsigned* st) {
    XcdBarrier b; b.bar = bar; b.x = xb_xcc_id(); b.st = st;
    if (threadIdx.x == 0) (void)xb_add(&bar[XB_XCNT(b.x)], 1u);
    return b;
}
__device__ __forceinline__ void xcd_barrier_complete(unsigned* bar, unsigned x, unsigned& nloc, unsigned& nx) {
    const unsigned G = gridDim.x * gridDim.y * gridDim.z;
    unsigned sum, cnt, mine, sp = 0u;
    for (;;) {
        sum = 0u; cnt = 0u; mine = 0u;
#pragma unroll
        for (unsigned j = 0; j < 16; ++j) { const unsigned c = xb_ld(&bar[XB_XCNT(j)]); sum += c; cnt += (c > 0u) ? 1u : 0u; mine = (j == x) ? c : mine; }
        if (sum == G) break;
        __builtin_amdgcn_s_sleep(1);
        if ((++sp & 255u) == 0u) { if (xb_ld(&bar[XB_TMO])) break; if (sp > XB_SPIN_CAP) { atomicAdd(&bar[XB_TMO], 1u); break; } }
    }
    nloc = mine > 0u ? mine : 1u; nx = cnt > 0u ? cnt : 1u;
}

__device__ __forceinline__ void xcd_barrier(const XcdBarrier& b) {
    asm volatile("s_waitcnt vmcnt(0)" ::: "memory");
    __syncthreads();
    if (threadIdx.x == 0) {
        unsigned* bar = b.bar;
        __builtin_amdgcn_s_waitcnt(0);
        unsigned nloc = b.st[0], nx = b.st[1];
        if (nloc == 0u) { xcd_barrier_complete(bar, b.x, nloc, nx); b.st[0] = nloc; b.st[1] = nx; }
        const unsigned old = xb_add(&bar[XB_XSUB(b.x)], 1u);
        const unsigned gen = old / nloc;
        if (old + 1u == (gen + 1u) * nloc) {
            __builtin_amdgcn_fence(__ATOMIC_RELEASE, "agent");
            asm volatile("s_waitcnt vmcnt(0)" ::: "memory");
            const unsigned og = xb_add(&bar[XB_TOP], 1u);
            const unsigned tg = og / nx;
            if (og + 1u == (tg + 1u) * nx) xb_add(&bar[XB_TOPGEN], 1u);
            else XB_SPIN(xb_ld(&bar[XB_TOPGEN]) == tg, bar);
            __builtin_amdgcn_fence(__ATOMIC_ACQUIRE, "agent");
            xb_add(&bar[XB_XGEN(b.x)], 1u);
            asm volatile("s_waitcnt vmcnt(0)" ::: "memory");
        } else {
            XB_SPIN(xb_ld(&bar[XB_XGEN(b.x)]) == gen, bar);
            __builtin_amdgcn_fence(__ATOMIC_ACQUIRE, "agent");
            asm volatile("s_waitcnt vmcnt(0)" ::: "memory");
        }
    }
    __syncthreads();
}


__device__ __forceinline__ void transpose_item(const float* W, int K, int N, bf16* WT, LAS float* scr, int item, int lane) {
    const int nblk = N / 32, kb = item / nblk, nb = item % nblk, k0 = 64 * kb, n0 = 32 * nb;
#pragma unroll 8
    for (int i = 0; i < 32; ++i) { const int kk = 2 * i + (lane >> 5); scr[kk * 33 + (lane & 31)] = W[(size_t)(k0 + kk) * N + n0 + (lane & 31)]; }
    LDS_WAIT(); asm volatile("" ::: "memory");
    const int c = lane & 7;
#pragma unroll
    for (int j = 0; j < 4; ++j) { const int n = (lane >> 3) + 8 * j; const LAS float* s = scr + (8 * c) * 33 + n;
        v4u o; o.x = pk2(s[0 * 33], s[1 * 33]); o.y = pk2(s[2 * 33], s[3 * 33]); o.z = pk2(s[4 * 33], s[5 * 33]); o.w = pk2(s[6 * 33], s[7 * 33]);
        *(GAS v4u*)(WT + (size_t)(n0 + n) * K + k0 + 8 * c) = o; }
    LDS_WAIT(); asm volatile("" ::: "memory");
}

__device__ __forceinline__ void norm_chunk(const float* xrow0, bf16* hrow0, const float* gain, const float* shift, const float* scale, int lane) {
    f32x4 A[8], B[8];
#pragma unroll
    for (int j = 0; j < 8; ++j) { const int col = 4 * lane + 256 * j; const f32x4 gn = *(const f32x4*)(gain + col), sc = *(const f32x4*)(scale + col); A[j] = gn * (sc + 1.0f); B[j] = *(const f32x4*)(shift + col); }
    for (int rr = 0; rr < 8; ++rr) {
        const GAS f32x4* xr = (const GAS f32x4*)(xrow0 + (size_t)rr * D) + lane;
        f32x4 v[8]; float ss = 0.f;
#pragma unroll
        for (int j = 0; j < 8; ++j) { v[j] = xr[64 * j]; ss += (v[j].x * v[j].x + v[j].y * v[j].y) + (v[j].z * v[j].z + v[j].w * v[j].w); }
        const float rstd = 1.0f / sqrtf(wave_sum(ss) * (1.0f / D) + RMS_EPS);
        GAS v2u* o8 = (GAS v2u*)(hrow0 + (size_t)rr * D) + lane;
#pragma unroll
        for (int j = 0; j < 8; ++j) { const f32x4 y = (v[j] * rstd) * A[j] + B[j]; v2u w; w.x = pk2(y.x, y.y); w.y = pk2(y.z, y.w); o8[64 * j] = w; }
    }
}

__device__ __forceinline__ void norm_chunk_b(const bf16* xrow0, bf16* hrow0, const float* gain, const float* shift, const float* scale, int lane) {
    f32x4 A[4][2], B[4][2];
#pragma unroll
    for (int j = 0; j < 4; ++j)
#pragma unroll
        for (int e = 0; e < 2; ++e) { const int col = 8 * lane + 512 * j + 4 * e; const f32x4 gn = *(const f32x4*)(gain + col), sc = *(const f32x4*)(scale + col); A[j][e] = gn * (sc + 1.0f); B[j][e] = *(const f32x4*)(shift + col); }
#pragma unroll 1
    for (int r4 = 0; r4 < 8; r4 += 4) {
        v4u w[4][4];
#pragma unroll
        for (int rr = 0; rr < 4; ++rr) { const GAS v4u* xr = (const GAS v4u*)(xrow0 + (size_t)(r4 + rr) * D) + lane;
#pragma unroll
            for (int j = 0; j < 4; ++j) w[rr][j] = xr[64 * j]; }
#pragma unroll
        for (int rr = 0; rr < 4; ++rr) {
            f32x4 v[4][2]; float ss = 0.f;
#pragma unroll
            for (int j = 0; j < 4; ++j) { const v4u q = w[rr][j];
                v[j][0] = (f32x4){bf_lo(q.x), bf_hi(q.x), bf_lo(q.y), bf_hi(q.y)}; v[j][1] = (f32x4){bf_lo(q.z), bf_hi(q.z), bf_lo(q.w), bf_hi(q.w)};
#pragma unroll
                for (int e = 0; e < 2; ++e) ss += (v[j][e].x * v[j][e].x + v[j][e].y * v[j][e].y) + (v[j][e].z * v[j][e].z + v[j][e].w * v[j][e].w); }
            const float rstd = 1.0f / sqrtf(wave_sum(ss) * (1.0f / D) + RMS_EPS);
            GAS v4u* o16 = (GAS v4u*)(hrow0 + (size_t)(r4 + rr) * D) + lane;
#pragma unroll
            for (int j = 0; j < 4; ++j) { const f32x4 y0 = (v[j][0] * rstd) * A[j][0] + B[j][0], y1 = (v[j][1] * rstd) * A[j][1] + B[j][1];
                v4u o; o.x = pk2(y0.x, y0.y); o.y = pk2(y0.z, y0.w); o.z = pk2(y1.x, y1.y); o.w = pk2(y1.z, y1.w); o16[64 * j] = o; }
        }
    }
}

__device__ __forceinline__ unsigned vimg_off(unsigned row, unsigned ch) { return 256u * row + 16u * (ch ^ (((row & 3) << 2) | ((row >> 2) & 3))); }
__device__ __forceinline__ s16x4 vtr(LAS unsigned char* p) { return __builtin_bit_cast(s16x4, __builtin_amdgcn_ds_read_tr16_b64_v4i16((LAS s16x4*)p)); }
#define MFMA32(a, b, c) __builtin_amdgcn_mfma_f32_32x32x16_bf16((a), (b), (c), 0, 0, 0)

__device__ __forceinline__ void attn_wave_unit(int w, LAS unsigned char* vl, const bf16* QKV, bf16* mixed, float* lse, int lane_in) {
    int lane = lane_in; asm volatile("" : "+v"(lane));
    const int n = lane & 31, h = lane >> 5;
    const int g = w / 9216; int w1 = w - g * 9216;
    int hh, w3, lsh, sstart;
    if (w1 < 3072) { const int bb = w1 / 1536, w2 = w1 - bb * 1536; hh = w2 >> 8; w3 = w2 & 255; sstart = bb * SEQP; lsh = 13 - 2 * g; }
    else { w1 -= 3072; const int bb = w1 / 384, w2 = w1 - bb * 384; hh = w2 >> 6; w3 = w2 & 63; sstart = MP + bb * SEQS; lsh = 11 - 2 * g; }
    const int head = g * 6 + hh, L = 1 << lsh, pos0 = w3 * 32, r = pos0 >> lsh, u0 = pos0 & (L - 1), seqlo = sstart + (r << lsh);
    const bf16* Qh = QKV + ((size_t)(0 * NH + head) * M + seqlo) * HD;
    const bf16* Kh = QKV + ((size_t)(1 * NH + head) * M + seqlo) * HD;
    const bf16* Vh = QKV + ((size_t)(2 * NH + head) * M + seqlo) * HD;
#define ATT_LDK(dst, kb) do { int ku_ = u0 - 64 + 32 * (kb) + n; ku_ = ku_ < 0 ? 0 : (ku_ > L - 1 ? L - 1 : ku_); const GAS bf16x8* kp_ = (const GAS bf16x8*)(Kh + (size_t)ku_ * HD + 8 * h); \
        _Pragma("unroll") for (int ks = 0; ks < 8; ++ks) dst[ks] = kp_[2 * ks]; } while (0)
#define ATT_LDV(dst, kb) do { _Pragma("unroll") for (int i = 0; i < 8; ++i) { int ku_ = u0 - 64 + 32 * (kb) + (lane >> 4) + 4 * i; ku_ = ku_ < 0 ? 0 : (ku_ > L - 1 ? L - 1 : ku_); \
        dst[i] = *(const GAS v4u*)(Vh + (size_t)ku_ * HD + 8 * (lane & 15)); } } while (0)
    bf16x8 qf[8], kfa[8], kfb[8];
    { const GAS bf16x8* qp = (const GAS bf16x8*)(Qh + (size_t)(u0 + n) * HD + 8 * h);
#pragma unroll
      for (int ks = 0; ks < 8; ++ks) qf[ks] = qp[2 * ks]; }
    ATT_LDK(kfa, 0);
    const float slope2 = exp2f(-8.0f * (float)(head + 1) / 18.0f) * (float)(1 << (2 * g)) * LOG2E;
    f32x16 s[5];
#pragma unroll
    for (int kb = 0; kb < 5; ++kb) {
        asm volatile("" ::: "memory");
        if (kb + 1 < 5) { if (kb & 1) ATT_LDK(kfa, kb + 1); else ATT_LDK(kfb, kb + 1); }
        asm volatile("" ::: "memory");
        f32x16 acc;
#pragma unroll
        for (int i = 0; i < 16; ++i) acc[i] = 0.f;
#pragma unroll
        for (int ks = 0; ks < 8; ++ks) acc = (kb & 1) ? MFMA32(kfb[ks], qf[ks], acc) : MFMA32(kfa[ks], qf[ks], acc);
#pragma unroll
        for (int i = 0; i < 16; ++i) {
            const int krow = (i & 3) + 8 * (i >> 2) + 4 * h, kuu = u0 - 64 + 32 * kb + krow, du = -64 + 32 * kb + krow - n;
            bool ok = (unsigned)kuu < (unsigned)L;
            if (kb == 0) ok = ok && (du >= -64);
            if (kb == 4) ok = ok && (du <= 64);
            s[kb][i] = ok ? acc[i] - slope2 * fabsf((float)du) : -1e30f;
        }
    }
    v4u vra[8], vrb[8];
    ATT_LDV(vra, 0);
    float mx = -1e30f;
#pragma unroll
    for (int kb = 0; kb < 5; ++kb)
#pragma unroll
        for (int i = 0; i < 16; ++i) mx = fmaxf(mx, s[kb][i]);
    mx = fmaxf(mx, __shfl_xor(mx, 32));
    float lsum = 0.f;
    v4u pw[5][2];
#pragma unroll
    for (int kb = 0; kb < 5; ++kb)
#pragma unroll
        for (int s2 = 0; s2 < 2; ++s2) { float p[8];
#pragma unroll
            for (int e = 0; e < 8; ++e) { p[e] = __builtin_amdgcn_exp2f(s[kb][8 * s2 + e] - mx); lsum += p[e]; }
            pw[kb][s2].x = pk2(p[0], p[1]); pw[kb][s2].y = pk2(p[2], p[3]); pw[kb][s2].z = pk2(p[4], p[5]); pw[kb][s2].w = pk2(p[6], p[7]); }
    lsum += __shfl_xor(lsum, 32);
    f32x16 o[4];
#pragma unroll
    for (int c = 0; c < 4; ++c)
#pragma unroll
        for (int i = 0; i < 16; ++i) o[c][i] = 0.f;
    const unsigned q4 = (lane & 15) >> 2, p4 = lane & 3, blk = (lane >> 4) & 1;
#pragma unroll
    for (int kb = 0; kb < 5; ++kb) {
#pragma unroll
        for (int i = 0; i < 8; ++i) { const unsigned row = (lane >> 4) + 4 * i; *(LAS v4u*)(vl + vimg_off(row, lane & 15)) = (kb & 1) ? vrb[i] : vra[i]; }
        asm volatile("s_waitcnt lgkmcnt(0)" ::: "memory");
        if (kb + 1 < 5) { if (kb & 1) ATT_LDV(vra, kb + 1); else ATT_LDV(vrb, kb + 1); }
        asm volatile("" ::: "memory");
#pragma unroll
        for (int s2 = 0; s2 < 2; ++s2) {
            const bf16x8 pf = __builtin_bit_cast(bf16x8, pw[kb][s2]);
#pragma unroll
            for (int c = 0; c < 4; ++c) {
                const unsigned ch = 4 * c + 2 * blk + (p4 >> 1);
                const s16x4 lo = vtr(vl + vimg_off(16 * s2 + 0 + 4 * h + q4, ch) + 8 * (p4 & 1));
                const s16x4 hi = vtr(vl + vimg_off(16 * s2 + 8 + 4 * h + q4, ch) + 8 * (p4 & 1));
                const bf16x8 vf = __builtin_shufflevector(lo, hi, 0, 1, 2, 3, 4, 5, 6, 7);
                o[c] = MFMA32(vf, pf, o[c]);
            }
        }
        asm volatile("s_waitcnt lgkmcnt(0)" ::: "memory");
    }
#undef ATT_LDK
#undef ATT_LDV
    const float inv = 1.0f / lsum;
    const int mrow = sstart + ((u0 + n) << (2 * g)) + r;
    bf16* op = mixed + (size_t)mrow * AW + head * HD + 4 * h;
#pragma unroll
    for (int c = 0; c < 4; ++c)
#pragma unroll
        for (int k4 = 0; k4 < 4; ++k4) { v2u wv; wv.x = pk2(o[c][4 * k4 + 0] * inv, o[c][4 * k4 + 1] * inv); wv.y = pk2(o[c][4 * k4 + 2] * inv, o[c][4 * k4 + 3] * inv);
            *(GAS v2u*)(op + 32 * c + 8 * k4) = wv; }
    if (h == 0) lse[(size_t)mrow * NH + head] = (mx + __builtin_amdgcn_logf(lsum)) * LN2;
}

template <int N2> __device__ __forceinline__ void fbc_item(const bf16* AOb, bf16* outb, int k1, int cg, LAS float* tw, int lane) {
    constexpr int S = 256 * N2; constexpr float scale = (N2 == 32) ? 0.17677669529663687f : 0.35355339059327373f;
    for (int idx = lane; idx < N2 * N2; idx += 64) { const int n2 = idx / N2, k2 = idx % N2; const float ph = (float)((n2 * (k1 + 256 * k2)) & (S - 1)) * (1.0f / S);
        *(LAS f32x2*)(tw + 2 * idx) = (f32x2){__builtin_amdgcn_cosf(ph) * scale, __builtin_amdgcn_sinf(ph) * scale}; }
    asm volatile("s_waitcnt lgkmcnt(0)" ::: "memory");
    for (int ch = 0; ch < 2; ++ch) {
        const int col = (cg * 2 + ch) * 256 + lane * 4;
        const GAS v2u* pr = (const GAS v2u*)(AOb + ((size_t)k1 * N2) * 2048 + col);
        const GAS v2u* pi = (const GAS v2u*)(AOb + ((size_t)(256 + k1) * N2) * 2048 + col);
        f32x4 acc[N2];
#pragma unroll
        for (int k2 = 0; k2 < N2; ++k2) acc[k2] = (f32x4){0.f, 0.f, 0.f, 0.f};
#pragma unroll 2
        for (int n2 = 0; n2 < N2; ++n2) {
            const v2u r = pr[(size_t)n2 * 512], im = pi[(size_t)n2 * 512];
            const f32x4 xr = {bf_lo(r.x), bf_hi(r.x), bf_lo(r.y), bf_hi(r.y)}, xi = {bf_lo(im.x), bf_hi(im.x), bf_lo(im.y), bf_hi(im.y)};
#pragma unroll
            for (int k2 = 0; k2 < N2; ++k2) { const f32x2 cs = *(const LAS f32x2*)(tw + 2 * (n2 * N2 + k2)); acc[k2] += xr * cs.x + xi * cs.y; }
        }
#pragma unroll
        for (int k2 = 0; k2 < N2; ++k2) { v2u w; w.x = pk2(acc[k2].x, acc[k2].y); w.y = pk2(acc[k2].z, acc[k2].w); *(GAS v2u*)(outb + (size_t)(k1 + 256 * k2) * D + col) = w; }
    }
    asm volatile("s_waitcnt lgkmcnt(0)" ::: "memory");
}

struct Args { const float* in[17]; float* out; unsigned char* ws; };
typedef const Args __attribute__((address_space(4)))* KArgs;
__device__ __forceinline__ KArgs kargs() { KArgs p = (KArgs)__builtin_amdgcn_kernarg_segment_ptr(); asm volatile("" : "+s"(p)); return p; }
__global__ void __launch_bounds__(NWAVES * 64, 2) fwd(Args args) {
    extern __shared__ __attribute__((aligned(16))) unsigned char lds_raw[];
    LAS unsigned char* lds = (LAS unsigned char*)lds_raw;
    const int wave = __builtin_amdgcn_readfirstlane((int)threadIdx.x >> 6), G = gridDim.x;
#define FRESH_TID(name) int name = threadIdx.x; asm volatile("" : "+v"(name))
    const int gw = blockIdx.x * NWAVES + wave, NGW = G * NWAVES;
    unsigned* ctl = (unsigned*)(kargs()->ws + WS_CTL);
    { FRESH_TID(tid); for (int u = tid; u < (LDS_BYTES - LDSCTL_OFF) / 4; u += NWAVES * 64) ((LAS unsigned*)(lds + LDSCTL_OFF))[u] = 0u; }
    __syncthreads();
    (void)xcd_barrier_post(ctl + CW_BAR, (volatile LAS unsigned*)(lds + MISC_OFF) + 8);
#define GRID_BAR() do { XcdBarrier bar_; bar_.bar = (unsigned*)(kargs()->ws + WS_CTL) + CW_BAR; bar_.x = xb_xcc_id(); bar_.st = (volatile LAS unsigned*)(lds + MISC_OFF) + 8; xcd_barrier(bar_); } while (0)

#define KA() kargs()
#define WSP(off) (KA()->ws + (off))
    LAS float* scr = (LAS float*)(lds + wave * 16384);

    { FRESH_TID(tid); const float* c_p = KA()->in[2]; const float* c_s = KA()->in[3]; float* cact = (float*)WSP(WS_CACT);
    for (int idx = blockIdx.x * (NWAVES * 64) + tid; idx < D * 20; idx += G * NWAVES * 64) {
        const int k = idx / 20, b = idx - 20 * k; float v = 0.f;
        if (b < NBP) v = c_p[b * D + k]; else if (b < NB) v = c_s[(b - NBP) * D + k];
        cact[idx] = v / (1.0f + __expf(-v));
    } }
    GRID_BAR();

    {
        FRESH_TID(tid_); const int lane = tid_ & 63;
        const float* w_ada = KA()->in[4]; float* modp = (float*)WSP(WS_MODP); const float* cact = (const float*)WSP(WS_CACT);
        bf16* FC = (bf16*)WSP(WS_FC); bf16* GM = (bf16*)WSP(WS_G);
        constexpr int N_MOD = DEPTH * 48 * 8, N_G = 64, N_FC = 32, N_ALL = N_MOD + N_G + N_FC;
        for (int it = gw; it < N_ALL; it += NGW) {
            if (it < N_MOD) {
#ifndef SKIP_MOD
                const int kseg = it & 7, cb = (it >> 3) % 48, layer = it / 384, col = cb * 256 + lane * 4;
                f32x4 acc[NB];
#pragma unroll
                for (int b = 0; b < NB; ++b) acc[b] = (f32x4){0.f, 0.f, 0.f, 0.f};
                const float* wp = w_ada + ((size_t)layer * D + kseg * 256) * (NMOD * D) + col;
                const float* cbase = cact + (kseg * 256) * 20;
#pragma unroll 4
                for (int k = 0; k < 256; ++k) {
                    const f32x4 wv = *(const GAS f32x4*)(wp + (size_t)k * (NMOD * D));
                    const GAS f32x4* cp = (const GAS f32x4*)(cbase + k * 20);
                    const f32x4 c0 = cp[0], c1 = cp[1], c2 = cp[2], c3 = cp[3]; const f32x2 c4 = *(const GAS f32x2*)(cp + 4);
                    acc[0] += wv * c0.x; acc[1] += wv * c0.y; acc[2] += wv * c0.z; acc[3] += wv * c0.w;
                    acc[4] += wv * c1.x; acc[5] += wv * c1.y; acc[6] += wv * c1.z; acc[7] += wv * c1.w;
                    acc[8] += wv * c2.x; acc[9] += wv * c2.y; acc[10] += wv * c2.z; acc[11] += wv * c2.w;
                    acc[12] += wv * c3.x; acc[13] += wv * c3.y; acc[14] += wv * c3.z; acc[15] += wv * c3.w;
                    acc[16] += wv * c4.x; acc[17] += wv * c4.y;
                }
#pragma unroll
                for (int b = 0; b < NB; ++b) *(GAS f32x4*)(modp + (((size_t)kseg * DEPTH + layer) * NB + b) * (NMOD * D) + col) = acc[b];
#endif
            } else if (it < N_MOD + N_G) {
                const int r = it - N_MOD;
#pragma unroll 2
                for (int i = 0; i < 8; ++i) { const int e0 = r * 4096 + i * 512 + lane * 8, row = e0 >> 9, c0 = e0 & 511, part = row >> 8, k1 = row & 255, cpart = c0 >> 8; float f[8];
#pragma unroll
                    for (int e = 0; e < 8; ++e) { const int n1 = (c0 + e) & 255; const float ph = (float)((k1 * n1) & 255) * (1.0f / 256.0f), cs = __builtin_amdgcn_cosf(ph), sn = __builtin_amdgcn_sinf(ph);
                        f[e] = (part == cpart ? cs : (part == 0 ? sn : -sn)) * 0.0625f; }
                    v4u o; o.x = pk2(f[0], f[1]); o.y = pk2(f[2], f[3]); o.z = pk2(f[4], f[5]); o.w = pk2(f[6], f[7]);
                    *(GAS v4u*)(GM + e0) = o; }
            } else {
                const int r = it - N_MOD - N_G;
#pragma unroll 2
                for (int i = 0; i < 8; ++i) { const int e0 = r * 4096 + i * 512 + lane * 8, row = e0 >> 8, c0 = e0 & 255, part = row >> 8, j = row & 255; float f[8];
#pragma unroll
                    for (int e = 0; e < 8; ++e) { const float ph = (float)((j * (c0 + e)) & 255) * (1.0f / 256.0f);
                        f[e] = (part ? -__builtin_amdgcn_sinf(ph) : __builtin_amdgcn_cosf(ph)) * 0.0625f; }
                    v4u o; o.x = pk2(f[0], f[1]); o.y = pk2(f[2], f[3]); o.z = pk2(f[4], f[5]); o.w = pk2(f[6], f[7]);
                    *(GAS v4u*)(FC + e0) = o; }
            }
        }
    }
    GRID_BAR();
    { FRESH_TID(tid); const float* b_ada = KA()->in[5]; float* mod = (float*)WSP(WS_MOD); const float* modp = (const float*)WSP(WS_MODP);
      constexpr int NV = DEPTH * NB * (NMOD * D) / 4;
      for (int i = blockIdx.x * (NWAVES * 64) + tid; i < NV; i += G * NWAVES * 64) {
          const int layer = i / (NB * (NMOD * D) / 4), col4 = i % ((NMOD * D) / 4);
          f32x4 v = ((const GAS f32x4*)(b_ada + (size_t)layer * (NMOD * D)))[col4];
#pragma unroll
          for (int ks = 0; ks < 8; ++ks) v += ((const GAS f32x4*)modp)[(size_t)ks * NV + i];
          ((GAS f32x4*)mod)[i] = v; } }
    GRID_BAR();

#define CONVERT_REST(lane_) do { const float* w_o_ = KA()->in[9]; const float* w1_ = KA()->in[12]; const float* w2_ = KA()->in[14]; bf16* WO_ = (bf16*)WSP(WS_WO); bf16* W1_ = (bf16*)WSP(WS_W1); bf16* W2_ = (bf16*)WSP(WS_W2); \
        LAS float* scr2_ = (LAS float*)(lds + SCR2_OFF + wave * SCR2_STRIDE); const int I_B_ = is_attn ? (AW / 64) * (D / 32) : 0, I_1_ = (D / 64) * (FF / 32), I_2_ = (FF / 64) * (D / 32); \
        for (int it_ = gw; it_ < I_B_ + I_1_ + I_2_; it_ += NGW) { int r_ = it_; \
            if (r_ < I_B_) { transpose_item(w_o_ + (size_t)l2 * AW * D, AW, D, WO_, scr2_, r_, lane_); continue; } r_ -= I_B_; \
            if (r_ < I_1_) { transpose_item(w1_ + (size_t)l * D * FF, D, FF, W1_, scr2_, r_, lane_); continue; } r_ -= I_1_; \
            transpose_item(w2_ + (size_t)l * FF * D, FF, D, W2_, scr2_, r_, lane_); } } while (0)
#ifndef REP_W1
#define REP_W1 1
#endif
#ifndef REP_QKV
#define REP_QKV 1
#endif
#ifndef REP_N
#define REP_N 1
#endif
#ifndef REP_AT
#define REP_AT 1
#endif
#ifndef REP_FB
#define REP_FB 1
#endif
#ifndef REP_F1A
#define REP_F1A 1
#endif
    for (int l = 0; l < DEPTH; ++l) {
        const bool is_attn = (l & 1) == 0; const int l2 = l >> 1;
#define MODL() ((const float*)WSP(WS_MOD) + (size_t)l * NB * (NMOD * D))
        for (int rep_ = 0; rep_ < REP_N; ++rep_) {
            FRESH_TID(tid_); const int lane = tid_ & 63;
            const float* w_qkv = KA()->in[8]; const float* w_f = KA()->in[10]; bf16* WQKV = (bf16*)WSP(WS_WQKV); bf16* WF = (bf16*)WSP(WS_WF);
            const int I_A = is_attn ? (D / 64) * (QKVW / 32) : (D / 64) * (D / 32);
            for (int it = gw; it < I_A; it += NGW) { if (is_attn) transpose_item(w_qkv + (size_t)l2 * D * QKVW, D, QKVW, WQKV, scr, it, lane); else transpose_item(w_f + (size_t)l2 * D * D, D, D, WF, scr, it, lane); }
            const float* x_p = KA()->in[0]; const float* x_s = KA()->in[1]; const bf16* XB = (const bf16*)WSP(WS_XB); const float* norm1_g = KA()->in[6]; const float* modl = MODL(); bf16* HM = (bf16*)WSP(WS_HM);
            for (int it = gw; it < M / 8; it += NGW) {
                const int row0 = it * 8, b = batch_of_tile(row0 >> 8);
                const float* mb = modl + (size_t)b * (NMOD * D);
                if (l == 0) norm_chunk(row0 < MP ? x_p + (size_t)row0 * D : x_s + (size_t)(row0 - MP) * D, HM + (size_t)row0 * D, norm1_g + l * D, mb, mb + D, lane);
                else norm_chunk_b(XB + (size_t)row0 * D, HM + (size_t)row0 * D, norm1_g + l * D, mb, mb + D, lane);
            }
        }
        GRID_BAR();
        if (is_attn) {
            for (int rep_ = 0; rep_ < REP_QKV; ++rep_) { pg8::GemmDesc g = pg8::plain_gemm(WSP(WS_HM), WSP(WS_WQKV), D, D, D, M / 256); pg8::StaticOrder S; S.init(M / 256, QKVW / 256, G, (int)blockIdx.x);
              pg8::EpiQKV E{(bf16*)WSP(WS_R), 0.08838834764831845f * LOG2E};
              pg8::gemm_phase<pg8::EpiQKV, pg8::StaticOrder, PG8_ALIGN, PG8_SP2>(lds, g, S, E); }
            GRID_BAR();
#ifndef SKIP_ATTN
            { FRESH_TID(tid_); const bf16* RB = (const bf16*)WSP(WS_R); bf16* HM = (bf16*)WSP(WS_HM); float* lse = (float*)WSP(WS_LSE);
              for (int rep_ = 0; rep_ < REP_AT; ++rep_) for (int w = gw; w < 27648; w += NGW) attn_wave_unit(w, lds + wave * 8192, RB, HM, lse, tid_ & 63);
              CONVERT_REST(tid_ & 63); }
#endif
            GRID_BAR();
            { FRESH_TID(tid_); const int lane = tid_ & 63; bf16* HM = (bf16*)WSP(WS_HM); const float* lse = (const float*)WSP(WS_LSE);
            for (int m = gw * 4; m < M; m += NGW * 4) {
                v4u vv[4][5]; float al[4][5];
#pragma unroll
                for (int rr = 0; rr < 4; ++rr) { const float* lr = lse + (size_t)(m + rr) * NH;
#pragma unroll
                    for (int i = 0; i < 5; ++i) { const int c = lane + 64 * i;
                        if (c < AW / 8) { const int head = c >> 4, hh = head % 6; const float l0 = lr[hh], l1 = lr[6 + hh], l2v = lr[12 + hh], mxl = fmaxf(l0, fmaxf(l1, l2v));
                            const float e0 = __expf(l0 - mxl), e1 = __expf(l1 - mxl), e2 = __expf(l2v - mxl); al[rr][i] = (head < 6 ? e0 : (head < 12 ? e1 : e2)) / (e0 + e1 + e2);
                            vv[rr][i] = *((const GAS v4u*)(HM + (size_t)(m + rr) * AW) + c); } } }
#pragma unroll
                for (int rr = 0; rr < 4; ++rr)
#pragma unroll
                    for (int i = 0; i < 5; ++i) { const int c = lane + 64 * i;
                        if (c < AW / 8) { const v4u v = vv[rr][i]; const float a = al[rr][i]; v4u o;
                            o.x = pk2(bf_lo(v.x) * a, bf_hi(v.x) * a); o.y = pk2(bf_lo(v.y) * a, bf_hi(v.y) * a); o.z = pk2(bf_lo(v.z) * a, bf_hi(v.z) * a); o.w = pk2(bf_lo(v.w) * a, bf_hi(v.w) * a);
                            *((GAS v4u*)(HM + (size_t)(m + rr) * AW) + c) = o; } }
            } }
            GRID_BAR();
            { pg8::GemmDesc g = pg8::plain_gemm(WSP(WS_HM), WSP(WS_WO), AW, AW, AW, M / 256); pg8::StaticOrder S; S.init(M / 256, D / 256, G, (int)blockIdx.x);
              pg8::EpiRes E{(l == 0) ? KA()->in[0] : nullptr, (l == 0) ? KA()->in[1] : nullptr, (bf16*)WSP(WS_XB), nullptr, MODL() + 2 * D};
              pg8::gemm_phase<pg8::EpiRes, pg8::StaticOrder, PG8_ALIGN, PG8_SP2>(lds, g, S, E); }
        } else {
            for (int rep_ = 0; rep_ < REP_F1A; ++rep_) { pg8::GemmDesc g{(const char*)WSP(WS_FC), (const char*)WSP(WS_HM), 256, (SEQP / 256) * D, 256, 2, 8, 1, 0, 0, (long long)SEQP * D * 2, 512, (long long)D * 2, 0}; pg8::StaticOrder S; S.init(NBP * 8 * 2, SEQP / 256, G, (int)blockIdx.x);
              pg8::EpiZT E{(bf16*)WSP(WS_R), 0, SEQP, SEQP / 256};
              pg8::gemm_phase<pg8::EpiZT, pg8::StaticOrder, PG8_ALIGN, PG8_SP2>(lds, g, S, E); }
            for (int rep_ = 0; rep_ < REP_F1A; ++rep_) { pg8::GemmDesc g{(const char*)WSP(WS_FC), (const char*)((bf16*)WSP(WS_HM) + (size_t)MP * D), 256, (SEQS / 256) * D, 256, 2, 8, 1, 0, 0, (long long)SEQS * D * 2, 512, (long long)D * 2, 0}; pg8::StaticOrder S; S.init(NBS * 8 * 2, SEQS / 256, G, (int)blockIdx.x);
              pg8::EpiZT E{(bf16*)WSP(WS_R), MP, SEQS, SEQS / 256};
              pg8::gemm_phase<pg8::EpiZT, pg8::StaticOrder, PG8_ALIGN, PG8_SP2>(lds, g, S, E); }
            GRID_BAR();
            for (int rep_ = 0; rep_ < REP_F1A; ++rep_) { constexpr int N2 = SEQP / 256; pg8::GemmDesc g{(const char*)WSP(WS_G), (const char*)WSP(WS_R), 512, N2 * 512, 512, 2, 1, 8, 0, 0, (long long)4096 * SEQP * 2, 0, 1024, (long long)256 * N2 * 1024};
              pg8::StaticOrder S; S.init(NBP * 2, N2 * 8, G, (int)blockIdx.x);
              pg8::EpiAO E{(bf16*)WSP(WS_AO), 0, SEQP, N2};
              pg8::gemm_phase<pg8::EpiAO, pg8::StaticOrder, PG8_ALIGN, PG8_SP2>(lds, g, S, E); }
            for (int rep_ = 0; rep_ < REP_F1A; ++rep_) { constexpr int N2 = SEQS / 256; pg8::GemmDesc g{(const char*)WSP(WS_G), (const char*)((bf16*)WSP(WS_R) + (size_t)4096 * MP), 512, N2 * 512, 512, 2, 1, 8, 0, 0, (long long)4096 * SEQS * 2, 0, 1024, (long long)256 * N2 * 1024};
              pg8::StaticOrder S; S.init(NBS * 2, N2 * 8, G, (int)blockIdx.x);
              pg8::EpiAO E{(bf16*)WSP(WS_AO), MP, SEQS, N2};
              pg8::gemm_phase<pg8::EpiAO, pg8::StaticOrder, PG8_ALIGN, PG8_SP2>(lds, g, S, E); }
            GRID_BAR();
            for (int rep_ = 0; rep_ < REP_FB; ++rep_) { FRESH_TID(tid_); const int lane = tid_ & 63; const bf16* AO = (const bf16*)WSP(WS_AO); bf16* HM = (bf16*)WSP(WS_HM); LAS float* tw = (LAS float*)(lds + wave * 8192);
              for (int it = gw; it < NBP * 256 * 4; it += NGW) { const int b = it >> 10, k1 = (it >> 2) & 255, cg = it & 3;
                  fbc_item<SEQP / 256>(AO + (size_t)4096 * (b * SEQP), HM + (size_t)(b * SEQP) * D, k1, cg, tw, lane); }
              for (int it = gw; it < NBS * 256 * 4; it += NGW) { const int b = it >> 10, k1 = (it >> 2) & 255, cg = it & 3;
                  fbc_item<SEQS / 256>(AO + (size_t)4096 * (MP + b * SEQS), HM + (size_t)(MP + b * SEQS) * D, k1, cg, tw, lane); }
              if (rep_ == 0) CONVERT_REST(lane); }
            GRID_BAR();
            { pg8::GemmDesc g = pg8::plain_gemm(WSP(WS_HM), WSP(WS_WF), D, D, D, M / 256); pg8::StaticOrder S; S.init(M / 256, D / 256, G, (int)blockIdx.x);
              pg8::EpiRes E{nullptr, nullptr, (bf16*)WSP(WS_XB), KA()->in[11] + (size_t)l2 * D, MODL() + 2 * D};
              pg8::gemm_phase<pg8::EpiRes, pg8::StaticOrder, PG8_ALIGN, PG8_SP2>(lds, g, S, E); }
        }
        GRID_BAR();
        for (int rep_ = 0; rep_ < REP_N; ++rep_) { FRESH_TID(tid_); const int lane = tid_ & 63; const bf16* XB = (const bf16*)WSP(WS_XB); const float* norm2_g = KA()->in[7]; const float* modl = MODL(); bf16* HM = (bf16*)WSP(WS_HM);
        for (int it = gw; it < M / 8; it += NGW) {
            const int row0 = it * 8, b = batch_of_tile(row0 >> 8);
            const float* mb = modl + (size_t)b * (NMOD * D) + 3 * D;
            norm_chunk_b(XB + (size_t)row0 * D, HM + (size_t)row0 * D, norm2_g + l * D, mb, mb + D, lane);
        } }
        GRID_BAR();
        for (int rep_ = 0; rep_ < REP_W1; ++rep_) { pg8::GemmDesc g = pg8::plain_gemm(WSP(WS_HM), WSP(WS_W1), D, D, D, M / 256); pg8::StaticOrder S; S.init(M / 256, FF / 256, G, (int)blockIdx.x);
          pg8::EpiBf16<1> E{(bf16*)WSP(WS_R), FF, KA()->in[13] + (size_t)l * FF, 0};
          pg8::gemm_phase<pg8::EpiBf16<1>, pg8::StaticOrder, PG8_ALIGN, PG8_SP2>(lds, g, S, E); }
        GRID_BAR();
#ifdef PROBE_W2
        { pg8::GemmDesc g = pg8::plain_gemm(WSP(WS_R), WSP(WS_W2), FF, FF, FF, M / 256); pg8::StaticOrder S; S.init(M / 256, D / 256, G, (int)blockIdx.x);
          pg8::EpiBf16<0> E{(bf16*)WSP(WS_END), D, nullptr, 0};
          pg8::gemm_phase<pg8::EpiBf16<0>, pg8::StaticOrder, PG8_ALIGN, PG8_SP2>(lds, g, S, E); }
#endif
        { pg8::GemmDesc g = pg8::plain_gemm(WSP(WS_R), WSP(WS_W2), FF, FF, FF, M / 256); pg8::StaticOrder S; S.init(M / 256, D / 256, G, (int)blockIdx.x);
          pg8::EpiRes E{nullptr, nullptr, (bf16*)WSP(WS_XB), KA()->in[15] + (size_t)l * D, MODL() + 5 * D};
          pg8::gemm_phase<pg8::EpiRes, pg8::StaticOrder, PG8_ALIGN, PG8_SP2>(lds, g, S, E); }
        GRID_BAR();
    }
    FRESH_TID(tid_); const int lane = tid_ & 63; float* yout = KA()->out; const bf16* XB = (const bf16*)WSP(WS_XB); const float* final_g = KA()->in[16];
    for (int m = gw; m < M; m += NGW) {
        const GAS v4u* xr = (const GAS v4u*)(XB + (size_t)m * D) + lane;
        f32x4 v[4][2]; float ss = 0.f;
#pragma unroll
        for (int j = 0; j < 4; ++j) { const v4u w = xr[64 * j];
            v[j][0] = (f32x4){bf_lo(w.x), bf_hi(w.x), bf_lo(w.y), bf_hi(w.y)}; v[j][1] = (f32x4){bf_lo(w.z), bf_hi(w.z), bf_lo(w.w), bf_hi(w.w)};
#pragma unroll
            for (int e = 0; e < 2; ++e) ss += (v[j][e].x * v[j][e].x + v[j][e].y * v[j][e].y) + (v[j][e].z * v[j][e].z + v[j][e].w * v[j][e].w); }
        const float rstd = 1.0f / sqrtf(wave_sum(ss) * (1.0f / D) + RMS_EPS);
#pragma unroll
        for (int j = 0; j < 4; ++j)
#pragma unroll
            for (int e = 0; e < 2; ++e) { const int col = 8 * lane + 512 * j + 4 * e; *(GAS f32x4*)(yout + (size_t)m * D + col) = (v[j][e] * rstd) * *(const f32x4*)(final_g + col); }
    }
}

extern "C" void kernel_launch(void* const* d_in, const int* in_sizes, int n_in, void* d_out, int out_size, void* d_ws, size_t ws_size, hipStream_t stream) {
    static int grid = 0;
    if (grid == 0) {
        if (n_in != 17 || out_size != M * D || ws_size < WS_END) { fprintf(stderr, "kernel_launch: unexpected shapes (n_in %d, out %d, ws %zu < %zu); nothing launched\n", n_in, out_size, ws_size, (size_t)WS_END); grid = -1; return; }
        int dev = 0, cus = 0, per_cu = 0;
        if (hipGetDevice(&dev) != hipSuccess || hipDeviceGetAttribute(&cus, hipDeviceAttributeMultiprocessorCount, dev) != hipSuccess) { grid = -1; return; }
        if (hipFuncSetAttribute((const void*)fwd, hipFuncAttributeMaxDynamicSharedMemorySize, LDS_BYTES) != hipSuccess) { fprintf(stderr, "kernel_launch: hipFuncSetAttribute failed\n"); grid = -1; return; }
        if (hipOccupancyMaxActiveBlocksPerMultiprocessor(&per_cu, (const void*)fwd, NWAVES * 64, LDS_BYTES) != hipSuccess || per_cu < 1)
            fprintf(stderr, "kernel_launch: note: occupancy query reports %d workgroups per CU\n", per_cu);
        (void)hipGetLastError();
        grid = cus;
    }
    if (grid < 0) return;
    if (hipMemsetAsync((char*)d_ws + WS_CTL, 0, CTL_ZERO_BYTES, stream) != hipSuccess) { fprintf(stderr, "kernel_launch: hipMemsetAsync failed\n"); return; }
    Args a{};
    for (int i = 0; i < 17; ++i) a.in[i] = (const float*)d_in[i];
    a.out = (float*)d_out; a.ws = (unsigned char*)d_ws;
    hipLaunchKernelGGL(fwd, dim3(grid), dim3(NWAVES * 64), LDS_BYTES, stream, a);
    const hipError_t le = hipPeekAtLastError();
    if (le != hipSuccess) fprintf(stderr, "kernel_launch: launch failed: %s\n", hipGetErrorName(le));
}
```

```cpp
#include <hip/hip_runtime.h>
#include <cstdio>
#include <cstdint>

namespace pg8 {
#define PG8_LAS __attribute__((address_space(3)))
typedef unsigned short bf16_t;
typedef short bf16x8 __attribute__((ext_vector_type(8)));
typedef float f32x4 __attribute__((ext_vector_type(4)));
typedef float f32x2 __attribute__((ext_vector_type(2)));
typedef unsigned u32x4 __attribute__((ext_vector_type(4)));
constexpr int BM = 256, BK = 64, HALF = 128, HTB = HALF * BK * 2  , STAGE_BYTES = 8 * HTB, NXCD = 8, WGM = 8;

__host__ __device__ __forceinline__ int lds_byte(int r, int c) { const int st = (r >> 4) * 2 + (c >> 5), rr = r & 15, cc = c & 31, ob = rr * 64 + cc * 2; return st * 1024 + (ob ^ (((ob >> 9) & 1) << 5)); }
__host__ __device__ __forceinline__ void stage_rc(int b, int& R, int& C) { const int st = b / 1024, sb = b % 1024, swz = sb ^ (((sb >> 9) & 1) << 5); R = (st >> 1) * 16 + swz / 64; C = (st & 1) * 32 + (swz % 64) / 2; }
__host__ __device__ __forceinline__ int perm32(int rho) { const int n = rho >> 4, i = rho & 15; return 8 * (i >> 2) + 4 * n + (i & 3); }

struct Unit { int pm, pn; };

struct GemmDesc {
    const char* A; const char* B;
    int lda, ldb, K;
    int nMb, zdiv, pdiv;
    long long sA1, sA2, sB1, sB2;
    long long pB1, pB2;
    __device__ __forceinline__ const char* aptr(const Unit& u) const { const int z = u.pm / nMb, pml = u.pm - z * nMb, z1 = z / zdiv, z2 = z - z1 * zdiv; return A + (long long)pml * (512ll * lda) + z1 * sA1 + z2 * sA2; }
    __device__ __forceinline__ const char* bptr(const Unit& u) const { const int z = u.pm / nMb, z1 = z / zdiv, z2 = z - z1 * zdiv, p1 = u.pn / pdiv, p2 = u.pn - p1 * pdiv; return B + p1 * pB1 + p2 * pB2 + z1 * sB1 + z2 * sB2; }
};
__device__ __forceinline__ GemmDesc plain_gemm(const void* A, const void* B, int lda, int ldb, int K, int nM) { return GemmDesc{(const char*)A, (const char*)B, lda, ldb, K, nM, 1, 1, 0, 0, 0, 0, 512ll * ldb, 0}; }

struct StaticOrder {
    int nM, nN, nwg, G, c;
    __host__ __device__ void init(int nM_, int nN_, int G_, int c_) { nM = nM_; nN = nN_; nwg = nM * nN; G = G_; c = c_; }
    __host__ __device__ bool next(int i, Unit& u) const {
        const long L = (long)i * G + c; if (L >= nwg) return false;
        int wgid = (int)L; { const int q = nwg / NXCD, r = nwg % NXCD, xcd = wgid % NXCD, off = wgid / NXCD; wgid = (xcd < r ? xcd * (q + 1) : r * (q + 1) + (xcd - r) * q) + off; }
        const int nig = WGM * nN, gid = wgid / nig, fm = gid * WGM, gsz = (nM - fm) < WGM ? (nM - fm) : WGM;
        u.pm = fm + ((wgid % nig) % gsz); u.pn = (wgid % nig) / gsz; return true;
    }
    __device__ __forceinline__ void a_ready(const Unit&) const {}
    __device__ __forceinline__ void done(const Unit&) const {}
#ifndef PG8_KROT
#define PG8_KROT 1
#endif
    __device__ __forceinline__ int krot(int nt) const { return PG8_KROT ? 2 * (((c & 7) * (nt >> 1)) >> 3) : 0; }
};

__device__ __forceinline__ unsigned cvt_pk_bf16(float lo, float hi) { unsigned r; asm volatile("v_cvt_pk_bf16_f32 %0, %1, %2" : "=v"(r) : "v"(lo), "v"(hi)); return r; }

template <class Epi, class Sched, bool ALIGN_EPI = false, bool SP2 = false>
__device__ __forceinline__ void gemm_phase(PG8_LAS unsigned char* lds, const GemmDesc g, const Sched& S, const Epi& E) {
    int tid_ = threadIdx.x; asm volatile("" : "+v"(tid_));
    const int tid = tid_, wid = __builtin_amdgcn_readfirstlane(tid >> 6), lane = tid & 63, wr = wid >> 2, wc = wid & 3, fr = lane & 15, fq = lane >> 4;
    const int K = g.K, nt = K / BK;
    unsigned voffA[2], voffB[2];
#pragma unroll
    for (int i = 0; i < 2; ++i) { int R, C; stage_rc(tid * 16 + i * 8192, R, C); const int Rb = Epi::PERM ? ((R & ~31) + perm32(R & 31)) : R;
        voffA[i] = (unsigned)(R * g.lda + C) * 2u; voffB[i] = (unsigned)(Rb * g.ldb + C) * 2u; }
    const size_t kstep = (size_t)(BK * 2);
    const size_t hA = (size_t)HALF * g.lda * 2, hB = (size_t)HALF * g.ldb * 2;
    const unsigned ldsw = (unsigned)wid * 1024u;
    const int aoff = lds_byte(wr * 64 + fr, fq * 8), boff = lds_byte(wc * 32 + fr, fq * 8);
#define PG8_SA(b, h) (((b) * 2 + (h)) * HTB)
#define PG8_SB(b, h) ((4 + (b) * 2 + (h)) * HTB)
#define PG8_STAGE(bufoff, gbase, voff) do { _Pragma("unroll") for (int _i = 0; _i < 2; ++_i) \
        __builtin_amdgcn_global_load_lds((const unsigned*)((const char*)(gbase) + (voff)[_i]), (PG8_LAS unsigned*)(lds + (bufoff) + ldsw + _i * 8192), 16, 0, 0); } while (0)
#define PG8_LDA(dst, b, h) do { _Pragma("unroll") for (int m = 0; m < 4; ++m) _Pragma("unroll") for (int k = 0; k < 2; ++k) dst[m][k] = *(const PG8_LAS bf16x8*)(lds + PG8_SA(b, h) + aoff + m * 2048 + k * 1024); } while (0)
#define PG8_LDB(dst, b, h) do { _Pragma("unroll") for (int n = 0; n < 2; ++n) _Pragma("unroll") for (int k = 0; k < 2; ++k) dst[n][k] = *(const PG8_LAS bf16x8*)(lds + PG8_SB(b, h) + boff + n * 2048 + k * 1024); } while (0)
#define PG8_MMA(ai, bj, At, Bt) do { __builtin_amdgcn_s_setprio(1); _Pragma("unroll") for (int m = 0; m < 4; ++m) _Pragma("unroll") for (int n = 0; n < 2; ++n) _Pragma("unroll") for (int k = 0; k < 2; ++k) \
        acc[ai][bj][m][n] = __builtin_amdgcn_mfma_f32_16x16x32_bf16(Bt[n][k], At[m][k], acc[ai][bj][m][n], 0, 0, 0); __builtin_amdgcn_s_setprio(0); } while (0)
#define PG8_WAIT_V(n) asm volatile("s_waitcnt vmcnt(" #n ")" ::: "memory")
#define PG8_WAIT_L(n) asm volatile("s_waitcnt lgkmcnt(" #n ")" ::: "memory")
#define PG8_BAR __builtin_amdgcn_s_barrier()
#define PG8_SCHED __builtin_amdgcn_sched_barrier(0)
    Unit cur, nxt; int ui = 0;
    if (!S.next(0, cur)) return;
    f32x4 acc[2][2][4][2];
#pragma unroll
    for (int a = 0; a < 2; ++a)
#pragma unroll
        for (int b = 0; b < 2; ++b)
#pragma unroll
            for (int m = 0; m < 4; ++m)
#pragma unroll
                for (int n = 0; n < 2; ++n) acc[a][b][m][n] = (f32x4){0.f, 0.f, 0.f, 0.f};
    bf16x8 At[4][2], B0[2][2], B1[2][2];
    const char* cA = g.aptr(cur); const char* cB = g.bptr(cur);
    const int r0 = S.krot(nt); const size_t roff = (size_t)r0 * kstep;
    S.a_ready(cur);
    if constexpr (SP2) {
        PG8_STAGE(PG8_SB(0, 0), cB + roff, voffB); PG8_STAGE(PG8_SB(0, 1), cB + roff + hB, voffB); PG8_STAGE(PG8_SA(0, 0), cA + roff, voffA); PG8_STAGE(PG8_SA(0, 1), cA + roff + hA, voffA);
        if (wr == 1) PG8_BAR;
        PG8_WAIT_V(2); PG8_BAR;
        PG8_STAGE(PG8_SB(1, 0), cB + roff + kstep, voffB); PG8_STAGE(PG8_SA(1, 0), cA + roff + kstep, voffA); PG8_STAGE(PG8_SB(1, 1), cB + roff + hB + kstep, voffB);
        PG8_WAIT_V(6); PG8_BAR;
    } else {
        PG8_STAGE(PG8_SB(0, 0), cB + roff, voffB); PG8_STAGE(PG8_SA(0, 0), cA + roff, voffA); PG8_STAGE(PG8_SB(0, 1), cB + roff + hB, voffB); PG8_STAGE(PG8_SA(0, 1), cA + roff + hA, voffA);
        if (wr == 1) PG8_BAR;
        PG8_WAIT_V(4); PG8_BAR;
        PG8_STAGE(PG8_SB(1, 0), cB + roff + kstep, voffB); PG8_STAGE(PG8_SA(1, 0), cA + roff + kstep, voffA); PG8_STAGE(PG8_SB(1, 1), cB + roff + hB + kstep, voffB);
        PG8_WAIT_V(6); PG8_BAR;
    }
    for (;;) {
        const bool has_next = S.next(ui + 1, nxt);
        const char* nA = has_next ? g.aptr(nxt) : cA; const char* nB = has_next ? g.bptr(nxt) : cB;
        for (int t = 0; t < nt; t += 2) {
            const bool last = (t == nt - 2);
            int tt = t + r0; if (tt >= nt) tt -= nt; int tt2 = tt + 2; if (tt2 >= nt) tt2 -= nt;
            const char* a1 = cA + (size_t)(tt + 1) * kstep;
            const char* a2 = last ? nA + roff : cA + (size_t)tt2 * kstep; const char* b2 = last ? nB + roff : cB + (size_t)tt2 * kstep;
            const char* a3 = a2 + kstep; const char* b3 = b2 + kstep;
            if (last && has_next) S.a_ready(nxt);
            if constexpr (SP2) {
            PG8_LDB(B0, 0, 0); PG8_LDB(B1, 0, 1); PG8_SCHED; PG8_LDA(At, 0, 0); PG8_STAGE(PG8_SA(1, 1), a1 + hA, voffA);
            PG8_WAIT_V(8); PG8_WAIT_L(0); PG8_BAR; PG8_MMA(0, 0, At, B0); PG8_MMA(0, 1, At, B1); PG8_BAR; PG8_SCHED;
            PG8_LDA(At, 0, 1); PG8_STAGE(PG8_SB(0, 0), b2, voffB); PG8_STAGE(PG8_SB(0, 1), b2 + hB, voffB); PG8_STAGE(PG8_SA(0, 0), a2, voffA);
            PG8_WAIT_V(8); PG8_WAIT_L(0); PG8_BAR; PG8_MMA(1, 0, At, B0); PG8_MMA(1, 1, At, B1); PG8_BAR; PG8_SCHED;
            PG8_LDB(B0, 1, 0); PG8_LDB(B1, 1, 1); PG8_SCHED; PG8_LDA(At, 1, 0); PG8_STAGE(PG8_SA(0, 1), a2 + hA, voffA);
            PG8_WAIT_V(8); PG8_WAIT_L(0); PG8_BAR; PG8_MMA(0, 0, At, B0); PG8_MMA(0, 1, At, B1); PG8_BAR; PG8_SCHED;
            PG8_LDA(At, 1, 1); PG8_STAGE(PG8_SB(1, 0), b3, voffB); PG8_STAGE(PG8_SB(1, 1), b3 + hB, voffB); PG8_STAGE(PG8_SA(1, 0), a3, voffA);
            PG8_WAIT_V(8); PG8_WAIT_L(0); PG8_BAR; PG8_MMA(1, 0, At, B0); PG8_MMA(1, 1, At, B1); PG8_BAR; PG8_SCHED;
            } else {
            PG8_LDB(B0, 0, 0); PG8_SCHED; PG8_LDA(At, 0, 0); PG8_STAGE(PG8_SA(1, 1), a1 + hA, voffA);
            PG8_WAIT_L(8); PG8_BAR; PG8_WAIT_L(0); PG8_MMA(0, 0, At, B0); PG8_BAR; PG8_SCHED;
            PG8_LDB(B1, 0, 1); PG8_STAGE(PG8_SB(0, 0), b2, voffB);
            PG8_BAR; PG8_WAIT_L(0); PG8_MMA(0, 1, At, B1); PG8_BAR;
            PG8_LDA(At, 0, 1); PG8_STAGE(PG8_SA(0, 0), a2, voffA);
            PG8_BAR; PG8_WAIT_L(0); PG8_MMA(1, 0, At, B0); PG8_BAR; PG8_SCHED;
            PG8_STAGE(PG8_SB(0, 1), b2 + hB, voffB);
            PG8_WAIT_V(6); PG8_BAR; PG8_MMA(1, 1, At, B1); PG8_BAR;
            PG8_LDB(B0, 1, 0); PG8_SCHED; PG8_LDA(At, 1, 0); PG8_STAGE(PG8_SA(0, 1), a2 + hA, voffA);
            PG8_WAIT_L(8); PG8_BAR; PG8_WAIT_L(0); PG8_MMA(0, 0, At, B0); PG8_BAR; PG8_SCHED;
            PG8_LDB(B1, 1, 1); PG8_STAGE(PG8_SB(1, 0), b3, voffB);
            PG8_BAR; PG8_WAIT_L(0); PG8_MMA(0, 1, At, B1); PG8_BAR;
            PG8_LDA(At, 1, 1); PG8_STAGE(PG8_SA(1, 0), a3, voffA);
            PG8_BAR; PG8_WAIT_L(0); PG8_MMA(1, 0, At, B0); PG8_BAR; PG8_SCHED;
            PG8_STAGE(PG8_SB(1, 1), b3 + hB, voffB);
            PG8_WAIT_V(6); PG8_BAR; PG8_MMA(1, 1, At, B1); PG8_BAR;
            }
        }
        if constexpr (ALIGN_EPI) { if (wr == 0) PG8_BAR; }
        if constexpr (!Epi::AFTER_DRAIN) { E(acc, cur, wr, wc, fr, fq); S.done(cur); }
        if (!has_next) break;
#pragma unroll
        for (int a = 0; a < 2; ++a)
#pragma unroll
            for (int b = 0; b < 2; ++b)
#pragma unroll
                for (int m = 0; m < 4; ++m)
#pragma unroll
                    for (int n = 0; n < 2; ++n) acc[a][b][m][n] = (f32x4){0.f, 0.f, 0.f, 0.f};
        cur = nxt; cA = nA; cB = nB; ++ui;
        if constexpr (ALIGN_EPI) { if (wr == 1) PG8_BAR; }
    }
    PG8_WAIT_V(0);
    if constexpr (!ALIGN_EPI) { if (wr == 0) PG8_BAR; }
    PG8_BAR;
    if constexpr (Epi::AFTER_DRAIN) { E.fused(acc, cur, wr, wc, fr, fq, lds, wid, lane); S.done(cur); }
#undef PG8_SA
#undef PG8_SB
#undef PG8_STAGE
#undef PG8_LDA
#undef PG8_LDB
#undef PG8_MMA
#undef PG8_WAIT_V
#undef PG8_WAIT_L
#undef PG8_BAR
#undef PG8_SCHED
}
}

constexpr int D = 2048, SEQP = 8192, SEQS = 2048, NBP = 2, NBS = 16, NB = NBP + NBS;
constexpr int MP = NBP * SEQP, MS = NBS * SEQS, M = MP + MS;
constexpr int NH = 18, HD = 128, AW = NH * HD, QKVW = 3 * AW, FF = 4 * D, DEPTH = 4, NMOD = 6;
constexpr float RMS_EPS = 1e-6f, LOG2E = 1.4426950408889634f, LN2 = 0.6931471805599453f;
constexpr int NWAVES = 8;

constexpr size_t MiB = 1u << 20;
constexpr size_t WS_CTL = 0, CTL_ZERO_BYTES = 1 * MiB;
constexpr size_t WS_MOD = 1 * MiB;
constexpr size_t WS_CACT = 5 * MiB;
constexpr size_t WS_LSE = 6 * MiB;
constexpr size_t WS_FC = 10 * MiB;
constexpr size_t WS_G = 11 * MiB;
constexpr size_t WS_W = 12 * MiB;
constexpr size_t WS_WQKV = WS_W, WS_WF = WS_W, WS_WO = WS_W + 27 * MiB, WS_W1 = WS_W + 36 * MiB, WS_W2 = WS_W + 68 * MiB;
constexpr size_t WS_HM = 112 * MiB;
constexpr size_t WS_R = 328 * MiB;
constexpr size_t WS_AO = WS_R + 384 * MiB;
constexpr size_t WS_MODP = WS_AO;
constexpr size_t WS_XB = 1096 * MiB;
constexpr size_t WS_END = 1288 * MiB;
static_assert(WS_W2 + (size_t)D * FF * 2 <= WS_HM && WS_HM + (size_t)M * AW * 2 <= WS_R && WS_R + (size_t)M * FF * 2 <= WS_XB && WS_XB + (size_t)M * D * 2 <= WS_END, "d_ws map");
static_assert((size_t)3 * NH * M * HD * 2 <= WS_XB - WS_R && (size_t)M * 2 * D * 2 <= WS_AO - WS_R && WS_AO + (size_t)M * 2 * D * 2 <= WS_XB, "d_ws map (R)");
constexpr int CW_BAR = 4096;

constexpr int RING_BYTES = 131072;
constexpr int LDS_BYTES = 147456;
constexpr int LDSCTL_OFF = LDS_BYTES - 512, MISC_OFF = LDSCTL_OFF + 320;
constexpr int SCR2_OFF = 65536, SCR2_STRIDE = 8448;
static_assert(SCR2_OFF + 8 * SCR2_STRIDE <= LDSCTL_OFF, "LDS map");

#define GAS __attribute__((address_space(1)))
#define LAS __attribute__((address_space(3)))
typedef unsigned short bf16;
typedef unsigned v4u __attribute__((ext_vector_type(4)));
typedef unsigned v2u __attribute__((ext_vector_type(2)));
typedef float f32x4 __attribute__((ext_vector_type(4)));
typedef float f32x2 __attribute__((ext_vector_type(2)));
typedef float f32x16 __attribute__((ext_vector_type(16)));
typedef short bf16x8 __attribute__((ext_vector_type(8)));
typedef short s16x4 __attribute__((ext_vector_type(4)));
typedef __bf16 bf16x2_t __attribute__((ext_vector_type(2)));
#define LDS_WAIT() asm volatile("s_waitcnt lgkmcnt(0)" ::: "memory")
__device__ __forceinline__ unsigned pk2(float lo, float hi) { f32x2 v = {lo, hi}; bf16x2_t b = __builtin_convertvector(v, bf16x2_t); return __builtin_bit_cast(unsigned, b); }
__device__ __forceinline__ float bf_lo(unsigned w) { return __builtin_bit_cast(float, w << 16); }
__device__ __forceinline__ float bf_hi(unsigned w) { return __builtin_bit_cast(float, w & 0xffff0000u); }
__device__ __forceinline__ float wave_sum(float v) {
#pragma unroll
    for (int o = 1; o < 64; o <<= 1) v += __shfl_xor(v, o);
    return v;
}
__device__ __forceinline__ int batch_of_tile(int pm) { return pm < 64 ? (pm >> 5) : 2 + ((pm - 64) >> 3); }

namespace pg8 {
#ifndef PG8_NT
#define PG8_NT 0
#endif
#if PG8_NT
#define PG8_ST_STREAM(p, v) __builtin_nontemporal_store((v), (p))
#else
#define PG8_ST_STREAM(p, v) (*(p) = (v))
#endif
struct EpiQKV {
    static constexpr bool PERM = true, AFTER_DRAIN = false;
    bf16_t* O; float qscale;
    __device__ __forceinline__ void operator()(const f32x4 (&acc)[2][2][4][2], const Unit& u, int wr, int wc, int fr, int fq) const {
        const int g = u.pn / 9, j = u.pn - 9 * g, which = j / 3, hp = (j - 3 * which) * 2, sh = 2 * g;
        int sstart, t0, lsh;
        if (u.pm < 64) { sstart = (u.pm >> 5) * SEQP; t0 = (u.pm & 31) * 256; lsh = 13 - sh; } else { const int q = u.pm - 64; sstart = MP + (q >> 3) * SEQS; t0 = (q & 7) * 256; lsh = 11 - sh; }
        const float sc = which == 0 ? qscale : 1.f;
#pragma unroll
        for (int ai = 0; ai < 2; ++ai)
#pragma unroll
            for (int m = 0; m < 4; ++m) { const int t = t0 + ai * HALF + wr * 64 + m * 16 + fr, prow = sstart + ((t & ((1 << sh) - 1)) << lsh) + (t >> sh);
#pragma unroll
                for (int bj = 0; bj < 2; ++bj) { const int head = g * 6 + hp + bj;
                    bf16_t* dst = O + ((size_t)(which * NH + head) * M + prow) * HD + wc * 32 + 8 * fq;
                    const f32x4 v0 = acc[ai][bj][m][0] * sc, v1 = acc[ai][bj][m][1] * sc;
                    u32x4 w; w.x = cvt_pk_bf16(v0[0], v0[1]); w.y = cvt_pk_bf16(v0[2], v0[3]); w.z = cvt_pk_bf16(v1[0], v1[1]); w.w = cvt_pk_bf16(v1[2], v1[3]);
                    PG8_ST_STREAM((u32x4*)dst, w); } }
    }
};
struct EpiRes {
    static constexpr bool PERM = true, AFTER_DRAIN = false;
    const float* xin_p; const float* xin_s; bf16_t* xb; const float* bias; const float* gate;
    __device__ __forceinline__ void operator()(const f32x4 (&acc)[2][2][4][2], const Unit& u, int wr, int wc, int fr, int fq) const {
        const int b = batch_of_tile(u.pm), col0 = u.pn * BM + wc * 32 + 8 * fq, row0 = u.pm * BM + wr * 64 + fr;
        const float* gp = gate + (size_t)b * (NMOD * D) + col0;
        f32x4 gv[2][2], bv[2][2];
#pragma unroll
        for (int bj = 0; bj < 2; ++bj)
#pragma unroll
            for (int n = 0; n < 2; ++n) { gv[bj][n] = *(const f32x4*)(gp + bj * HALF + 4 * n); bv[bj][n] = bias ? *(const f32x4*)(bias + col0 + bj * HALF + 4 * n) : (f32x4){0.f, 0.f, 0.f, 0.f}; }
#pragma unroll
        for (int ai = 0; ai < 2; ++ai) {
            if (xin_p) {
#pragma unroll
                for (int mh = 0; mh < 4; mh += 2) {
                    f32x4 xf[2][2][2];
#pragma unroll
                    for (int m = 0; m < 2; ++m) { const int row = row0 + ai * HALF + (mh + m) * 16; const float* xi = (row < MP ? xin_p + (size_t)row * D : xin_s + (size_t)(row - MP) * D) + col0;
#pragma unroll
                        for (int bj = 0; bj < 2; ++bj) { xf[m][bj][0] = *(const f32x4*)(xi + bj * HALF); xf[m][bj][1] = *(const f32x4*)(xi + bj * HALF + 4); } }
#pragma unroll
                    for (int m = 0; m < 2; ++m) { bf16_t* xo = xb + (size_t)(row0 + ai * HALF + (mh + m) * 16) * D + col0;
#pragma unroll
                        for (int bj = 0; bj < 2; ++bj) { const f32x4 v0 = xf[m][bj][0] + gv[bj][0] * (acc[ai][bj][mh + m][0] + bv[bj][0]), v1 = xf[m][bj][1] + gv[bj][1] * (acc[ai][bj][mh + m][1] + bv[bj][1]);
                            u32x4 o; o.x = cvt_pk_bf16(v0[0], v0[1]); o.y = cvt_pk_bf16(v0[2], v0[3]); o.z = cvt_pk_bf16(v1[0], v1[1]); o.w = cvt_pk_bf16(v1[2], v1[3]);
                            *(u32x4*)(xo + bj * HALF) = o; } }
                }
            } else {
                u32x4 xw[4][2];
#pragma unroll
                for (int m = 0; m < 4; ++m) { const bf16_t* xi = xb + (size_t)(row0 + ai * HALF + m * 16) * D + col0;
#pragma unroll
                    for (int bj = 0; bj < 2; ++bj) xw[m][bj] = *(const u32x4*)(xi + bj * HALF); }
#pragma unroll
                for (int m = 0; m < 4; ++m) { bf16_t* xo = xb + (size_t)(row0 + ai * HALF + m * 16) * D + col0;
#pragma unroll
                    for (int bj = 0; bj < 2; ++bj) { const u32x4 w = xw[m][bj];
                        const f32x4 x0 = {__builtin_bit_cast(float, w.x << 16), __builtin_bit_cast(float, w.x & 0xffff0000u), __builtin_bit_cast(float, w.y << 16), __builtin_bit_cast(float, w.y & 0xffff0000u)};
                        const f32x4 x1 = {__builtin_bit_cast(float, w.z << 16), __builtin_bit_cast(float, w.z & 0xffff0000u), __builtin_bit_cast(float, w.w << 16), __builtin_bit_cast(float, w.w & 0xffff0000u)};
                        const f32x4 v0 = x0 + gv[bj][0] * (acc[ai][bj][m][0] + bv[bj][0]), v1 = x1 + gv[bj][1] * (acc[ai][bj][m][1] + bv[bj][1]);
                        u32x4 o; o.x = cvt_pk_bf16(v0[0], v0[1]); o.y = cvt_pk_bf16(v0[2], v0[3]); o.z = cvt_pk_bf16(v1[0], v1[1]); o.w = cvt_pk_bf16(v1[2], v1[3]);
                        *(u32x4*)(xo + bj * HALF) = o; } }
            }
        }
    }
};
template <int ACT> struct EpiBf16 {
    static constexpr bool PERM = true, AFTER_DRAIN = false;
    bf16_t* O; int ldc; const float* bias; int row_base;
    __device__ __forceinline__ void operator()(const f32x4 (&acc)[2][2][4][2], const Unit& u, int wr, int wc, int fr, int fq) const {
        const int row0 = row_base + u.pm * BM + wr * 64 + fr, col0 = u.pn * BM + wc * 32 + 8 * fq;
        f32x4 bv[2][2];
#pragma unroll
        for (int bj = 0; bj < 2; ++bj)
#pragma unroll
            for (int n = 0; n < 2; ++n) bv[bj][n] = bias ? *(const f32x4*)(bias + col0 + bj * HALF + 4 * n) : (f32x4){0.f, 0.f, 0.f, 0.f};
#pragma unroll
        for (int ai = 0; ai < 2; ++ai)
#pragma unroll
            for (int m = 0; m < 4; ++m) { bf16_t* rowp = O + (size_t)(row0 + ai * HALF + m * 16) * ldc + col0;
#pragma unroll
                for (int bj = 0; bj < 2; ++bj) { f32x4 v0 = acc[ai][bj][m][0] + bv[bj][0], v1 = acc[ai][bj][m][1] + bv[bj][1];
                    if (ACT == 1) {
#pragma unroll
                        for (int e = 0; e < 4; ++e) { const float a = fmaxf(v0[e], 0.f), b = fmaxf(v1[e], 0.f); v0[e] = a * a; v1[e] = b * b; } }
                    u32x4 w; w.x = cvt_pk_bf16(v0[0], v0[1]); w.y = cvt_pk_bf16(v0[2], v0[3]); w.z = cvt_pk_bf16(v1[0], v1[1]); w.w = cvt_pk_bf16(v1[2], v1[3]);
                    PG8_ST_STREAM((u32x4*)(rowp + bj * HALF), w); } }
    }
};
struct EpiZT {
    static constexpr bool PERM = true, AFTER_DRAIN = false;
    bf16_t* ZT; int seq0, S, N2;
    __device__ __forceinline__ void operator()(const f32x4 (&acc)[2][2][4][2], const Unit& u, int wr, int wc, int fr, int fq) const {
        const int part = u.pm & 1, z = u.pm >> 1, b = z >> 3, g = z & 7;
        bf16_t* base = ZT + (size_t)4096 * (seq0 + b * S) + ((size_t)(g * 256 + wr * 64 + fr) * N2 + u.pn) * 512 + part * 256 + wc * 32 + 8 * fq;
#pragma unroll
        for (int ai = 0; ai < 2; ++ai)
#pragma unroll
            for (int m = 0; m < 4; ++m) { bf16_t* rowp = base + (size_t)(ai * HALF + m * 16) * N2 * 512;
#pragma unroll
                for (int bj = 0; bj < 2; ++bj) { const f32x4 v0 = acc[ai][bj][m][0], v1 = acc[ai][bj][m][1];
                    u32x4 w; w.x = cvt_pk_bf16(v0[0], v0[1]); w.y = cvt_pk_bf16(v0[2], v0[3]); w.z = cvt_pk_bf16(v1[0], v1[1]); w.w = cvt_pk_bf16(v1[2], v1[3]);
                    PG8_ST_STREAM((u32x4*)(rowp + bj * HALF), w); } }
    }
};
struct EpiAO {
    static constexpr bool PERM = true, AFTER_DRAIN = false;
    bf16_t* AO; int seq0, S, N2;
    __device__ __forceinline__ void operator()(const f32x4 (&acc)[2][2][4][2], const Unit& u, int wr, int wc, int fr, int fq) const {
        const int part = u.pm & 1, b = u.pm >> 1, n2 = u.pn >> 3, cb = u.pn & 7;
        bf16_t* base = AO + (size_t)4096 * (seq0 + b * S) + ((size_t)(part * 256 + wr * 64 + fr) * N2 + n2) * 2048 + cb * 256 + wc * 32 + 8 * fq;
#pragma unroll
        for (int ai = 0; ai < 2; ++ai)
#pragma unroll
            for (int m = 0; m < 4; ++m) { bf16_t* rowp = base + (size_t)(ai * HALF + m * 16) * N2 * 2048;
#pragma unroll
                for (int bj = 0; bj < 2; ++bj) { const f32x4 v0 = acc[ai][bj][m][0], v1 = acc[ai][bj][m][1];
                    u32x4 w; w.x = cvt_pk_bf16(v0[0], v0[1]); w.y = cvt_pk_bf16(v0[2], v0[3]); w.z = cvt_pk_bf16(v1[0], v1[1]); w.w = cvt_pk_bf16(v1[2], v1[3]);
                    PG8_ST_STREAM((u32x4*)(rowp + bj * HALF), w); } }
    }
};
}

#ifndef PG8_SP2
#define PG8_SP2 true
#endif
#ifndef PG8_ALIGN
#define PG8_ALIGN true
#endif

#define XB_TMO      128
#define XB_XCNT(j)  (256  + 64 * (j))
#define XB_XSUB(j)  (1280 + 64 * (j))
#define XB_XGEN(j)  (2304 + 64 * (j))
#define XB_TOP      3328
#define XB_TOPGEN   3392
#define XCD_BAR_WORDS 3456
#define XB_SPIN_CAP (1u << 18)

__device__ __forceinline__ unsigned xb_ld(unsigned* p)              { return __hip_atomic_load(p, __ATOMIC_RELAXED, __HIP_MEMORY_SCOPE_AGENT); }
__device__ __forceinline__ unsigned xb_add(unsigned* p, unsigned v) { return __hip_atomic_fetch_add(p, v, __ATOMIC_RELAXED, __HIP_MEMORY_SCOPE_AGENT); }
__device__ __forceinline__ unsigned xb_xcc_id() { return (unsigned)__builtin_amdgcn_s_getreg((3 << 11) | 20) & 0xFu; }
#define XB_SPIN(cond, bar) do { unsigned _sp = 0; while (cond) { __builtin_amdgcn_s_sleep(1); \
    if ((++_sp & 255u) == 0u) { if (xb_ld(&(bar)[XB_TMO])) break; if (_sp > XB_SPIN_CAP) { atomicAdd(&(bar)[XB_TMO], 1u); break; } } } } while (0)

struct XcdBarrier {
    unsigned* bar; unsigned x;
    volatile LAS unsigned* st;
};

__device__ __forceinline__ XcdBarrier xcd_barrier_post(unsigned* bar, volatile LAS unsigned* st) {
    XcdBarrier b; b.bar = bar; b.x = xb_xcc_id(); b.st = st;
    if (threadIdx.x == 0) (void)xb_add(&bar[XB_XCNT(b.x)], 1u);
    return b;
}
__device__ __forceinline__ void xcd_barrier_complete(unsigned* bar, unsigned x, unsigned& nloc, unsigned& nx) {
    const unsigned G = gridDim.x * gridDim.y * gridDim.z;
    unsigned sum, cnt, mine, sp = 0u;
    for (;;) {
        sum = 0u; cnt = 0u; mine = 0u;
#pragma unroll
        for (unsigned j = 0; j < 16; ++j) { const unsigned c = xb_ld(&bar[XB_XCNT(j)]); sum += c; cnt += (c > 0u) ? 1u : 0u; mine = (j == x) ? c : mine; }
        if (sum == G) break;
        __builtin_amdgcn_s_sleep(1);
        if ((++sp & 255u) == 0u) { if (xb_ld(&bar[XB_TMO])) break; if (sp > XB_SPIN_CAP) { atomicAdd(&bar[XB_TMO], 1u); break; } }
    }
    nloc = mine > 0u ? mine : 1u; nx = cnt > 0u ? cnt : 1u;
}

__device__ __forceinline__ void xcd_barrier(const XcdBarrier& b) {
    asm volatile("s_waitcnt vmcnt(0)" ::: "memory");
    __syncthreads();
    if (threadIdx.x == 0) {
        unsigned* bar = b.bar;
        __builtin_amdgcn_s_waitcnt(0);
        unsigned nloc = b.st[0], nx = b.st[1];
        if (nloc == 0u) { xcd_barrier_complete(bar, b.x, nloc, nx); b.st[0] = nloc; b.st[1] = nx; }
        const unsigned old = xb_add(&bar[XB_XSUB(b.x)], 1u);
        const unsigned gen = old / nloc;
        if (old + 1u == (gen + 1u) * nloc) {
            __builtin_amdgcn_fence(__ATOMIC_RELEASE, "agent");
            asm volatile("s_waitcnt vmcnt(0)" ::: "memory");
            const unsigned og = xb_add(&bar[XB_TOP], 1u);
            const unsigned tg = og / nx;
            if (og + 1u == (tg + 1u) * nx) xb_add(&bar[XB_TOPGEN], 1u);
            else XB_SPIN(xb_ld(&bar[XB_TOPGEN]) == tg, bar);
            __builtin_amdgcn_fence(__ATOMIC_ACQUIRE, "agent");
            xb_add(&bar[XB_XGEN(b.x)], 1u);
            asm volatile("s_waitcnt vmcnt(0)" ::: "memory");
        } else {
            XB_SPIN(xb_ld(&bar[XB_XGEN(b.x)]) == gen, bar);
            __builtin_amdgcn_fence(__ATOMIC_ACQUIRE, "agent");
            asm volatile("s_waitcnt vmcnt(0)" ::: "memory");
        }
    }
    __syncthreads();
}


__device__ __forceinline__ void transpose_item(const float* W, int K, int N, bf16* WT, LAS float* scr, int item, int lane) {
    const int nblk = N / 32, kb = item / nblk, nb = item % nblk, k0 = 64 * kb, n0 = 32 * nb;
#pragma unroll 8
    for (int i = 0; i < 32; ++i) { const int kk = 2 * i + (lane >> 5); scr[kk * 33 + (lane & 31)] = W[(size_t)(k0 + kk) * N + n0 + (lane & 31)]; }
    LDS_WAIT(); asm volatile("" ::: "memory");
    const int c = lane & 7;
#pragma unroll
    for (int j = 0; j < 4; ++j) { const int n = (lane >> 3) + 8 * j; const LAS float* s = scr + (8 * c) * 33 + n;
        v4u o; o.x = pk2(s[0 * 33], s[1 * 33]); o.y = pk2(s[2 * 33], s[3 * 33]); o.z = pk2(s[4 * 33], s[5 * 33]); o.w = pk2(s[6 * 33], s[7 * 33]);
        *(GAS v4u*)(WT + (size_t)(n0 + n) * K + k0 + 8 * c) = o; }
    LDS_WAIT(); asm volatile("" ::: "memory");
}

__device__ __forceinline__ void norm_chunk(const float* xrow0, bf16* hrow0, const float* gain, const float* shift, const float* scale, int lane) {
    f32x4 A[8], B[8];
#pragma unroll
    for (int j = 0; j < 8; ++j) { const int col = 4 * lane + 256 * j; const f32x4 gn = *(const f32x4*)(gain + col), sc = *(const f32x4*)(scale + col); A[j] = gn * (sc + 1.0f); B[j] = *(const f32x4*)(shift + col); }
    for (int rr = 0; rr < 8; ++rr) {
        const GAS f32x4* xr = (const GAS f32x4*)(xrow0 + (size_t)rr * D) + lane;
        f32x4 v[8]; float ss = 0.f;
#pragma unroll
        for (int j = 0; j < 8; ++j) { v[j] = xr[64 * j]; ss += (v[j].x * v[j].x + v[j].y * v[j].y) + (v[j].z * v[j].z + v[j].w * v[j].w); }
        const float rstd = 1.0f / sqrtf(wave_sum(ss) * (1.0f / D) + RMS_EPS);
        GAS v2u* o8 = (GAS v2u*)(hrow0 + (size_t)rr * D) + lane;
#pragma unroll
        for (int j = 0; j < 8; ++j) { const f32x4 y = (v[j] * rstd) * A[j] + B[j]; v2u w; w.x = pk2(y.x, y.y); w.y = pk2(y.z, y.w); o8[64 * j] = w; }
    }
}

__device__ __forceinline__ void norm_chunk_b(const bf16* xrow0, bf16* hrow0, const float* gain, const float* shift, const float* scale, int lane) {
    f32x4 A[4][2], B[4][2];
#pragma unroll
    for (int j = 0; j < 4; ++j)
#pragma unroll
        for (int e = 0; e < 2; ++e) { const int col = 8 * lane + 512 * j + 4 * e; const f32x4 gn = *(const f32x4*)(gain + col), sc = *(const f32x4*)(scale + col); A[j][e] = gn * (sc + 1.0f); B[j][e] = *(const f32x4*)(shift + col); }
#pragma unroll 1
    for (int r4 = 0; r4 < 8; r4 += 4) {
        v4u w[4][4];
#pragma unroll
        for (int rr = 0; rr < 4; ++rr) { const GAS v4u* xr = (const GAS v4u*)(xrow0 + (size_t)(r4 + rr) * D) + lane;
#pragma unroll
            for (int j = 0; j < 4; ++j) w[rr][j] = xr[64 * j]; }
#pragma unroll
        for (int rr = 0; rr < 4; ++rr) {
            f32x4 v[4][2]; float ss = 0.f;
#pragma unroll
            for (int j = 0; j < 4; ++j) { const v4u q = w[rr][j];
                v[j][0] = (f32x4){bf_lo(q.x), bf_hi(q.x), bf_lo(q.y), bf_hi(q.y)}; v[j][1] = (f32x4){bf_lo(q.z), bf_hi(q.z), bf_lo(q.w), bf_hi(q.w)};
#pragma unroll
                for (int e = 0; e < 2; ++e) ss += (v[j][e].x * v[j][e].x + v[j][e].y * v[j][e].y) + (v[j][e].z * v[j][e].z + v[j][e].w * v[j][e].w); }
            const float rstd = 1.0f / sqrtf(wave_sum(ss) * (1.0f / D) + RMS_EPS);
            GAS v4u* o16 = (GAS v4u*)(hrow0 + (size_t)(r4 + rr) * D) + lane;
#pragma unroll
            for (int j = 0; j < 4; ++j) { const f32x4 y0 = (v[j][0] * rstd) * A[j][0] + B[j][0], y1 = (v[j][1] * rstd) * A[j][1] + B[j][1];
                v4u o; o.x = pk2(y0.x, y0.y); o.y = pk2(y0.z, y0.w); o.z = pk2(y1.x, y1.y); o.w = pk2(y1.z, y1.w); o16[64 * j] = o; }
        }
    }
}

__device__ __forceinline__ unsigned vimg_off(unsigned row, unsigned ch) { return 256u * row + 16u * (ch ^ (((row & 3) << 2) | ((row >> 2) & 3))); }
__device__ __forceinline__ s16x4 vtr(LAS unsigned char* p) { return __builtin_bit_cast(s16x4, __builtin_amdgcn_ds_read_tr16_b64_v4i16((LAS s16x4*)p)); }
#define MFMA32(a, b, c) __builtin_amdgcn_mfma_f32_32x32x16_bf16((a), (b), (c), 0, 0, 0)

__device__ __forceinline__ void attn_wave_unit(int w, LAS unsigned char* vl, const bf16* QKV, bf16* mixed, float* lse, int lane_in) {
    int lane = lane_in; asm volatile("" : "+v"(lane));
    const int n = lane & 31, h = lane >> 5;
    const int g = w / 9216; int w1 = w - g * 9216;
    int hh, w3, lsh, sstart;
    if (w1 < 3072) { const int bb = w1 / 1536, w2 = w1 - bb * 1536; hh = w2 >> 8; w3 = w2 & 255; sstart = bb * SEQP; lsh = 13 - 2 * g; }
    else { w1 -= 3072; const int bb = w1 / 384, w2 = w1 - bb * 384; hh = w2 >> 6; w3 = w2 & 63; sstart = MP + bb * SEQS; lsh = 11 - 2 * g; }
    const int head = g * 6 + hh, L = 1 << lsh, pos0 = w3 * 32, r = pos0 >> lsh, u0 = pos0 & (L - 1), seqlo = sstart + (r << lsh);
    const bf16* Qh = QKV + ((size_t)(0 * NH + head) * M + seqlo) * HD;
    const bf16* Kh = QKV + ((size_t)(1 * NH + head) * M + seqlo) * HD;
    const bf16* Vh = QKV + ((size_t)(2 * NH + head) * M + seqlo) * HD;
#define ATT_LDK(dst, kb) do { int ku_ = u0 - 64 + 32 * (kb) + n; ku_ = ku_ < 0 ? 0 : (ku_ > L - 1 ? L - 1 : ku_); const GAS bf16x8* kp_ = (const GAS bf16x8*)(Kh + (size_t)ku_ * HD + 8 * h); \
        _Pragma("unroll") for (int ks = 0; ks < 8; ++ks) dst[ks] = kp_[2 * ks]; } while (0)
#define ATT_LDV(dst, kb) do { _Pragma("unroll") for (int i = 0; i < 8; ++i) { int ku_ = u0 - 64 + 32 * (kb) + (lane >> 4) + 4 * i; ku_ = ku_ < 0 ? 0 : (ku_ > L - 1 ? L - 1 : ku_); \
        dst[i] = *(const GAS v4u*)(Vh + (size_t)ku_ * HD + 8 * (lane & 15)); } } while (0)
    bf16x8 qf[8], kfa[8], kfb[8];
    { const GAS bf16x8* qp = (const GAS bf16x8*)(Qh + (size_t)(u0 + n) * HD + 8 * h);
#pragma unroll
      for (int ks = 0; ks < 8; ++ks) qf[ks] = qp[2 * ks]; }
    ATT_LDK(kfa, 0);
    const float slope2 = exp2f(-8.0f * (float)(head + 1) / 18.0f) * (float)(1 << (2 * g)) * LOG2E;
    f32x16 s[5];
#pragma unroll
    for (int kb = 0; kb < 5; ++kb) {
        asm volatile("" ::: "memory");
        if (kb + 1 < 5) { if (kb & 1) ATT_LDK(kfa, kb + 1); else ATT_LDK(kfb, kb + 1); }
        asm volatile("" ::: "memory");
        f32x16 acc;
#pragma unroll
        for (int i = 0; i < 16; ++i) acc[i] = 0.f;
#pragma unroll
        for (int ks = 0; ks < 8; ++ks) acc = (kb & 1) ? MFMA32(kfb[ks], qf[ks], acc) : MFMA32(kfa[ks], qf[ks], acc);
#pragma unroll
        for (int i = 0; i < 16; ++i) {
            const int krow = (i & 3) + 8 * (i >> 2) + 4 * h, kuu = u0 - 64 + 32 * kb + krow, du = -64 + 32 * kb + krow - n;
            bool ok = (unsigned)kuu < (unsigned)L;
            if (kb == 0) ok = ok && (du >= -64);
            if (kb == 4) ok = ok && (du <= 64);
            s[kb][i] = ok ? acc[i] - slope2 * fabsf((float)du) : -1e30f;
        }
    }
    v4u vra[8], vrb[8];
    ATT_LDV(vra, 0);
    float mx = -1e30f;
#pragma unroll
    for (int kb = 0; kb < 5; ++kb)
#pragma unroll
        for (int i = 0; i < 16; ++i) mx = fmaxf(mx, s[kb][i]);
    mx = fmaxf(mx, __shfl_xor(mx, 32));
    float lsum = 0.f;
    v4u pw[5][2];
#pragma unroll
    for (int kb = 0; kb < 5; ++kb)
#pragma unroll
        for (int s2 = 0; s2 < 2; ++s2) { float p[8];
#pragma unroll
            for (int e = 0; e < 8; ++e) { p[e] = __builtin_amdgcn_exp2f(s[kb][8 * s2 + e] - mx); lsum += p[e]; }
            pw[kb][s2].x = pk2(p[0], p[1]); pw[kb][s2].y = pk2(p[2], p[3]); pw[kb][s2].z = pk2(p[4], p[5]); pw[kb][s2].w = pk2(p[6], p[7]); }
    lsum += __shfl_xor(lsum, 32);
    f32x16 o[4];
#pragma unroll
    for (int c = 0; c < 4; ++c)
#pragma unroll
        for (int i = 0; i < 16; ++i) o[c][i] = 0.f;
    const unsigned q4 = (lane & 15) >> 2, p4 = lane & 3, blk = (lane >> 4) & 1;
#pragma unroll
    for (int kb = 0; kb < 5; ++kb) {
#pragma unroll
        for (int i = 0; i < 8; ++i) { const unsigned row = (lane >> 4) + 4 * i; *(LAS v4u*)(vl + vimg_off(row, lane & 15)) = (kb & 1) ? vrb[i] : vra[i]; }
        asm volatile("s_waitcnt lgkmcnt(0)" ::: "memory");
        if (kb + 1 < 5) { if (kb & 1) ATT_LDV(vra, kb + 1); else ATT_LDV(vrb, kb + 1); }
        asm volatile("" ::: "memory");
#pragma unroll
        for (int s2 = 0; s2 < 2; ++s2) {
            const bf16x8 pf = __builtin_bit_cast(bf16x8, pw[kb][s2]);
#pragma unroll
            for (int c = 0; c < 4; ++c) {
                const unsigned ch = 4 * c + 2 * blk + (p4 >> 1);
                const s16x4 lo = vtr(vl + vimg_off(16 * s2 + 0 + 4 * h + q4, ch) + 8 * (p4 & 1));
                const s16x4 hi = vtr(vl + vimg_off(16 * s2 + 8 + 4 * h + q4, ch) + 8 * (p4 & 1));
                const bf16x8 vf = __builtin_shufflevector(lo, hi, 0, 1, 2, 3, 4, 5, 6, 7);
                o[c] = MFMA32(vf, pf, o[c]);
            }
        }
        asm volatile("s_waitcnt lgkmcnt(0)" ::: "memory");
    }
#undef ATT_LDK
#undef ATT_LDV
    const float inv = 1.0f / lsum;
    const int mrow = sstart + ((u0 + n) << (2 * g)) + r;
    bf16* op = mixed + (size_t)mrow * AW + head * HD + 4 * h;
#pragma unroll
    for (int c = 0; c < 4; ++c)
#pragma unroll
        for (int k4 = 0; k4 < 4; ++k4) { v2u wv; wv.x = pk2(o[c][4 * k4 + 0] * inv, o[c][4 * k4 + 1] * inv); wv.y = pk2(o[c][4 * k4 + 2] * inv, o[c][4 * k4 + 3] * inv);
            *(GAS v2u*)(op + 32 * c + 8 * k4) = wv; }
    if (h == 0) lse[(size_t)mrow * NH + head] = (mx + __builtin_amdgcn_logf(lsum)) * LN2;
}

template <int N2> __device__ __forceinline__ void fbc_item(const bf16* AOb, bf16* outb, int k1, int cg, LAS float* tw, int lane) {
    constexpr int S = 256 * N2; constexpr float scale = (N2 == 32) ? 0.17677669529663687f : 0.35355339059327373f;
    for (int idx = lane; idx < N2 * N2; idx += 64) { const int n2 = idx / N2, k2 = idx % N2; const float ph = (float)((n2 * (k1 + 256 * k2)) & (S - 1)) * (1.0f / S);
        *(LAS f32x2*)(tw + 2 * idx) = (f32x2){__builtin_amdgcn_cosf(ph) * scale, __builtin_amdgcn_sinf(ph) * scale}; }
    asm volatile("s_waitcnt lgkmcnt(0)" ::: "memory");
    for (int ch = 0; ch < 2; ++ch) {
        const int col = (cg * 2 + ch) * 256 + lane * 4;
        const GAS v2u* pr = (const GAS v2u*)(AOb + ((size_t)k1 * N2) * 2048 + col);
        const GAS v2u* pi = (const GAS v2u*)(AOb + ((size_t)(256 + k1) * N2) * 2048 + col);
        f32x4 acc[N2];
#pragma unroll
        for (int k2 = 0; k2 < N2; ++k2) acc[k2] = (f32x4){0.f, 0.f, 0.f, 0.f};
#pragma unroll 2
        for (int n2 = 0; n2 < N2; ++n2) {
            const v2u r = pr[(size_t)n2 * 512], im = pi[(size_t)n2 * 512];
            const f32x4 xr = {bf_lo(r.x), bf_hi(r.x), bf_lo(r.y), bf_hi(r.y)}, xi = {bf_lo(im.x), bf_hi(im.x), bf_lo(im.y), bf_hi(im.y)};
#pragma unroll
            for (int k2 = 0; k2 < N2; ++k2) { const f32x2 cs = *(const LAS f32x2*)(tw + 2 * (n2 * N2 + k2)); acc[k2] += xr * cs.x + xi * cs.y; }
        }
#pragma unroll
        for (int k2 = 0; k2 < N2; ++k2) { v2u w; w.x = pk2(acc[k2].x, acc[k2].y); w.y = pk2(acc[k2].z, acc[k2].w); *(GAS v2u*)(outb + (size_t)(k1 + 256 * k2) * D + col) = w; }
    }
    asm volatile("s_waitcnt lgkmcnt(0)" ::: "memory");
}

struct Args { const float* in[17]; float* out; unsigned char* ws; };
typedef const Args __attribute__((address_space(4)))* KArgs;
__device__ __forceinline__ KArgs kargs() { KArgs p = (KArgs)__builtin_amdgcn_kernarg_segment_ptr(); asm volatile("" : "+s"(p)); return p; }
__global__ void __launch_bounds__(NWAVES * 64, 2) fwd(Args args) {
    extern __shared__ __attribute__((aligned(16))) unsigned char lds_raw[];
    LAS unsigned char* lds = (LAS unsigned char*)lds_raw;
    const int wave = __builtin_amdgcn_readfirstlane((int)threadIdx.x >> 6), G = gridDim.x;
#define FRESH_TID(name) int name = threadIdx.x; asm volatile("" : "+v"(name))
    const int gw = blockIdx.x * NWAVES + wave, NGW = G * NWAVES;
    unsigned* ctl = (unsigned*)(kargs()->ws + WS_CTL);
    { FRESH_TID(tid); for (int u = tid; u < (LDS_BYTES - LDSCTL_OFF) / 4; u += NWAVES * 64) ((LAS unsigned*)(lds + LDSCTL_OFF))[u] = 0u; }
    __syncthreads();
    (void)xcd_barrier_post(ctl + CW_BAR, (volatile LAS unsigned*)(lds + MISC_OFF) + 8);
#define GRID_BAR() do { XcdBarrier bar_; bar_.bar = (unsigned*)(kargs()->ws + WS_CTL) + CW_BAR; bar_.x = xb_xcc_id(); bar_.st = (volatile LAS unsigned*)(lds + MISC_OFF) + 8; xcd_barrier(bar_); } while (0)

#define KA() kargs()
#define WSP(off) (KA()->ws + (off))
    LAS float* scr = (LAS float*)(lds + wave * 16384);

    { FRESH_TID(tid); const float* c_p = KA()->in[2]; const float* c_s = KA()->in[3]; float* cact = (float*)WSP(WS_CACT);
    for (int idx = blockIdx.x * (NWAVES * 64) + tid; idx < D * 20; idx += G * NWAVES * 64) {
        const int k = idx / 20, b = idx - 20 * k; float v = 0.f;
        if (b < NBP) v = c_p[b * D + k]; else if (b < NB) v = c_s[(b - NBP) * D + k];
        cact[idx] = v / (1.0f + __expf(-v));
    } }
    GRID_BAR();

    {
        FRESH_TID(tid_); const int lane = tid_ & 63;
        const float* w_ada = KA()->in[4]; float* modp = (float*)WSP(WS_MODP); const float* cact = (const float*)WSP(WS_CACT);
        bf16* FC = (bf16*)WSP(WS_FC); bf16* GM = (bf16*)WSP(WS_G);
        constexpr int N_MOD = DEPTH * 48 * 8, N_G = 64, N_FC = 32, N_ALL = N_MOD + N_G + N_FC;
        for (int it = gw; it < N_ALL; it += NGW) {
            if (it < N_MOD) {
#ifndef SKIP_MOD
                const int kseg = it & 7, cb = (it >> 3) % 48, layer = it / 384, col = cb * 256 + lane * 4;
                f32x4 acc[NB];
#pragma unroll
                for (int b = 0; b < NB; ++b) acc[b] = (f32x4){0.f, 0.f, 0.f, 0.f};
                const float* wp = w_ada + ((size_t)layer * D + kseg * 256) * (NMOD * D) + col;
                const float* cbase = cact + (kseg * 256) * 20;
#pragma unroll 4
                for (int k = 0; k < 256; ++k) {
                    const f32x4 wv = *(const GAS f32x4*)(wp + (size_t)k * (NMOD * D));
                    const GAS f32x4* cp = (const GAS f32x4*)(cbase + k * 20);
                    const f32x4 c0 = cp[0], c1 = cp[1], c2 = cp[2], c3 = cp[3]; const f32x2 c4 = *(const GAS f32x2*)(cp + 4);
                    acc[0] += wv * c0.x; acc[1] += wv * c0.y; acc[2] += wv * c0.z; acc[3] += wv * c0.w;
                    acc[4] += wv * c1.x; acc[5] += wv * c1.y; acc[6] += wv * c1.z; acc[7] += wv * c1.w;
                    acc[8] += wv * c2.x; acc[9] += wv * c2.y; acc[10] += wv * c2.z; acc[11] += wv * c2.w;
                    acc[12] += wv * c3.x; acc[13] += wv * c3.y; acc[14] += wv * c3.z; acc[15] += wv * c3.w;
                    acc[16] += wv * c4.x; acc[17] += wv * c4.y;
                }
#pragma unroll
                for (int b = 0; b < NB; ++b) *(GAS f32x4*)(modp + (((size_t)kseg * DEPTH + layer) * NB + b) * (NMOD * D) + col) = acc[b];
#endif
            } else if (it < N_MOD + N_G) {
                const int r = it - N_MOD;
#pragma unroll 2
                for (int i = 0; i < 8; ++i) { const int e0 = r * 4096 + i * 512 + lane * 8, row = e0 >> 9, c0 = e0 & 511, part = row >> 8, k1 = row & 255, cpart = c0 >> 8; float f[8];
#pragma unroll
                    for (int e = 0; e < 8; ++e) { const int n1 = (c0 + e) & 255; const float ph = (float)((k1 * n1) & 255) * (1.0f / 256.0f), cs = __builtin_amdgcn_cosf(ph), sn = __builtin_amdgcn_sinf(ph);
                        f[e] = (part == cpart ? cs : (part == 0 ? sn : -sn)) * 0.0625f; }
                    v4u o; o.x = pk2(f[0], f[1]); o.y = pk2(f[2], f[3]); o.z = pk2(f[4], f[5]); o.w = pk2(f[6], f[7]);
                    *(GAS v4u*)(GM + e0) = o; }
            } else {
                const int r = it - N_MOD - N_G;
#pragma unroll 2
                for (int i = 0; i < 8; ++i) { const int e0 = r * 4096 + i * 512 + lane * 8, row = e0 >> 8, c0 = e0 & 255, part = row >> 8, j = row & 255; float f[8];
#pragma unroll
                    for (int e = 0; e < 8; ++e) { const float ph = (float)((j * (c0 + e)) & 255) * (1.0f / 256.0f);
                        f[e] = (part ? -__builtin_amdgcn_sinf(ph) : __builtin_amdgcn_cosf(ph)) * 0.0625f; }
                    v4u o; o.x = pk2(f[0], f[1]); o.y = pk2(f[2], f[3]); o.z = pk2(f[4], f[5]); o.w = pk2(f[6], f[7]);
                    *(GAS v4u*)(FC + e0) = o; }
            }
        }
    }
    GRID_BAR();
    { FRESH_TID(tid); const float* b_ada = KA()->in[5]; float* mod = (float*)WSP(WS_MOD); const float* modp = (const float*)WSP(WS_MODP);
      constexpr int NV = DEPTH * NB * (NMOD * D) / 4;
      for (int i = blockIdx.x * (NWAVES * 64) + tid; i < NV; i += G * NWAVES * 64) {
          const int layer = i / (NB * (NMOD * D) / 4), col4 = i % ((NMOD * D) / 4);
          f32x4 v = ((const GAS f32x4*)(b_ada + (size_t)layer * (NMOD * D)))[col4];
#pragma unroll
          for (int ks = 0; ks < 8; ++ks) v += ((const GAS f32x4*)modp)[(size_t)ks * NV + i];
          ((GAS f32x4*)mod)[i] = v; } }
    GRID_BAR();

#define CONVERT_REST(lane_) do { const float* w_o_ = KA()->in[9]; const float* w1_ = KA()->in[12]; const float* w2_ = KA()->in[14]; bf16* WO_ = (bf16*)WSP(WS_WO); bf16* W1_ = (bf16*)WSP(WS_W1); bf16* W2_ = (bf16*)WSP(WS_W2); \
        LAS float* scr2_ = (LAS float*)(lds + SCR2_OFF + wave * SCR2_STRIDE); const int I_B_ = is_attn ? (AW / 64) * (D / 32) : 0, I_1_ = (D / 64) * (FF / 32), I_2_ = (FF / 64) * (D / 32); \
        for (int it_ = gw; it_ < I_B_ + I_1_ + I_2_; it_ += NGW) { int r_ = it_; \
            if (r_ < I_B_) { transpose_item(w_o_ + (size_t)l2 * AW * D, AW, D, WO_, scr2_, r_, lane_); continue; } r_ -= I_B_; \
            if (r_ < I_1_) { transpose_item(w1_ + (size_t)l * D * FF, D, FF, W1_, scr2_, r_, lane_); continue; } r_ -= I_1_; \
            transpose_item(w2_ + (size_t)l * FF * D, FF, D, W2_, scr2_, r_, lane_); } } while (0)
#ifndef REP_W1
#define REP_W1 1
#endif
#ifndef REP_QKV
#define REP_QKV 1
#endif
#ifndef REP_N
#define REP_N 1
#endif
#ifndef REP_AT
#define REP_AT 1
#endif
#ifndef REP_FB
#define REP_FB 1
#endif
#ifndef REP_F1A
#define REP_F1A 1
#endif
    for (int l = 0; l < DEPTH; ++l) {
        const bool is_attn = (l & 1) == 0; const int l2 = l >> 1;
#define MODL() ((const float*)WSP(WS_MOD) + (size_t)l * NB * (NMOD * D))
        for (int rep_ = 0; rep_ < REP_N; ++rep_) {
            FRESH_TID(tid_); const int lane = tid_ & 63;
            const float* w_qkv = KA()->in[8]; const float* w_f = KA()->in[10]; bf16* WQKV = (bf16*)WSP(WS_WQKV); bf16* WF = (bf16*)WSP(WS_WF);
            const int I_A = is_attn ? (D / 64) * (QKVW / 32) : (D / 64) * (D / 32);
            for (int it = gw; it < I_A; it += NGW) { if (is_attn) transpose_item(w_qkv + (size_t)l2 * D * QKVW, D, QKVW, WQKV, scr, it, lane); else transpose_item(w_f + (size_t)l2 * D * D, D, D, WF, scr, it, lane); }
            const float* x_p = KA()->in[0]; const float* x_s = KA()->in[1]; const bf16* XB = (const bf16*)WSP(WS_XB); const float* norm1_g = KA()->in[6]; const float* modl = MODL(); bf16* HM = (bf16*)WSP(WS_HM);
            for (int it = gw; it < M / 8; it += NGW) {
                const int row0 = it * 8, b = batch_of_tile(row0 >> 8);
                const float* mb = modl + (size_t)b * (NMOD * D);
                if (l == 0) norm_chunk(row0 < MP ? x_p + (size_t)row0 * D : x_s + (size_t)(row0 - MP) * D, HM + (size_t)row0 * D, norm1_g + l * D, mb, mb + D, lane);
                else norm_chunk_b(XB + (size_t)row0 * D, HM + (size_t)row0 * D, norm1_g + l * D, mb, mb + D, lane);
            }
        }
        GRID_BAR();
        if (is_attn) {
            for (int rep_ = 0; rep_ < REP_QKV; ++rep_) { pg8::GemmDesc g = pg8::plain_gemm(WSP(WS_HM), WSP(WS_WQKV), D, D, D, M / 256); pg8::StaticOrder S; S.init(M / 256, QKVW / 256, G, (int)blockIdx.x);
              pg8::EpiQKV E{(bf16*)WSP(WS_R), 0.08838834764831845f * LOG2E};
              pg8::gemm_phase<pg8::EpiQKV, pg8::StaticOrder, PG8_ALIGN, PG8_SP2>(lds, g, S, E); }
            GRID_BAR();
#ifndef SKIP_ATTN
            { FRESH_TID(tid_); const bf16* RB = (const bf16*)WSP(WS_R); bf16* HM = (bf16*)WSP(WS_HM); float* lse = (float*)WSP(WS_LSE);
              for (int rep_ = 0; rep_ < REP_AT; ++rep_) for (int w = gw; w < 27648; w += NGW) attn_wave_unit(w, lds + wave * 8192, RB, HM, lse, tid_ & 63);
              CONVERT_REST(tid_ & 63); }
#endif
            GRID_BAR();
            { FRESH_TID(tid_); const int lane = tid_ & 63; bf16* HM = (bf16*)WSP(WS_HM); const float* lse = (const float*)WSP(WS_LSE);
            for (int m = gw * 4; m < M; m += NGW * 4) {
                v4u vv[4][5]; float al[4][5];
#pragma unroll
                for (int rr = 0; rr < 4; ++rr) { const float* lr = lse + (size_t)(m + rr) * NH;
#pragma unroll
                    for (int i = 0; i < 5; ++i) { const int c = lane + 64 * i;
                        if (c < AW / 8) { const int head = c >> 4, hh = head % 6; const float l0 = lr[hh], l1 = lr[6 + hh], l2v = lr[12 + hh], mxl = fmaxf(l0, fmaxf(l1, l2v));
                            const float e0 = __expf(l0 - mxl), e1 = __expf(l1 - mxl), e2 = __expf(l2v - mxl); al[rr][i] = (head < 6 ? e0 : (head < 12 ? e1 : e2)) / (e0 + e1 + e2);
                            vv[rr][i] = *((const GAS v4u*)(HM + (size_t)(m + rr) * AW) + c); } } }
#pragma unroll
                for (int rr = 0; rr < 4; ++rr)
#pragma unroll
                    for (int i = 0; i < 5; ++i) { const int c = lane + 64 * i;
                        if (c < AW / 8) { const v4u v = vv[rr][i]; const float a = al[rr][i]; v4u o;
                            o.x = pk2(bf_lo(v.x) * a, bf_hi(v.x) * a); o.y = pk2(bf_lo(v.y) * a, bf_hi(v.y) * a); o.z = pk2(bf_lo(v.z) * a, bf_hi(v.z) * a); o.w = pk2(bf_lo(v.w) * a, bf_hi(v.w) * a);
                            *((GAS v4u*)(HM + (size_t)(m + rr) * AW) + c) = o; } }
            } }
            GRID_BAR();
            { pg8::GemmDesc g = pg8::plain_gemm(WSP(WS_HM), WSP(WS_WO), AW, AW, AW, M / 256); pg8::StaticOrder S; S.init(M / 256, D / 256, G, (int)blockIdx.x);
              pg8::EpiRes E{(l == 0) ? KA()->in[0] : nullptr, (l == 0) ? KA()->in[1] : nullptr, (bf16*)WSP(WS_XB), nullptr, MODL() + 2 * D};
              pg8::gemm_phase<pg8::EpiRes, pg8::StaticOrder, PG8_ALIGN, PG8_SP2>(lds, g, S, E); }
        } else {
            for (int rep_ = 0; rep_ < REP_F1A; ++rep_) { pg8::GemmDesc g{(const char*)WSP(WS_FC), (const char*)WSP(WS_HM), 256, (SEQP / 256) * D, 256, 2, 8, 1, 0, 0, (long long)SEQP * D * 2, 512, (long long)D * 2, 0}; pg8::StaticOrder S; S.init(NBP * 8 * 2, SEQP / 256, G, (int)blockIdx.x);
              pg8::EpiZT E{(bf16*)WSP(WS_R), 0, SEQP, SEQP / 256};
              pg8::gemm_phase<pg8::EpiZT, pg8::StaticOrder, PG8_ALIGN, PG8_SP2>(lds, g, S, E); }
            for (int rep_ = 0; rep_ < REP_F1A; ++rep_) { pg8::GemmDesc g{(const char*)WSP(WS_FC), (const char*)((bf16*)WSP(WS_HM) + (size_t)MP * D), 256, (SEQS / 256) * D, 256, 2, 8, 1, 0, 0, (long long)SEQS * D * 2, 512, (long long)D * 2, 0}; pg8::StaticOrder S; S.init(NBS * 8 * 2, SEQS / 256, G, (int)blockIdx.x);
              pg8::EpiZT E{(bf16*)WSP(WS_R), MP, SEQS, SEQS / 256};
              pg8::gemm_phase<pg8::EpiZT, pg8::StaticOrder, PG8_ALIGN, PG8_SP2>(lds, g, S, E); }
            GRID_BAR();
            for (int rep_ = 0; rep_ < REP_F1A; ++rep_) { constexpr int N2 = SEQP / 256; pg8::GemmDesc g{(const char*)WSP(WS_G), (const char*)WSP(WS_R), 512, N2 * 512, 512, 2, 1, 8, 0, 0, (long long)4096 * SEQP * 2, 0, 1024, (long long)256 * N2 * 1024};
              pg8::StaticOrder S; S.init(NBP * 2, N2 * 8, G, (int)blockIdx.x);
              pg8::EpiAO E{(bf16*)WSP(WS_AO), 0, SEQP, N2};
              pg8::gemm_phase<pg8::EpiAO, pg8::StaticOrder, PG8_ALIGN, PG8_SP2>(lds, g, S, E); }
            for (int rep_ = 0; rep_ < REP_F1A; ++rep_) { constexpr int N2 = SEQS / 256; pg8::GemmDesc g{(const char*)WSP(WS_G), (const char*)((bf16*)WSP(WS_R) + (size_t)4096 * MP), 512, N2 * 512, 512, 2, 1, 8, 0, 0, (long long)4096 * SEQS * 2, 0, 1024, (long long)256 * N2 * 1024};
              pg8::StaticOrder S; S.init(NBS * 2, N2 * 8, G, (int)blockIdx.x);
              pg8::EpiAO E{(bf16*)WSP(WS_AO), MP, SEQS, N2};
              pg8::gemm_phase<pg8::EpiAO, pg8::StaticOrder, PG8_ALIGN, PG8_SP2>(lds, g, S, E); }
            GRID_BAR();
            for (int rep_ = 0; rep_ < REP_FB; ++rep_) { FRESH_TID(tid_); const int lane = tid_ & 63; const bf16* AO = (const bf16*)WSP(WS_AO); bf16* HM = (bf16*)WSP(WS_HM); LAS float* tw = (LAS float*)(lds + wave * 8192);
              for (int it = gw; it < NBP * 256 * 4; it += NGW) { const int b = it >> 10, k1 = (it >> 2) & 255, cg = it & 3;
                  fbc_item<SEQP / 256>(AO + (size_t)4096 * (b * SEQP), HM + (size_t)(b * SEQP) * D, k1, cg, tw, lane); }
              for (int it = gw; it < NBS * 256 * 4; it += NGW) { const int b = it >> 10, k1 = (it >> 2) & 255, cg = it & 3;
                  fbc_item<SEQS / 256>(AO + (size_t)4096 * (MP + b * SEQS), HM + (size_t)(MP + b * SEQS) * D, k1, cg, tw, lane); }
              if (rep_ == 0) CONVERT_REST(lane); }
            GRID_BAR();
            { pg8::GemmDesc g = pg8::plain_gemm(WSP(WS_HM), WSP(WS_WF), D, D, D, M / 256); pg8::StaticOrder S; S.init(M / 256, D / 256, G, (int)blockIdx.x);
              pg8::EpiRes E{nullptr, nullptr, (bf16*)WSP(WS_XB), KA()->in[11] + (size_t)l2 * D, MODL() + 2 * D};
              pg8::gemm_phase<pg8::EpiRes, pg8::StaticOrder, PG8_ALIGN, PG8_SP2>(lds, g, S, E); }
        }
        GRID_BAR();
        for (int rep_ = 0; rep_ < REP_N; ++rep_) { FRESH_TID(tid_); const int lane = tid_ & 63; const bf16* XB = (const bf16*)WSP(WS_XB); const float* norm2_g = KA()->in[7]; const float* modl = MODL(); bf16* HM = (bf16*)WSP(WS_HM);
        for (int it = gw; it < M / 8; it += NGW) {
            const int row0 = it * 8, b = batch_of_tile(row0 >> 8);
            const float* mb = modl + (size_t)b * (NMOD * D) + 3 * D;
            norm_chunk_b(XB + (size_t)row0 * D, HM + (size_t)row0 * D, norm2_g + l * D, mb, mb + D, lane);
        } }
        GRID_BAR();
        for (int rep_ = 0; rep_ < REP_W1; ++rep_) { pg8::GemmDesc g = pg8::plain_gemm(WSP(WS_HM), WSP(WS_W1), D, D, D, M / 256); pg8::StaticOrder S; S.init(M / 256, FF / 256, G, (int)blockIdx.x);
          pg8::EpiBf16<1> E{(bf16*)WSP(WS_R), FF, KA()->in[13] + (size_t)l * FF, 0};
          pg8::gemm_phase<pg8::EpiBf16<1>, pg8::StaticOrder, PG8_ALIGN, PG8_SP2>(lds, g, S, E); }
        GRID_BAR();
#ifdef PROBE_W2
        { pg8::GemmDesc g = pg8::plain_gemm(WSP(WS_R), WSP(WS_W2), FF, FF, FF, M / 256); pg8::StaticOrder S; S.init(M / 256, D / 256, G, (int)blockIdx.x);
          pg8::EpiBf16<0> E{(bf16*)WSP(WS_END), D, nullptr, 0};
          pg8::gemm_phase<pg8::EpiBf16<0>, pg8::StaticOrder, PG8_ALIGN, PG8_SP2>(lds, g, S, E); }
#endif
        { pg8::GemmDesc g = pg8::plain_gemm(WSP(WS_R), WSP(WS_W2), FF, FF, FF, M / 256); pg8::StaticOrder S; S.init(M / 256, D / 256, G, (int)blockIdx.x);
          pg8::EpiRes E{nullptr, nullptr, (bf16*)WSP(WS_XB), KA()->in[15] + (size_t)l * D, MODL() + 5 * D};
          pg8::gemm_phase<pg8::EpiRes, pg8::StaticOrder, PG8_ALIGN, PG8_SP2>(lds, g, S, E); }
        GRID_BAR();
    }
    FRESH_TID(tid_); const int lane = tid_ & 63; float* yout = KA()->out; const bf16* XB = (const bf16*)WSP(WS_XB); const float* final_g = KA()->in[16];
    for (int m = gw; m < M; m += NGW) {
        const GAS v4u* xr = (const GAS v4u*)(XB + (size_t)m * D) + lane;
        f32x4 v[4][2]; float ss = 0.f;
#pragma unroll
        for (int j = 0; j < 4; ++j) { const v4u w = xr[64 * j];
            v[j][0] = (f32x4){bf_lo(w.x), bf_hi(w.x), bf_lo(w.y), bf_hi(w.y)}; v[j][1] = (f32x4){bf_lo(w.z), bf_hi(w.z), bf_lo(w.w), bf_hi(w.w)};
#pragma unroll
            for (int e = 0; e < 2; ++e) ss += (v[j][e].x * v[j][e].x + v[j][e].y * v[j][e].y) + (v[j][e].z * v[j][e].z + v[j][e].w * v[j][e].w); }
        const float rstd = 1.0f / sqrtf(wave_sum(ss) * (1.0f / D) + RMS_EPS);
#pragma unroll
        for (int j = 0; j < 4; ++j)
#pragma unroll
            for (int e = 0; e < 2; ++e) { const int col = 8 * lane + 512 * j + 4 * e; *(GAS f32x4*)(yout + (size_t)m * D + col) = (v[j][e] * rstd) * *(const f32x4*)(final_g + col); }
    }
}

extern "C" void kernel_launch(void* const* d_in, const int* in_sizes, int n_in, void* d_out, int out_size, void* d_ws, size_t ws_size, hipStream_t stream) {
    static int grid = 0;
    if (grid == 0) {
        if (n_in != 17 || out_size != M * D || ws_size < WS_END) { fprintf(stderr, "kernel_launch: unexpected shapes (n_in %d, out %d, ws %zu < %zu); nothing launched\n", n_in, out_size, ws_size, (size_t)WS_END); grid = -1; return; }
        int dev = 0, cus = 0, per_cu = 0;
        if (hipGetDevice(&dev) != hipSuccess || hipDeviceGetAttribute(&cus, hipDeviceAttributeMultiprocessorCount, dev) != hipSuccess) { grid = -1; return; }
        if (hipFuncSetAttribute((const void*)fwd, hipFuncAttributeMaxDynamicSharedMemorySize, LDS_BYTES) != hipSuccess) { fprintf(stderr, "kernel_launch: hipFuncSetAttribute failed\n"); grid = -1; return; }
        if (hipOccupancyMaxActiveBlocksPerMultiprocessor(&per_cu, (const void*)fwd, NWAVES * 64, LDS_BYTES) != hipSuccess || per_cu < 1)
            fprintf(stderr, "kernel_launch: note: occupancy query reports %d workgroups per CU\n", per_cu);
        (void)hipGetLastError();
        grid = cus;
    }
    if (grid < 0) return;
    if (hipMemsetAsync((char*)d_ws + WS_CTL, 0, CTL_ZERO_BYTES, stream) != hipSuccess) { fprintf(stderr, "kernel_launch: hipMemsetAsync failed\n"); return; }
    Args a{};
    for (int i = 0; i < 17; ++i) a.in[i] = (const float*)d_in[i];
    a.out = (float*)d_out; a.ws = (unsigned char*)d_ws;
    hipLaunchKernelGGL(fwd, dim3(grid), dim3(NWAVES * 64), LDS_BYTES, stream, a);
    const hipError_t le = hipPeekAtLastError();
    if (le != hipSuccess) fprintf(stderr, "kernel_launch: launch failed: %s\n", hipGetErrorName(le));
}
```

```cpp
#include <hip/hip_runtime.h>
#include <cstdio>
#include <cstdint>

#ifndef PG8_SNAKE
#define PG8_SNAKE 1
#endif
#ifndef PG8_WGM
#define PG8_WGM 4
#endif
namespace pg8 {
#define PG8_LAS __attribute__((address_space(3)))
typedef unsigned short bf16_t;
typedef short bf16x8 __attribute__((ext_vector_type(8)));
typedef float f32x4 __attribute__((ext_vector_type(4)));
typedef float f32x2 __attribute__((ext_vector_type(2)));
typedef unsigned u32x4 __attribute__((ext_vector_type(4)));
constexpr int BM = 256, BK = 64, HALF = 128, HTB = HALF * BK * 2  , STAGE_BYTES = 8 * HTB, NXCD = 8, WGM = PG8_WGM;

__host__ __device__ __forceinline__ int lds_byte(int r, int c) { const int st = (r >> 4) * 2 + (c >> 5), rr = r & 15, cc = c & 31, ob = rr * 64 + cc * 2; return st * 1024 + (ob ^ (((ob >> 9) & 1) << 5)); }
__host__ __device__ __forceinline__ void stage_rc(int b, int& R, int& C) { const int st = b / 1024, sb = b % 1024, swz = sb ^ (((sb >> 9) & 1) << 5); R = (st >> 1) * 16 + swz / 64; C = (st & 1) * 32 + (swz % 64) / 2; }
__host__ __device__ __forceinline__ int perm32(int rho) { const int n = rho >> 4, i = rho & 15; return 8 * (i >> 2) + 4 * n + (i & 3); }

struct Unit { int pm, pn; };

struct GemmDesc {
    const char* A; const char* B;
    int lda, ldb, K;
    int nMb, zdiv, pdiv;
    long long sA1, sA2, sB1, sB2;
    long long pB1, pB2;
    int kstepA;
    __device__ __forceinline__ const char* aptr(const Unit& u) const { const int z = u.pm / nMb, pml = u.pm - z * nMb, z1 = z / zdiv, z2 = z - z1 * zdiv; return A + (long long)pml * (512ll * lda) + z1 * sA1 + z2 * sA2; }
    __device__ __forceinline__ const char* bptr(const Unit& u) const { const int z = u.pm / nMb, z1 = z / zdiv, z2 = z - z1 * zdiv, p1 = u.pn / pdiv, p2 = u.pn - p1 * pdiv; return B + p1 * pB1 + p2 * pB2 + z1 * sB1 + z2 * sB2; }
};
__device__ __forceinline__ GemmDesc plain_gemm(const void* A, const void* B, int lda, int ldb, int K, int nM) { return GemmDesc{(const char*)A, (const char*)B, lda, ldb, K, nM, 1, 1, 0, 0, 0, 0, 512ll * ldb, 0, 128}; }

struct StaticOrder {
    int nM, nN, nwg, G, c, wgm, rev;
    __host__ __device__ void init(int nM_, int nN_, int G_, int c_, int wgm_ = WGM, int rev_ = 0) { nM = nM_; nN = nN_; nwg = nM * nN; G = G_; c = c_; wgm = wgm_; rev = rev_; }
    __host__ __device__ bool next(int i, Unit& u) const {
        const long L = (long)i * G + c; if (L >= nwg) return false;
        int wgid = (int)L; { const int q = nwg / NXCD, r = nwg % NXCD, xcd = wgid % NXCD, off = wgid / NXCD; wgid = (xcd < r ? xcd * (q + 1) : r * (q + 1) + (xcd - r) * q) + off; }
        const int nig = wgm * nN, gid = wgid / nig, fm = gid * wgm, gsz = (nM - fm) < wgm ? (nM - fm) : wgm;
        u.pm = fm + ((wgid % nig) % gsz); u.pn = (wgid % nig) / gsz; if (PG8_SNAKE && (gid & 1)) u.pn = nN - 1 - u.pn; if (rev) u.pm = nM - 1 - u.pm; return true;
    }
    __device__ __forceinline__ void a_ready(const Unit&) const {}
    __device__ __forceinline__ void done(const Unit&) const {}
#ifndef PG8_KROT
#define PG8_KROT 1
#endif
#ifndef PG8_STAG_TICKS
#define PG8_STAG_TICKS 0
#endif
    __device__ __forceinline__ void stagger() const { if (PG8_STAG_TICKS > 0) { const unsigned long long t0 = __builtin_amdgcn_s_memrealtime(), d = (unsigned long long)(((c >> 3) & 3) * PG8_STAG_TICKS);
        while (__builtin_amdgcn_s_memrealtime() - t0 < d) __builtin_amdgcn_s_sleep(4); } }
    __device__ __forceinline__ int krot(int nt) const { return PG8_KROT ? 2 * (((c & 7) * (nt >> 1)) >> 3) : 0; }
};

__device__ __forceinline__ unsigned cvt_pk_bf16(float lo, float hi) { unsigned r; asm volatile("v_cvt_pk_bf16_f32 %0, %1, %2" : "=v"(r) : "v"(lo), "v"(hi)); return r; }

template <class Epi, class Sched, bool ALIGN_EPI = false, bool SP2 = false>
__device__ __forceinline__ void gemm_phase(PG8_LAS unsigned char* lds, const GemmDesc g, const Sched& S, const Epi& E) {
    int tid_ = threadIdx.x; asm volatile("" : "+v"(tid_));
    const int tid = tid_, wid = __builtin_amdgcn_readfirstlane(tid >> 6), lane = tid & 63, wr = wid >> 2, wc = wid & 3, fr = lane & 15, fq = lane >> 4;
    const int K = g.K, nt = K / BK;
    unsigned voffA[2], voffB[2];
#pragma unroll
    for (int i = 0; i < 2; ++i) { int R, C; stage_rc(tid * 16 + i * 8192, R, C); const int Rb = Epi::PERM ? ((R & ~31) + perm32(R & 31)) : R;
        voffA[i] = (unsigned)(R * g.lda + C) * 2u; voffB[i] = (unsigned)(Rb * g.ldb + C) * 2u; }
    const size_t kstep = (size_t)(BK * 2), kA = (size_t)g.kstepA;
    const size_t hA = (size_t)HALF * g.lda * 2, hB = (size_t)HALF * g.ldb * 2;
    const unsigned ldsw = (unsigned)wid * 1024u;
    const int aoff = lds_byte(wr * 64 + fr, fq * 8), boff = lds_byte(wc * 32 + fr, fq * 8);
#define PG8_SA(b, h) (((b) * 2 + (h)) * HTB)
#define PG8_SB(b, h) ((4 + (b) * 2 + (h)) * HTB)
#define PG8_STAGE(bufoff, gbase, voff) do { _Pragma("unroll") for (int _i = 0; _i < 2; ++_i) \
        __builtin_amdgcn_global_load_lds((const unsigned*)((const char*)(gbase) + (voff)[_i]), (PG8_LAS unsigned*)(lds + (bufoff) + ldsw + _i * 8192), 16, 0, 0); } while (0)
#define PG8_LDA(dst, b, h) do { _Pragma("unroll") for (int m = 0; m < 4; ++m) _Pragma("unroll") for (int k = 0; k < 2; ++k) dst[m][k] = *(const PG8_LAS bf16x8*)(lds + PG8_SA(b, h) + aoff + m * 2048 + k * 1024); } while (0)
#define PG8_LDB(dst, b, h) do { _Pragma("unroll") for (int n = 0; n < 2; ++n) _Pragma("unroll") for (int k = 0; k < 2; ++k) dst[n][k] = *(const PG8_LAS bf16x8*)(lds + PG8_SB(b, h) + boff + n * 2048 + k * 1024); } while (0)
#define PG8_MMA(ai, bj, At, Bt) do { __builtin_amdgcn_s_setprio(1); _Pragma("unroll") for (int m = 0; m < 4; ++m) _Pragma("unroll") for (int n = 0; n < 2; ++n) _Pragma("unroll") for (int k = 0; k < 2; ++k) \
        acc[ai][bj][m][n] = __builtin_amdgcn_mfma_f32_16x16x32_bf16(Bt[n][k], At[m][k], acc[ai][bj][m][n], 0, 0, 0); __builtin_amdgcn_s_setprio(0); } while (0)
#define PG8_WAIT_V(n) asm volatile("s_waitcnt vmcnt(" #n ")" ::: "memory")
#define PG8_WAIT_L(n) asm volatile("s_waitcnt lgkmcnt(" #n ")" ::: "memory")
#define PG8_WAIT_V8_OR_24(rx) asm volatile("s_cmp_lg_u32 %0, 0\n\ts_cbranch_scc1 1f\n\ts_waitcnt vmcnt(8)\n1:\n\ts_waitcnt vmcnt(24)" :: "s"(rx) : "memory", "scc")
#define PG8_BAR __builtin_amdgcn_s_barrier()
#define PG8_SCHED __builtin_amdgcn_sched_barrier(0)
    Unit cur, nxt; int ui = 0;
    if (!S.next(0, cur)) return;
    S.stagger();
    f32x4 acc[2][2][4][2];
#pragma unroll
    for (int a = 0; a < 2; ++a)
#pragma unroll
        for (int b = 0; b < 2; ++b)
#pragma unroll
            for (int m = 0; m < 4; ++m)
#pragma unroll
                for (int n = 0; n < 2; ++n) acc[a][b][m][n] = (f32x4){0.f, 0.f, 0.f, 0.f};
    bf16x8 At[4][2], B0[2][2], B1[2][2];
    typename Epi::Pre pre;
    const char* cA = g.aptr(cur); const char* cB = g.bptr(cur);
    const int r0 = S.krot(nt); const size_t roff = (size_t)r0 * kstep, roffA = (size_t)r0 * kA;
    S.a_ready(cur);
    if constexpr (SP2) {
        PG8_STAGE(PG8_SB(0, 0), cB + roff, voffB); PG8_STAGE(PG8_SB(0, 1), cB + roff + hB, voffB); PG8_STAGE(PG8_SA(0, 0), cA + roffA, voffA); PG8_STAGE(PG8_SA(0, 1), cA + roffA + hA, voffA);
        if (wr == 1) PG8_BAR;
        PG8_WAIT_V(2); PG8_BAR;
        PG8_STAGE(PG8_SB(1, 0), cB + roff + kstep, voffB); PG8_STAGE(PG8_SA(1, 0), cA + roffA + kA, voffA); PG8_STAGE(PG8_SB(1, 1), cB + roff + hB + kstep, voffB);
        PG8_WAIT_V(6); PG8_BAR;
    } else {
        PG8_STAGE(PG8_SB(0, 0), cB + roff, voffB); PG8_STAGE(PG8_SA(0, 0), cA + roffA, voffA); PG8_STAGE(PG8_SB(0, 1), cB + roff + hB, voffB); PG8_STAGE(PG8_SA(0, 1), cA + roffA + hA, voffA);
        if (wr == 1) PG8_BAR;
        PG8_WAIT_V(4); PG8_BAR;
        PG8_STAGE(PG8_SB(1, 0), cB + roff + kstep, voffB); PG8_STAGE(PG8_SA(1, 0), cA + roffA + kA, voffA); PG8_STAGE(PG8_SB(1, 1), cB + roff + hB + kstep, voffB);
        PG8_WAIT_V(6); PG8_BAR;
    }
    for (;;) {
        const bool has_next = S.next(ui + 1, nxt);
        const char* nA = has_next ? g.aptr(nxt) : cA; const char* nB = has_next ? g.bptr(nxt) : cB;
        for (int t = 0; t < nt; t += 2) {
            const bool last = (t == nt - 2);
            int tt = t + r0; if (tt >= nt) tt -= nt; int tt2 = tt + 2; if (tt2 >= nt) tt2 -= nt;
            const char* a1 = cA + (size_t)(tt + 1) * kA;
            const char* a2 = last ? nA + roffA : cA + (size_t)tt2 * kA; const char* b2 = last ? nB + roff : cB + (size_t)tt2 * kstep;
            const char* a3 = a2 + kA; const char* b3 = b2 + kstep;
            if (last && has_next) S.a_ready(nxt);
            if (last) E.prefetch(pre, cur, wc, fq);
            if constexpr (SP2) {
            const int relax = __builtin_amdgcn_readfirstlane((Epi::NST >= 16 && ui > 0 && t == 0) ? 1 : 0);
            PG8_LDB(B0, 0, 0); PG8_LDB(B1, 0, 1); PG8_SCHED; PG8_LDA(At, 0, 0); PG8_STAGE(PG8_SA(1, 1), a1 + hA, voffA);
            PG8_WAIT_V8_OR_24(relax); PG8_WAIT_L(0); PG8_BAR; PG8_MMA(0, 0, At, B0); PG8_MMA(0, 1, At, B1); PG8_BAR; PG8_SCHED;
            PG8_LDA(At, 0, 1); PG8_STAGE(PG8_SB(0, 0), b2, voffB); PG8_STAGE(PG8_SB(0, 1), b2 + hB, voffB); PG8_STAGE(PG8_SA(0, 0), a2, voffA);
            PG8_WAIT_V8_OR_24(relax); PG8_WAIT_L(0); PG8_BAR; PG8_MMA(1, 0, At, B0); PG8_MMA(1, 1, At, B1); PG8_BAR; PG8_SCHED;
            PG8_LDB(B0, 1, 0); PG8_LDB(B1, 1, 1); PG8_SCHED; PG8_LDA(At, 1, 0); PG8_STAGE(PG8_SA(0, 1), a2 + hA, voffA);
            PG8_WAIT_V(8); PG8_WAIT_L(0); PG8_BAR; PG8_MMA(0, 0, At, B0); PG8_MMA(0, 1, At, B1); PG8_BAR; PG8_SCHED;
            PG8_LDA(At, 1, 1); PG8_STAGE(PG8_SB(1, 0), b3, voffB); PG8_STAGE(PG8_SB(1, 1), b3 + hB, voffB); PG8_STAGE(PG8_SA(1, 0), a3, voffA);
            PG8_WAIT_V(8); PG8_WAIT_L(0); PG8_BAR; PG8_MMA(1, 0, At, B0); PG8_MMA(1, 1, At, B1); PG8_BAR; PG8_SCHED;
            } else {
            PG8_LDB(B0, 0, 0); PG8_SCHED; PG8_LDA(At, 0, 0); PG8_STAGE(PG8_SA(1, 1), a1 + hA, voffA);
            PG8_WAIT_L(8); PG8_BAR; PG8_WAIT_L(0); PG8_MMA(0, 0, At, B0); PG8_BAR; PG8_SCHED;
            PG8_LDB(B1, 0, 1); PG8_STAGE(PG8_SB(0, 0), b2, voffB);
            PG8_BAR; PG8_WAIT_L(0); PG8_MMA(0, 1, At, B1); PG8_BAR;
            PG8_LDA(At, 0, 1); PG8_STAGE(PG8_SA(0, 0), a2, voffA);
            PG8_BAR; PG8_WAIT_L(0); PG8_MMA(1, 0, At, B0); PG8_BAR; PG8_SCHED;
            PG8_STAGE(PG8_SB(0, 1), b2 + hB, voffB);
            PG8_WAIT_V(6); PG8_BAR; PG8_MMA(1, 1, At, B1); PG8_BAR;
            PG8_LDB(B0, 1, 0); PG8_SCHED; PG8_LDA(At, 1, 0); PG8_STAGE(PG8_SA(0, 1), a2 + hA, voffA);
            PG8_WAIT_L(8); PG8_BAR; PG8_WAIT_L(0); PG8_MMA(0, 0, At, B0); PG8_BAR; PG8_SCHED;
            PG8_LDB(B1, 1, 1); PG8_STAGE(PG8_SB(1, 0), b3, voffB);
            PG8_BAR; PG8_WAIT_L(0); PG8_MMA(0, 1, At, B1); PG8_BAR;
            PG8_LDA(At, 1, 1); PG8_STAGE(PG8_SA(1, 0), a3, voffA);
            PG8_BAR; PG8_WAIT_L(0); PG8_MMA(1, 0, At, B0); PG8_BAR; PG8_SCHED;
            PG8_STAGE(PG8_SB(1, 1), b3 + hB, voffB);
            PG8_WAIT_V(6); PG8_BAR; PG8_MMA(1, 1, At, B1); PG8_BAR;
            }
        }
        if constexpr (ALIGN_EPI) { if (wr == 0) PG8_BAR; }
        if constexpr (!Epi::AFTER_DRAIN) { E(acc, cur, wr, wc, fr, fq, pre); S.done(cur); }
        if (!has_next) break;
#pragma unroll
        for (int a = 0; a < 2; ++a)
#pragma unroll
            for (int b = 0; b < 2; ++b)
#pragma unroll
                for (int m = 0; m < 4; ++m)
#pragma unroll
                    for (int n = 0; n < 2; ++n) acc[a][b][m][n] = (f32x4){0.f, 0.f, 0.f, 0.f};
        cur = nxt; cA = nA; cB = nB; ++ui;
        if constexpr (ALIGN_EPI) { if (wr == 1) PG8_BAR; }
    }
    PG8_WAIT_V(0);
    if constexpr (!ALIGN_EPI) { if (wr == 0) PG8_BAR; }
    PG8_BAR;
    if constexpr (Epi::AFTER_DRAIN) { E.fused(acc, cur, wr, wc, fr, fq, lds, wid, lane); S.done(cur); }
#undef PG8_SA
#undef PG8_SB
#undef PG8_STAGE
#undef PG8_LDA
#undef PG8_LDB
#undef PG8_MMA
#undef PG8_WAIT_V
#undef PG8_WAIT_L
#undef PG8_WAIT_V8_OR_24
#undef PG8_BAR
#undef PG8_SCHED
}
}

constexpr int D = 2048, SEQP = 8192, SEQS = 2048, NBP = 2, NBS = 16, NB = NBP + NBS;
constexpr int MP = NBP * SEQP, MS = NBS * SEQS, M = MP + MS;
constexpr int NH = 18, HD = 128, AW = NH * HD, QKVW = 3 * AW, FF = 4 * D, DEPTH = 4, NMOD = 6;
constexpr float RMS_EPS = 1e-6f, LOG2E = 1.4426950408889634f, LN2 = 0.6931471805599453f;
constexpr int NWAVES = 8;
#ifndef LDU_PAD
#define LDU_PAD 64
#endif
constexpr int LDU = FF + LDU_PAD;

constexpr size_t MiB = 1u << 20;
constexpr size_t WS_CTL = 0, CTL_ZERO_BYTES = 1 * MiB;
constexpr size_t WS_MOD = 1 * MiB;
constexpr size_t WS_CACT = 5 * MiB;
constexpr size_t WS_LSE = 6 * MiB;
constexpr size_t WS_FC = 10 * MiB;
constexpr size_t WS_G = 11 * MiB;
constexpr size_t WS_W = 12 * MiB;
constexpr size_t WS_WQKV = WS_W, WS_WF = WS_W, WS_WO = WS_W + 27 * MiB, WS_W1 = WS_W + 36 * MiB, WS_W2 = WS_W + 68 * MiB;
constexpr size_t WS_HM = 112 * MiB;
constexpr size_t WS_R = 328 * MiB;
constexpr size_t WS_AO = WS_R + 384 * MiB;
constexpr size_t WS_MODP = WS_AO;
constexpr size_t WS_XB = 1104 * MiB;
constexpr size_t WS_END = 1296 * MiB;
static_assert(WS_W2 + (size_t)D * FF * 2 <= WS_HM && WS_HM + (size_t)M * AW * 2 <= WS_R && WS_R + (size_t)M * LDU * 2 <= WS_XB && WS_XB + (size_t)M * D * 2 <= WS_END, "d_ws map");
static_assert((size_t)3 * NH * M * HD * 2 <= WS_XB - WS_R && (size_t)M * 2 * D * 2 <= WS_AO - WS_R && WS_AO + (size_t)M * 2 * D * 2 <= WS_XB, "d_ws map (R)");
constexpr int CW_BAR = 4096;

constexpr int RING_BYTES = 131072;
constexpr int LDS_BYTES = 147456;
constexpr int LDSCTL_OFF = LDS_BYTES - 512, MISC_OFF = LDSCTL_OFF + 320;
constexpr int SCR2_OFF = 65536, SCR2_STRIDE = 8448;
static_assert(SCR2_OFF + 8 * SCR2_STRIDE <= LDSCTL_OFF, "LDS map");

#define GAS __attribute__((address_space(1)))
#define LAS __attribute__((address_space(3)))
typedef unsigned short bf16;
typedef unsigned v4u __attribute__((ext_vector_type(4)));
typedef unsigned v2u __attribute__((ext_vector_type(2)));
typedef float f32x4 __attribute__((ext_vector_type(4)));
typedef float f32x2 __attribute__((ext_vector_type(2)));
typedef float f32x16 __attribute__((ext_vector_type(16)));
typedef short bf16x8 __attribute__((ext_vector_type(8)));
typedef short s16x4 __attribute__((ext_vector_type(4)));
typedef __bf16 bf16x2_t __attribute__((ext_vector_type(2)));
#define LDS_WAIT() asm volatile("s_waitcnt lgkmcnt(0)" ::: "memory")
__device__ __forceinline__ unsigned pk2(float lo, float hi) { f32x2 v = {lo, hi}; bf16x2_t b = __builtin_convertvector(v, bf16x2_t); return __builtin_bit_cast(unsigned, b); }
__device__ __forceinline__ float bf_lo(unsigned w) { return __builtin_bit_cast(float, w << 16); }
__device__ __forceinline__ float bf_hi(unsigned w) { return __builtin_bit_cast(float, w & 0xffff0000u); }
__device__ __forceinline__ float wave_sum(float v) {
#pragma unroll
    for (int o = 1; o < 64; o <<= 1) v += __shfl_xor(v, o);
    return v;
}
__device__ __forceinline__ int batch_of_tile(int pm) { return pm < 64 ? (pm >> 5) : 2 + ((pm - 64) >> 3); }

namespace pg8 {
struct NoPre {};
#ifndef PG8_NT
#define PG8_NT 0
#endif
#if PG8_NT
#define PG8_ST_STREAM(p, v) __builtin_nontemporal_store((v), (p))
#else
#define PG8_ST_STREAM(p, v) (*(p) = (v))
#endif
__device__ __forceinline__ u32x4 tperm16(u32x4 w, int src4) { u32x4 t; t.x = (unsigned)__builtin_amdgcn_ds_bpermute(src4, (int)w.x); t.y = (unsigned)__builtin_amdgcn_ds_bpermute(src4, (int)w.y); t.z = (unsigned)__builtin_amdgcn_ds_bpermute(src4, (int)w.z); t.w = (unsigned)__builtin_amdgcn_ds_bpermute(src4, (int)w.w); return t; }
#define PG8_TLANES(fr, fq) const int lane_ = (fq) * 16 + (fr), src4 = (((lane_ & 3) << 4) + (lane_ >> 2)) << 2, frT = lane_ >> 2, fqT = lane_ & 3
struct EpiQKV {
    static constexpr int NST = 16; static constexpr bool PERM = true, AFTER_DRAIN = false; typedef NoPre Pre;
    __device__ __forceinline__ void prefetch(Pre&, const Unit&, int, int) const {}
    bf16_t* O; float qscale;
    __device__ __forceinline__ void operator()(const f32x4 (&acc)[2][2][4][2], const Unit& u, int wr, int wc, int fr, int fq, const Pre& pre) const {
        PG8_TLANES(fr, fq);
        const int g = u.pn / 9, j = u.pn - 9 * g, which = j / 3, hp = (j - 3 * which) * 2, sh = 2 * g;
        int sstart, t0, lsh;
        if (u.pm < 64) { sstart = (u.pm >> 5) * SEQP; t0 = (u.pm & 31) * 256; lsh = 13 - sh; } else { const int q = u.pm - 64; sstart = MP + (q >> 3) * SEQS; t0 = (q & 7) * 256; lsh = 11 - sh; }
        const float sc = which == 0 ? qscale : 1.f;
#pragma unroll
        for (int ai = 0; ai < 2; ++ai)
#pragma unroll
            for (int m = 0; m < 4; ++m) { const int t = t0 + ai * HALF + wr * 64 + m * 16 + frT, prow = sstart + ((t & ((1 << sh) - 1)) << lsh) + (t >> sh);
#pragma unroll
                for (int bj = 0; bj < 2; ++bj) { const int head = g * 6 + hp + bj;
                    bf16_t* dst = O + ((size_t)(which * NH + head) * M + prow) * HD + wc * 32 + 8 * fqT;
                    const f32x4 v0 = acc[ai][bj][m][0] * sc, v1 = acc[ai][bj][m][1] * sc;
                    u32x4 w; w.x = cvt_pk_bf16(v0[0], v0[1]); w.y = cvt_pk_bf16(v0[2], v0[3]); w.z = cvt_pk_bf16(v1[0], v1[1]); w.w = cvt_pk_bf16(v1[2], v1[3]);
                    PG8_ST_STREAM((u32x4*)dst, tperm16(w, src4)); } }
    }
};
template <bool F32IN> struct EpiRes {
    static constexpr int NST = 16; static constexpr bool PERM = true, AFTER_DRAIN = false; typedef NoPre Pre;
    __device__ __forceinline__ void prefetch(Pre&, const Unit&, int, int) const {}
    const float* xin_p; const float* xin_s; bf16_t* xb; const float* bias; const float* gate;
    __device__ __forceinline__ void operator()(const f32x4 (&acc)[2][2][4][2], const Unit& u, int wr, int wc, int fr, int fq, const Pre& pre) const {
        PG8_TLANES(fr, fq);
        const int b = batch_of_tile(u.pm), col0 = u.pn * BM + wc * 32 + 8 * fq, colT = u.pn * BM + wc * 32 + 8 * fqT, rowT = u.pm * BM + wr * 64 + frT;
        const float* gp = gate + (size_t)b * (NMOD * D) + col0;
        f32x4 gv[2][2], bv[2][2];
#pragma unroll
        for (int bj = 0; bj < 2; ++bj)
#pragma unroll
            for (int n = 0; n < 2; ++n) { gv[bj][n] = *(const f32x4*)(gp + bj * HALF + 4 * n); bv[bj][n] = bias ? *(const f32x4*)(bias + col0 + bj * HALF + 4 * n) : (f32x4){0.f, 0.f, 0.f, 0.f}; }
#pragma unroll
        for (int ai = 0; ai < 2; ++ai) {
            if constexpr (F32IN) {
#pragma unroll
                for (int mh = 0; mh < 4; mh += 2) {
                    f32x4 xf[2][2][2];
#pragma unroll
                    for (int m = 0; m < 2; ++m) { const int row = rowT + ai * HALF + (mh + m) * 16; const float* xi = (row < MP ? xin_p + (size_t)row * D : xin_s + (size_t)(row - MP) * D) + colT;
#pragma unroll
                        for (int bj = 0; bj < 2; ++bj) { xf[m][bj][0] = *(const f32x4*)(xi + bj * HALF); xf[m][bj][1] = *(const f32x4*)(xi + bj * HALF + 4); } }
#pragma unroll
                    for (int m = 0; m < 2; ++m) { bf16_t* xo = xb + (size_t)(rowT + ai * HALF + (mh + m) * 16) * D + colT;
#pragma unroll
                        for (int bj = 0; bj < 2; ++bj) { const f32x4 y0 = gv[bj][0] * (acc[ai][bj][mh + m][0] + bv[bj][0]), y1 = gv[bj][1] * (acc[ai][bj][mh + m][1] + bv[bj][1]);
                            const u32x4 t0 = tperm16(__builtin_bit_cast(u32x4, y0), src4), t1 = tperm16(__builtin_bit_cast(u32x4, y1), src4);
                            const f32x4 v0 = xf[m][bj][0] + __builtin_bit_cast(f32x4, t0), v1 = xf[m][bj][1] + __builtin_bit_cast(f32x4, t1);
                            u32x4 o; o.x = cvt_pk_bf16(v0[0], v0[1]); o.y = cvt_pk_bf16(v0[2], v0[3]); o.z = cvt_pk_bf16(v1[0], v1[1]); o.w = cvt_pk_bf16(v1[2], v1[3]);
                            *(u32x4*)(xo + bj * HALF) = o; } }
                }
            } else {
                u32x4 xw[4][2];
#pragma unroll
                for (int m = 0; m < 4; ++m) { const bf16_t* xi = xb + (size_t)(rowT + ai * HALF + m * 16) * D + colT;
#pragma unroll
                    for (int bj = 0; bj < 2; ++bj) xw[m][bj] = *(const u32x4*)(xi + bj * HALF); }
#pragma unroll
                for (int m = 0; m < 4; ++m) { bf16_t* xo = xb + (size_t)(rowT + ai * HALF + m * 16) * D + colT;
#pragma unroll
                    for (int bj = 0; bj < 2; ++bj) { const u32x4 w = xw[m][bj];
                        const f32x4 x0 = {__builtin_bit_cast(float, w.x << 16), __builtin_bit_cast(float, w.x & 0xffff0000u), __builtin_bit_cast(float, w.y << 16), __builtin_bit_cast(float, w.y & 0xffff0000u)};
                        const f32x4 x1 = {__builtin_bit_cast(float, w.z << 16), __builtin_bit_cast(float, w.z & 0xffff0000u), __builtin_bit_cast(float, w.w << 16), __builtin_bit_cast(float, w.w & 0xffff0000u)};
                        const f32x4 y0 = gv[bj][0] * (acc[ai][bj][m][0] + bv[bj][0]), y1 = gv[bj][1] * (acc[ai][bj][m][1] + bv[bj][1]);
                        const u32x4 t0 = tperm16(__builtin_bit_cast(u32x4, y0), src4), t1 = tperm16(__builtin_bit_cast(u32x4, y1), src4);
                        const f32x4 v0 = x0 + __builtin_bit_cast(f32x4, t0), v1 = x1 + __builtin_bit_cast(f32x4, t1);
                        u32x4 o; o.x = cvt_pk_bf16(v0[0], v0[1]); o.y = cvt_pk_bf16(v0[2], v0[3]); o.z = cvt_pk_bf16(v1[0], v1[1]); o.w = cvt_pk_bf16(v1[2], v1[3]);
                        *(u32x4*)(xo + bj * HALF) = o; } }
            }
        }
    }
};
template <int ACT, bool TILEMAJOR = false> struct EpiBf16 {
    static constexpr int NST = 16; static constexpr bool PERM = true, AFTER_DRAIN = false;
    struct Pre { f32x4 bv[2][2]; };
    bf16_t* O; int ldc; const float* bias; int row_base;
    __device__ __forceinline__ void prefetch(Pre& p, const Unit& u, int wc, int fq) const {
        const int bcol0 = u.pn * BM + wc * 32 + 8 * fq;
#pragma unroll
        for (int bj = 0; bj < 2; ++bj)
#pragma unroll
            for (int n = 0; n < 2; ++n) p.bv[bj][n] = bias ? *(const f32x4*)(bias + bcol0 + bj * HALF + 4 * n) : (f32x4){0.f, 0.f, 0.f, 0.f};
    }
    __device__ __forceinline__ void operator()(const f32x4 (&acc)[2][2][4][2], const Unit& u, int wr, int wc, int fr_in, int fq, const Pre& pre) const {
        int fr = fr_in; asm volatile("" : "+v"(fr));
        PG8_TLANES(fr, fq);
        const int row0 = row_base + u.pm * BM + wr * 64 + frT, col0 = u.pn * BM + wc * 32 + 8 * fqT;
        const f32x4 (&bv)[2][2] = pre.bv;
#pragma unroll
        for (int ai = 0; ai < 2; ++ai)
#pragma unroll
            for (int m = 0; m < 4; ++m) { bf16_t* rowp = TILEMAJOR ? O + ((size_t)u.pm * (ldc / 64) + (u.pn * 4 + (wc >> 1))) * (256 * 64) + (size_t)(wr * 64 + frT + ai * HALF + m * 16) * 64 + (wc & 1) * 32 + 8 * fqT
                                                                   : O + (size_t)(row0 + ai * HALF + m * 16) * ldc + col0;
#pragma unroll
                for (int bj = 0; bj < 2; ++bj) { f32x4 v0 = acc[ai][bj][m][0] + bv[bj][0], v1 = acc[ai][bj][m][1] + bv[bj][1];
                    if (ACT == 1) {
#pragma unroll
                        for (int e = 0; e < 4; ++e) { const float a = fmaxf(v0[e], 0.f), b = fmaxf(v1[e], 0.f); v0[e] = a * a; v1[e] = b * b; } }
                    u32x4 w; w.x = cvt_pk_bf16(v0[0], v0[1]); w.y = cvt_pk_bf16(v0[2], v0[3]); w.z = cvt_pk_bf16(v1[0], v1[1]); w.w = cvt_pk_bf16(v1[2], v1[3]);
                    PG8_ST_STREAM((u32x4*)(rowp + (TILEMAJOR ? bj * 2 * (256 * 64) : bj * HALF)), tperm16(w, src4)); } }
    }
};
struct EpiZT {
    static constexpr int NST = 0; static constexpr bool PERM = true, AFTER_DRAIN = false; typedef NoPre Pre;
    __device__ __forceinline__ void prefetch(Pre&, const Unit&, int, int) const {}
    bf16_t* ZT; int seq0, S, N2;
    __device__ __forceinline__ void operator()(const f32x4 (&acc)[2][2][4][2], const Unit& u, int wr, int wc, int fr, int fq, const Pre& pre) const {
        PG8_TLANES(fr, fq);
        const int part = u.pm & 1, z = u.pm >> 1, b = z >> 3, g = z & 7;
        bf16_t* base = ZT + (size_t)4096 * (seq0 + b * S) + ((size_t)(g * 256 + wr * 64 + frT) * N2 + u.pn) * 512 + part * 256 + wc * 32 + 8 * fqT;
#pragma unroll
        for (int ai = 0; ai < 2; ++ai)
#pragma unroll
            for (int m = 0; m < 4; ++m) { bf16_t* rowp = base + (size_t)(ai * HALF + m * 16) * N2 * 512;
#pragma unroll
                for (int bj = 0; bj < 2; ++bj) { const f32x4 v0 = acc[ai][bj][m][0], v1 = acc[ai][bj][m][1];
                    u32x4 w; w.x = cvt_pk_bf16(v0[0], v0[1]); w.y = cvt_pk_bf16(v0[2], v0[3]); w.z = cvt_pk_bf16(v1[0], v1[1]); w.w = cvt_pk_bf16(v1[2], v1[3]);
                    PG8_ST_STREAM((u32x4*)(rowp + bj * HALF), tperm16(w, src4)); } }
    }
};
struct EpiAO {
    static constexpr int NST = 0; static constexpr bool PERM = true, AFTER_DRAIN = false; typedef NoPre Pre;
    __device__ __forceinline__ void prefetch(Pre&, const Unit&, int, int) const {}
    bf16_t* AO; int seq0, S, N2;
    __device__ __forceinline__ void operator()(const f32x4 (&acc)[2][2][4][2], const Unit& u, int wr, int wc, int fr, int fq, const Pre& pre) const {
        PG8_TLANES(fr, fq);
        const int part = u.pm & 1, b = u.pm >> 1, n2 = u.pn >> 3, cb = u.pn & 7;
        bf16_t* base = AO + (size_t)4096 * (seq0 + b * S) + ((size_t)(part * 256 + wr * 64 + frT) * N2 + n2) * 2048 + cb * 256 + wc * 32 + 8 * fqT;
#pragma unroll
        for (int ai = 0; ai < 2; ++ai)
#pragma unroll
            for (int m = 0; m < 4; ++m) { bf16_t* rowp = base + (size_t)(ai * HALF + m * 16) * N2 * 2048;
#pragma unroll
                for (int bj = 0; bj < 2; ++bj) { const f32x4 v0 = acc[ai][bj][m][0], v1 = acc[ai][bj][m][1];
                    u32x4 w; w.x = cvt_pk_bf16(v0[0], v0[1]); w.y = cvt_pk_bf16(v0[2], v0[3]); w.z = cvt_pk_bf16(v1[0], v1[1]); w.w = cvt_pk_bf16(v1[2], v1[3]);
                    PG8_ST_STREAM((u32x4*)(rowp + bj * HALF), tperm16(w, src4)); } }
    }
};
struct EpiNull {
    static constexpr int NST = 0; static constexpr bool PERM = true, AFTER_DRAIN = false; typedef NoPre Pre;
    __device__ __forceinline__ void prefetch(Pre&, const Unit&, int, int) const {}
    __device__ __forceinline__ void operator()(const f32x4 (&acc)[2][2][4][2], const Unit&, int, int, int, int, const Pre&) const {
#pragma unroll
        for (int a = 0; a < 2; ++a)
#pragma unroll
            for (int b = 0; b < 2; ++b)
#pragma unroll
                for (int m = 0; m < 4; ++m)
#pragma unroll
                    for (int n = 0; n < 2; ++n) asm volatile("" :: "v"(acc[a][b][m][n]));
    }
};
}

#ifndef PG8_SP2
#define PG8_SP2 true
#endif
#ifndef PG8_ALIGN
#define PG8_ALIGN true
#endif

#define XB_TMO      128
#define XB_XCNT(j)  (256  + 64 * (j))
#define XB_XSUB(j)  (1280 + 64 * (j))
#define XB_XGEN(j)  (2304 + 64 * (j))
#define XB_TOP      3328
#define XB_TOPGEN   3392
#define XCD_BAR_WORDS 3456
#define XB_SPIN_CAP (1u << 18)

__device__ __forceinline__ unsigned xb_ld(unsigned* p)              { return __hip_atomic_load(p, __ATOMIC_RELAXED, __HIP_MEMORY_SCOPE_AGENT); }
__device__ __forceinline__ unsigned xb_add(unsigned* p, unsigned v) { return __hip_atomic_fetch_add(p, v, __ATOMIC_RELAXED, __HIP_MEMORY_SCOPE_AGENT); }
__device__ __forceinline__ unsigned xb_xcc_id() { return (unsigned)__builtin_amdgcn_s_getreg((3 << 11) | 20) & 0xFu; }
#define XB_SPIN(cond, bar) do { unsigned _sp = 0; while (cond) { __builtin_amdgcn_s_sleep(1); \
    if ((++_sp & 255u) == 0u) { if (xb_ld(&(bar)[XB_TMO])) break; if (_sp > XB_SPIN_CAP) { atomicAdd(&(bar)[XB_TMO], 1u); break; } } } } while (0)

struct XcdBarrier {
    unsigned* bar; unsigned x;
    volatile LAS unsigned* st;
};

__device__ __forceinline__ XcdBarrier xcd_barrier_post(unsigned* bar, volatile LAS unsigned* st) {
    XcdBarrier b; b.bar = bar; b.x = xb_xcc_id(); b.st = st;
    if (threadIdx.x == 0) (void)xb_add(&bar[XB_XCNT(b.x)], 1u);
    return b;
}
__device__ __forceinline__ void xcd_barrier_complete(unsigned* bar, unsigned x, unsigned& nloc, unsigned& nx) {
    const unsigned G = gridDim.x * gridDim.y * gridDim.z;
    unsigned sum, cnt, mine, sp = 0u;
    for (;;) {
        sum = 0u; cnt = 0u; mine = 0u;
#pragma unroll
        for (unsigned j = 0; j < 16; ++j) { const unsigned c = xb_ld(&bar[XB_XCNT(j)]); sum += c; cnt += (c > 0u) ? 1u : 0u; mine = (j == x) ? c : mine; }
        if (sum == G) break;
        __builtin_amdgcn_s_sleep(1);
        if ((++sp & 255u) == 0u) { if (xb_ld(&bar[XB_TMO])) break; if (sp > XB_SPIN_CAP) { atomicAdd(&bar[XB_TMO], 1u); break; } }
    }
    nloc = mine > 0u ? mine : 1u; nx = cnt > 0u ? cnt : 1u;
}

__device__ __forceinline__ void xcd_barrier(const XcdBarrier& b) {
    asm volatile("s_waitcnt vmcnt(0)" ::: "memory");
    __syncthreads();
    if (threadIdx.x == 0) {
        unsigned* bar = b.bar;
        __builtin_amdgcn_s_waitcnt(0);
        unsigned nloc = b.st[0], nx = b.st[1];
        if (nloc == 0u) { xcd_barrier_complete(bar, b.x, nloc, nx); b.st[0] = nloc; b.st[1] = nx; }
        const unsigned old = xb_add(&bar[XB_XSUB(b.x)], 1u);
        const unsigned gen = old / nloc;
        if (old + 1u == (gen + 1u) * nloc) {
            __builtin_amdgcn_fence(__ATOMIC_RELEASE, "agent");
            asm volatile("s_waitcnt vmcnt(0)" ::: "memory");
            const unsigned og = xb_add(&bar[XB_TOP], 1u);
            const unsigned tg = og / nx;
            if (og + 1u == (tg + 1u) * nx) xb_add(&bar[XB_TOPGEN], 1u);
            else XB_SPIN(xb_ld(&bar[XB_TOPGEN]) == tg, bar);
            __builtin_amdgcn_fence(__ATOMIC_ACQUIRE, "agent");
            xb_add(&bar[XB_XGEN(b.x)], 1u);
            asm volatile("s_waitcnt vmcnt(0)" ::: "memory");
        } else {
            XB_SPIN(xb_ld(&bar[XB_XGEN(b.x)]) == gen, bar);
            __builtin_amdgcn_fence(__ATOMIC_ACQUIRE, "agent");
            asm volatile("s_waitcnt vmcnt(0)" ::: "memory");
        }
    }
    __syncthreads();
}


__device__ __forceinline__ void transpose_item(const float* W, int K, int N, bf16* WT, LAS float* scr, int item, int lane) {
    const int nblk = N / 32, kb = item / nblk, nb = item % nblk, k0 = 64 * kb, n0 = 32 * nb;
    float wv[32];
#pragma unroll
    for (int i = 0; i < 32; ++i) wv[i] = W[(size_t)(k0 + 2 * i + (lane >> 5)) * N + n0 + (lane & 31)];
#pragma unroll
    for (int i = 0; i < 32; ++i) scr[(2 * i + (lane >> 5)) * 33 + (lane & 31)] = wv[i];
    LDS_WAIT(); asm volatile("" ::: "memory");
    const int c = lane & 7;
#pragma unroll
    for (int j = 0; j < 4; ++j) { const int n = (lane >> 3) + 8 * j; const LAS float* s = scr + (8 * c) * 33 + n;
        v4u o; o.x = pk2(s[0 * 33], s[1 * 33]); o.y = pk2(s[2 * 33], s[3 * 33]); o.z = pk2(s[4 * 33], s[5 * 33]); o.w = pk2(s[6 * 33], s[7 * 33]);
        *(GAS v4u*)(WT + (size_t)(n0 + n) * K + k0 + 8 * c) = o; }
    LDS_WAIT(); asm volatile("" ::: "memory");
}

__device__ __forceinline__ void norm_chunk(const float* xrow0, bf16* hrow0, const float* gain, const float* shift, const float* scale, int lane) {
    f32x4 A[8], B[8];
#pragma unroll
    for (int j = 0; j < 8; ++j) { const int col = 4 * lane + 256 * j; const f32x4 gn = *(const f32x4*)(gain + col), sc = *(const f32x4*)(scale + col); A[j] = gn * (sc + 1.0f); B[j] = *(const f32x4*)(shift + col); }
    for (int rr = 0; rr < 8; ++rr) {
        const GAS f32x4* xr = (const GAS f32x4*)(xrow0 + (size_t)rr * D) + lane;
        f32x4 v[8]; float ss = 0.f;
#pragma unroll
        for (int j = 0; j < 8; ++j) { v[j] = xr[64 * j]; ss += (v[j].x * v[j].x + v[j].y * v[j].y) + (v[j].z * v[j].z + v[j].w * v[j].w); }
        const float rstd = 1.0f / sqrtf(wave_sum(ss) * (1.0f / D) + RMS_EPS);
        GAS v2u* o8 = (GAS v2u*)(hrow0 + (size_t)rr * D) + lane;
#pragma unroll
        for (int j = 0; j < 8; ++j) { const f32x4 y = (v[j] * rstd) * A[j] + B[j]; v2u w; w.x = pk2(y.x, y.y); w.y = pk2(y.z, y.w); o8[64 * j] = w; }
    }
}

__device__ __forceinline__ void norm_chunk_b(const bf16* xrow0, bf16* hrow0, const float* gain, const float* shift, const float* scale, int lane) {
    f32x4 A[4][2], B[4][2];
#pragma unroll
    for (int j = 0; j < 4; ++j)
#pragma unroll
        for (int e = 0; e < 2; ++e) { const int col = 8 * lane + 512 * j + 4 * e; const f32x4 gn = *(const f32x4*)(gain + col), sc = *(const f32x4*)(scale + col); A[j][e] = gn * (sc + 1.0f); B[j][e] = *(const f32x4*)(shift + col); }
#pragma unroll 1
    for (int r4 = 0; r4 < 8; r4 += 4) {
        v4u w[4][4];
#pragma unroll
        for (int rr = 0; rr < 4; ++rr) { const GAS v4u* xr = (const GAS v4u*)(xrow0 + (size_t)(r4 + rr) * D) + lane;
#pragma unroll
            for (int j = 0; j < 4; ++j) w[rr][j] = xr[64 * j]; }
#pragma unroll
        for (int rr = 0; rr < 4; ++rr) {
            f32x4 v[4][2]; float ss = 0.f;
#pragma unroll
            for (int j = 0; j < 4; ++j) { const v4u q = w[rr][j];
                v[j][0] = (f32x4){bf_lo(q.x), bf_hi(q.x), bf_lo(q.y), bf_hi(q.y)}; v[j][1] = (f32x4){bf_lo(q.z), bf_hi(q.z), bf_lo(q.w), bf_hi(q.w)};
#pragma unroll
                for (int e = 0; e < 2; ++e) ss += (v[j][e].x * v[j][e].x + v[j][e].y * v[j][e].y) + (v[j][e].z * v[j][e].z + v[j][e].w * v[j][e].w); }
            const float rstd = 1.0f / sqrtf(wave_sum(ss) * (1.0f / D) + RMS_EPS);
            GAS v4u* o16 = (GAS v4u*)(hrow0 + (size_t)(r4 + rr) * D) + lane;
#pragma unroll
            for (int j = 0; j < 4; ++j) { const f32x4 y0 = (v[j][0] * rstd) * A[j][0] + B[j][0], y1 = (v[j][1] * rstd) * A[j][1] + B[j][1];
                v4u o; o.x = pk2(y0.x, y0.y); o.y = pk2(y0.z, y0.w); o.z = pk2(y1.x, y1.y); o.w = pk2(y1.z, y1.w); o16[64 * j] = o; }
        }
    }
}

__device__ __forceinline__ unsigned vimg_off(unsigned row, unsigned ch) { return 256u * row + 16u * (ch ^ (((row & 3) << 2) | ((row >> 2) & 3))); }
__device__ __forceinline__ s16x4 vtr(LAS unsigned char* p) { return __builtin_bit_cast(s16x4, __builtin_amdgcn_ds_read_tr16_b64_v4i16((LAS s16x4*)p)); }
#define MFMA32(a, b, c) __builtin_amdgcn_mfma_f32_32x32x16_bf16((a), (b), (c), 0, 0, 0)

__device__ __forceinline__ void attn_wave_unit(int w, LAS unsigned char* wl, const bf16* QKV, bf16* mixed, float* lse, int lane_in) {
    int lane = lane_in; asm volatile("" : "+v"(lane));
    const int n = lane & 31, h = lane >> 5, lrow = lane >> 4, lch = lane & 15;
    LAS unsigned char* kl = wl; LAS unsigned char* vl = wl + 8192;
    const int g = w / 9216; int w1 = w - g * 9216;
    int hh, w3, lsh, sstart;
    if (w1 < 3072) { const int bb = w1 / 1536, w2 = w1 - bb * 1536; hh = w2 >> 8; w3 = w2 & 255; sstart = bb * SEQP; lsh = 13 - 2 * g; }
    else { w1 -= 3072; const int bb = w1 / 384, w2 = w1 - bb * 384; hh = w2 >> 6; w3 = w2 & 63; sstart = MP + bb * SEQS; lsh = 11 - 2 * g; }
    const int head = g * 6 + hh, L = 1 << lsh, pos0 = w3 * 32, r = pos0 >> lsh, u0 = pos0 & (L - 1), seqlo = sstart + (r << lsh);
    const bf16* Qh = QKV + ((size_t)(0 * NH + head) * M + seqlo) * HD;
    const bf16* Kh = QKV + ((size_t)(1 * NH + head) * M + seqlo) * HD;
    const bf16* Vh = QKV + ((size_t)(2 * NH + head) * M + seqlo) * HD;
#define ATT_LDBLK(dst, base, ubase) do { _Pragma("unroll") for (int i = 0; i < 8; ++i) { int ku_ = (ubase) + lrow + 4 * i; ku_ = ku_ < 0 ? 0 : (ku_ > L - 1 ? L - 1 : ku_); \
        dst[i] = *(const GAS v4u*)((const GAS unsigned char*)(base) + (unsigned)(ku_ * 256 + lch * 16)); } } while (0)
#define ATT_STBLK(img, src) do { _Pragma("unroll") for (int i = 0; i < 8; ++i) *(LAS v4u*)((img) + vimg_off((unsigned)(lrow + 4 * i), (unsigned)lch)) = src[i]; } while (0)
    v4u ra[8], rb[8];
    ATT_LDBLK(ra, Qh, u0);
    ATT_STBLK(kl, ra);
    asm volatile("s_waitcnt lgkmcnt(0)" ::: "memory");
    ATT_LDBLK(ra, Kh, u0 - 64);
    bf16x8 qf[8];
#pragma unroll
    for (int ks = 0; ks < 8; ++ks) qf[ks] = *(const LAS bf16x8*)(kl + vimg_off((unsigned)n, (unsigned)(2 * ks + h)));
    asm volatile("s_waitcnt lgkmcnt(0)" ::: "memory");
    const float slope2 = exp2f(-8.0f * (float)(head + 1) / 18.0f) * (float)(1 << (2 * g)) * LOG2E;
    f32x16 s[5];
#pragma unroll
    for (int kb = 0; kb < 5; ++kb) {
        LAS unsigned char* img = ((kb + 1) & 1) ? vl : kl;
        ATT_STBLK(img, ra);
        asm volatile("s_waitcnt lgkmcnt(0)" ::: "memory");
        if (kb + 1 < 5) ATT_LDBLK(ra, Kh, u0 - 64 + 32 * (kb + 1));
        asm volatile("" ::: "memory");
        f32x16 acc;
#pragma unroll
        for (int i = 0; i < 16; ++i) acc[i] = 0.f;
#pragma unroll
        for (int kh = 0; kh < 4; ++kh) { bf16x8 kf[2];
#pragma unroll
            for (int k4 = 0; k4 < 2; ++k4) kf[k4] = *(const LAS bf16x8*)(img + vimg_off((unsigned)n, (unsigned)(2 * (2 * kh + k4) + h)));
#pragma unroll
            for (int k4 = 0; k4 < 2; ++k4) acc = MFMA32(kf[k4], qf[2 * kh + k4], acc);
            asm volatile("" ::: "memory"); }
        asm volatile("s_waitcnt lgkmcnt(0)" ::: "memory");
#pragma unroll
        for (int i = 0; i < 16; ++i) {
            const int krow = (i & 3) + 8 * (i >> 2) + 4 * h, kuu = u0 - 64 + 32 * kb + krow, du = -64 + 32 * kb + krow - n;
            bool ok = (unsigned)kuu < (unsigned)L;
            if (kb == 0) ok = ok && (du >= -64);
            if (kb == 4) ok = ok && (du <= 64);
            s[kb][i] = ok ? acc[i] - slope2 * fabsf((float)du) : -1e30f;
        }
    }
    asm volatile("" ::: "memory");
    ATT_LDBLK(rb, Vh, u0 - 64); ATT_LDBLK(ra, Vh, u0 - 64 + 32);
    asm volatile("" ::: "memory");
    float mx = -1e30f;
#pragma unroll
    for (int kb = 0; kb < 5; ++kb)
#pragma unroll
        for (int i = 0; i < 16; ++i) mx = fmaxf(mx, s[kb][i]);
    mx = fmaxf(mx, __shfl_xor(mx, 32));
    float lsum = 0.f;
    v4u pw[5][2];
#pragma unroll
    for (int kb = 0; kb < 5; ++kb)
#pragma unroll
        for (int s2 = 0; s2 < 2; ++s2) { float p[8];
#pragma unroll
            for (int e = 0; e < 8; ++e) { p[e] = __builtin_amdgcn_exp2f(s[kb][8 * s2 + e] - mx); lsum += p[e]; }
            pw[kb][s2].x = pk2(p[0], p[1]); pw[kb][s2].y = pk2(p[2], p[3]); pw[kb][s2].z = pk2(p[4], p[5]); pw[kb][s2].w = pk2(p[6], p[7]); }
    lsum += __shfl_xor(lsum, 32);
    f32x16 o[4];
#pragma unroll
    for (int c = 0; c < 4; ++c)
#pragma unroll
        for (int i = 0; i < 16; ++i) o[c][i] = 0.f;
    const unsigned q4 = (lane & 15) >> 2, p4 = lane & 3, blk = (lane >> 4) & 1;
#pragma unroll
    for (int kb = 0; kb < 5; ++kb) {
        LAS unsigned char* img = (kb & 1) ? vl : kl;
        if (kb & 1) ATT_STBLK(img, ra); else ATT_STBLK(img, rb);
        asm volatile("s_waitcnt lgkmcnt(0)" ::: "memory");
        if (kb + 2 < 5) { if (kb & 1) ATT_LDBLK(ra, Vh, u0 - 64 + 32 * (kb + 2)); else ATT_LDBLK(rb, Vh, u0 - 64 + 32 * (kb + 2)); }
        asm volatile("" ::: "memory");
#pragma unroll
        for (int s2 = 0; s2 < 2; ++s2) {
            const bf16x8 pf = __builtin_bit_cast(bf16x8, pw[kb][s2]);
#pragma unroll
            for (int c = 0; c < 4; ++c) {
                const unsigned ch = 4 * c + 2 * blk + (p4 >> 1);
                const s16x4 lo = vtr(img + vimg_off(16 * s2 + 0 + 4 * h + q4, ch) + 8 * (p4 & 1));
                const s16x4 hi = vtr(img + vimg_off(16 * s2 + 8 + 4 * h + q4, ch) + 8 * (p4 & 1));
                const bf16x8 vf = __builtin_shufflevector(lo, hi, 0, 1, 2, 3, 4, 5, 6, 7);
                o[c] = MFMA32(vf, pf, o[c]);
            }
        }
        asm volatile("s_waitcnt lgkmcnt(0)" ::: "memory");
    }
#undef ATT_LDBLK
#undef ATT_STBLK
    const float inv = 1.0f / lsum;
#pragma unroll
    for (int c = 0; c < 4; ++c)
#pragma unroll
        for (int k4 = 0; k4 < 4; ++k4) { v2u wv; wv.x = pk2(o[c][4 * k4 + 0] * inv, o[c][4 * k4 + 1] * inv); wv.y = pk2(o[c][4 * k4 + 2] * inv, o[c][4 * k4 + 3] * inv);
            *(LAS v2u*)(vl + vimg_off((unsigned)n, (unsigned)(4 * c + k4)) + 8 * h) = wv; }
    asm volatile("s_waitcnt lgkmcnt(0)" ::: "memory");
#pragma unroll
    for (int i = 0; i < 8; ++i) { const int q = lrow + 4 * i; const v4u ov = *(const LAS v4u*)(vl + vimg_off((unsigned)q, (unsigned)lch));
        const int mrow_q = sstart + ((u0 + q) << (2 * g)) + r;
        *(GAS v4u*)(mixed + (size_t)mrow_q * AW + head * HD + 8 * lch) = ov; }
    asm volatile("s_waitcnt lgkmcnt(0)" ::: "memory");
    if (h == 0) { const int mrow = sstart + ((u0 + n) << (2 * g)) + r; lse[(size_t)mrow * NH + head] = (mx + __builtin_amdgcn_logf(lsum)) * LN2; }
}

struct AttGroup { int g, head, sstart, slen, p0g; };
__device__ __forceinline__ AttGroup att_group(int gi) {
    AttGroup a; int w = (27648 / 8 - 1 - gi) * 8; int hh, w3;
    if (w < NBP * 4608) { const int bb = w / 4608, w1 = w - bb * 4608; a.g = w1 / 1536; const int w2 = w1 - a.g * 1536; hh = w2 >> 8; w3 = w2 & 255; a.sstart = bb * SEQP; a.slen = SEQP; }
    else { w -= NBP * 4608; const int bb = w / 1152, w1 = w - bb * 1152; a.g = w1 / 384; const int w2 = w1 - a.g * 384; hh = w2 >> 6; w3 = w2 & 63; a.sstart = MP + bb * SEQS; a.slen = SEQS; }
    a.head = a.g * 6 + hh; a.p0g = w3 * 32; return a;
}
#define ATTG_LD(dst, base, ag) do { _Pragma("unroll") for (int i = 0; i < 12; ++i) { int rr_ = (ag).p0g - 64 + 4 * (12 * wave + i) + (lane >> 4); rr_ = rr_ < 0 ? 0 : (rr_ > (ag).slen - 1 ? (ag).slen - 1 : rr_); \
        dst[i] = *(const GAS v4u*)((const GAS unsigned char*)(base) + (size_t)((ag).sstart + rr_) * 256 + (lane & 15) * 16); } } while (0)
#define ATTG_ST(src) do { _Pragma("unroll") for (int i = 0; i < 12; ++i) { const unsigned rr_ = 4 * (12 * wave + i) + (lane >> 4); \
        *(LAS v4u*)(lds + (rr_ >> 5) * 8192 + vimg_off(rr_ & 31, (unsigned)(lane & 15))) = src[i]; } } while (0)
#define ATTG_BAR() do { asm volatile("s_waitcnt lgkmcnt(0)" ::: "memory"); __builtin_amdgcn_s_barrier(); asm volatile("" ::: "memory"); } while (0)
__device__ __forceinline__ void attn_phase_coop(LAS unsigned char* lds, const bf16* QKV, bf16* mixed, float* lse, int vcu, int G, int wave, int lane_in) {
    constexpr int NGRP = 27648 / 8;
    if (vcu >= NGRP) return;
    int lane = lane_in;
    AttGroup ag = att_group(vcu);
    for (int gi = vcu; gi < NGRP; gi += G) {
        ag = att_group(gi);
        v4u kr[12], vr[12];
        ATTG_LD(kr, QKV + ((size_t)(1 * NH + ag.head) * M) * HD, ag);
        asm volatile("" : "+v"(lane));
        const int n = lane & 31, h = lane >> 5, lrow = lane >> 4, lch = lane & 15;
        const int g = ag.g, head = ag.head, sstart = ag.sstart, lsh = (ag.slen == SEQP ? 13 : 11) - 2 * g, L = 1 << lsh;
        const int pos0 = ag.p0g + 32 * wave, r = pos0 >> lsh, u0 = pos0 & (L - 1);
        ATTG_ST(kr);
        bf16x8 qf[8];
        { const GAS bf16x8* qp = (const GAS bf16x8*)(QKV + ((size_t)(0 * NH + head) * M + sstart + pos0 + n) * HD + 8 * h);
#pragma unroll
          for (int ks = 0; ks < 8; ++ks) qf[ks] = qp[2 * ks]; }
        ATTG_LD(vr, QKV + ((size_t)(2 * NH + head) * M) * HD, ag);
        ATTG_BAR();
        const float slope2 = exp2f(-8.0f * (float)(head + 1) / 18.0f) * (float)(1 << (2 * g)) * LOG2E;
        f32x16 s[5];
#pragma unroll
        for (int kb = 0; kb < 5; ++kb) {
            LAS unsigned char* img = lds + (wave + kb) * 8192;
            f32x16 acc;
#pragma unroll
            for (int i = 0; i < 16; ++i) acc[i] = 0.f;
#pragma unroll
            for (int kh = 0; kh < 4; ++kh) { bf16x8 kf[2];
#pragma unroll
                for (int k4 = 0; k4 < 2; ++k4) kf[k4] = *(const LAS bf16x8*)(img + vimg_off((unsigned)n, (unsigned)(2 * (2 * kh + k4) + h)));
#pragma unroll
                for (int k4 = 0; k4 < 2; ++k4) acc = MFMA32(kf[k4], qf[2 * kh + k4], acc);
                asm volatile("" ::: "memory"); }
#pragma unroll
            for (int i = 0; i < 16; ++i) {
                const int krow = (i & 3) + 8 * (i >> 2) + 4 * h, kuu = u0 - 64 + 32 * kb + krow, du = -64 + 32 * kb + krow - n;
                bool ok = (unsigned)kuu < (unsigned)L;
                if (kb == 0) ok = ok && (du >= -64);
                if (kb == 4) ok = ok && (du <= 64);
                s[kb][i] = ok ? acc[i] - slope2 * fabsf((float)du) : -1e30f;
            }
        }
        float mx = -1e30f;
#pragma unroll
        for (int kb = 0; kb < 5; ++kb)
#pragma unroll
            for (int i = 0; i < 16; ++i) mx = fmaxf(mx, s[kb][i]);
        mx = fmaxf(mx, __shfl_xor(mx, 32));
        float lsum = 0.f;
        v4u pw[5][2];
#pragma unroll
        for (int kb = 0; kb < 5; ++kb)
#pragma unroll
            for (int s2 = 0; s2 < 2; ++s2) { float p[8];
#pragma unroll
                for (int e = 0; e < 8; ++e) { p[e] = __builtin_amdgcn_exp2f(s[kb][8 * s2 + e] - mx); lsum += p[e]; }
                pw[kb][s2].x = pk2(p[0], p[1]); pw[kb][s2].y = pk2(p[2], p[3]); pw[kb][s2].z = pk2(p[4], p[5]); pw[kb][s2].w = pk2(p[6], p[7]); }
        lsum += __shfl_xor(lsum, 32);
        ATTG_BAR();
        ATTG_ST(vr);
        ATTG_BAR();
        f32x16 o[4];
#pragma unroll
        for (int c = 0; c < 4; ++c)
#pragma unroll
            for (int i = 0; i < 16; ++i) o[c][i] = 0.f;
        const unsigned q4 = (lane & 15) >> 2, p4 = lane & 3, blk = (lane >> 4) & 1;
#pragma unroll
        for (int kb = 0; kb < 5; ++kb) {
            LAS unsigned char* img = lds + (wave + kb) * 8192;
#pragma unroll
            for (int s2 = 0; s2 < 2; ++s2) {
                const bf16x8 pf = __builtin_bit_cast(bf16x8, pw[kb][s2]);
#pragma unroll
                for (int c = 0; c < 4; ++c) {
                    const unsigned ch = 4 * c + 2 * blk + (p4 >> 1);
                    const s16x4 lo = vtr(img + vimg_off(16 * s2 + 0 + 4 * h + q4, ch) + 8 * (p4 & 1));
                    const s16x4 hi = vtr(img + vimg_off(16 * s2 + 8 + 4 * h + q4, ch) + 8 * (p4 & 1));
                    const bf16x8 vf = __builtin_shufflevector(lo, hi, 0, 1, 2, 3, 4, 5, 6, 7);
                    o[c] = MFMA32(vf, pf, o[c]);
                }
            }
            asm volatile("" ::: "memory");
        }
        ATTG_BAR();
        LAS unsigned char* ol = lds + wave * 8192;
        const float inv = 1.0f / lsum;
#pragma unroll
        for (int c = 0; c < 4; ++c)
#pragma unroll
            for (int k4 = 0; k4 < 4; ++k4) { v2u wv; wv.x = pk2(o[c][4 * k4 + 0] * inv, o[c][4 * k4 + 1] * inv); wv.y = pk2(o[c][4 * k4 + 2] * inv, o[c][4 * k4 + 3] * inv);
                *(LAS v2u*)(ol + vimg_off((unsigned)n, (unsigned)(4 * c + k4)) + 8 * h) = wv; }
        asm volatile("s_waitcnt lgkmcnt(0)" ::: "memory");
#pragma unroll
        for (int i = 0; i < 8; ++i) { const int q = lrow + 4 * i; const v4u ov = *(const LAS v4u*)(ol + vimg_off((unsigned)q, (unsigned)lch));
            const int mrow_q = sstart + ((u0 + q) << (2 * g)) + r;
            *(GAS v4u*)(mixed + (size_t)mrow_q * AW + head * HD + 8 * lch) = ov; }
        if (h == 0) { const int mrow = sstart + ((u0 + n) << (2 * g)) + r; lse[(size_t)mrow * NH + head] = (mx + __builtin_amdgcn_logf(lsum)) * LN2; }
        ATTG_BAR();
    }
}
#undef ATTG_LD
#undef ATTG_ST
#undef ATTG_BAR

template <int N2> __device__ __forceinline__ void fbc_item(const bf16* AOb, bf16* outb, int k1, int cg, LAS float* tw, int lane) {
    constexpr int S = 256 * N2; constexpr float scale = (N2 == 32) ? 0.17677669529663687f : 0.35355339059327373f;
    for (int idx = lane; idx < N2 * N2; idx += 64) { const int n2 = idx / N2, k2 = idx % N2; const float ph = (float)((n2 * (k1 + 256 * k2)) & (S - 1)) * (1.0f / S);
        *(LAS f32x2*)(tw + 2 * idx) = (f32x2){__builtin_amdgcn_cosf(ph) * scale, __builtin_amdgcn_sinf(ph) * scale}; }
    asm volatile("s_waitcnt lgkmcnt(0)" ::: "memory");
    for (int ch = 0; ch < 2; ++ch) {
        const int col = (cg * 2 + ch) * 256 + lane * 4;
        const GAS v2u* pr = (const GAS v2u*)(AOb + ((size_t)k1 * N2) * 2048 + col);
        const GAS v2u* pi = (const GAS v2u*)(AOb + ((size_t)(256 + k1) * N2) * 2048 + col);
        f32x4 acc[N2];
#pragma unroll
        for (int k2 = 0; k2 < N2; ++k2) acc[k2] = (f32x4){0.f, 0.f, 0.f, 0.f};
#pragma unroll 1
        for (int n2b = 0; n2b < N2; n2b += 8) {
            v2u rr[8], ii[8];
#pragma unroll
            for (int q = 0; q < 8; ++q) { rr[q] = pr[(size_t)(n2b + q) * 512]; ii[q] = pi[(size_t)(n2b + q) * 512]; }
#pragma unroll
            for (int q = 0; q < 8; ++q) { asm volatile("" ::: "memory"); const int n2 = n2b + q; const v2u r = rr[q], im = ii[q];
            const f32x4 xr = {bf_lo(r.x), bf_hi(r.x), bf_lo(r.y), bf_hi(r.y)}, xi = {bf_lo(im.x), bf_hi(im.x), bf_lo(im.y), bf_hi(im.y)};
#pragma unroll
            for (int k2 = 0; k2 < N2; ++k2) { const f32x2 cs = *(const LAS f32x2*)(tw + 2 * (n2 * N2 + k2)); acc[k2] += xr * cs.x + xi * cs.y; }
            }
        }
#pragma unroll
        for (int k2 = 0; k2 < N2; ++k2) { v2u w; w.x = pk2(acc[k2].x, acc[k2].y); w.y = pk2(acc[k2].z, acc[k2].w); *(GAS v2u*)(outb + (size_t)(k1 + 256 * k2) * D + col) = w; }
    }
    asm volatile("s_waitcnt lgkmcnt(0)" ::: "memory");
}

struct Args { const float* in[17]; float* out; unsigned char* ws; };
typedef const Args __attribute__((address_space(4)))* KArgs;
__device__ __forceinline__ KArgs kargs() { KArgs p = (KArgs)__builtin_amdgcn_kernarg_segment_ptr(); asm volatile("" : "+s"(p)); return p; }
__global__ void __launch_bounds__(NWAVES * 64, 2) fwd(Args args) {
    extern __shared__ __attribute__((aligned(16))) unsigned char lds_raw[];
    LAS unsigned char* lds = (LAS unsigned char*)lds_raw;
    const int wave = __builtin_amdgcn_readfirstlane((int)threadIdx.x >> 6), G = gridDim.x;
#define FRESH_TID(name) int name = threadIdx.x; asm volatile("" : "+v"(name))
    const int gw = blockIdx.x * NWAVES + wave, NGW = G * NWAVES;
    unsigned* ctl = (unsigned*)(kargs()->ws + WS_CTL);
    { FRESH_TID(tid); for (int u = tid; u < (LDS_BYTES - LDSCTL_OFF) / 4; u += NWAVES * 64) ((LAS unsigned*)(lds + LDSCTL_OFF))[u] = 0u; }
    __syncthreads();
    (void)xcd_barrier_post(ctl + CW_BAR, (volatile LAS unsigned*)(lds + MISC_OFF) + 8);
#ifdef PROBE_STAMP
    int stamp_idx = 0;
#define STAMPS() ((unsigned long long*)(kargs()->ws + WS_CTL + 524288))
#define GRID_BAR() do { if (blockIdx.x == 0 && threadIdx.x == 0) STAMPS()[2 * stamp_idx] = __builtin_amdgcn_s_memrealtime(); GRID_BAR_() ; if (blockIdx.x == 0 && threadIdx.x == 0) STAMPS()[2 * stamp_idx + 1] = __builtin_amdgcn_s_memrealtime(); ++stamp_idx; } while (0)
#elif defined(PROBE_DOUBLE_BAR)
#define GRID_BAR() do { GRID_BAR_(); GRID_BAR_(); } while (0)
#else
#define GRID_BAR() GRID_BAR_()
#endif
#define GRID_BAR_() do { XcdBarrier bar_; bar_.bar = (unsigned*)(kargs()->ws + WS_CTL) + CW_BAR; bar_.x = xb_xcc_id(); bar_.st = (volatile LAS unsigned*)(lds + MISC_OFF) + 8; xcd_barrier(bar_); } while (0)

#define KA() kargs()
#define WSP(off) (KA()->ws + (off))
    LAS float* scr = (LAS float*)(lds + wave * 16384);

    { FRESH_TID(tid); const float* c_p = KA()->in[2]; const float* c_s = KA()->in[3]; float* cact = (float*)WSP(WS_CACT);
    for (int idx = blockIdx.x * (NWAVES * 64) + tid; idx < D * 20; idx += G * NWAVES * 64) {
        const int k = idx / 20, b = idx - 20 * k; float v = 0.f;
        if (b < NBP) v = c_p[b * D + k]; else if (b < NB) v = c_s[(b - NBP) * D + k];
        cact[idx] = v / (1.0f + __expf(-v));
    } }
    GRID_BAR();

    {
        FRESH_TID(tid_); const int lane = tid_ & 63;
        const float* w_ada = KA()->in[4]; float* modp = (float*)WSP(WS_MODP); const float* cact = (const float*)WSP(WS_CACT);
        bf16* FC = (bf16*)WSP(WS_FC); bf16* GM = (bf16*)WSP(WS_G);
        constexpr int N_MOD = DEPTH * 48 * 8, N_G = 64, N_FC = 32, N_ALL = N_MOD + N_G + N_FC;
        for (int it = gw; it < N_ALL; it += NGW) {
            if (it < N_MOD) {
#ifndef SKIP_MOD
                const int kseg = it & 7, cb = (it >> 3) % 48, layer = it / 384, col = cb * 256 + lane * 4;
                f32x4 acc[NB];
#pragma unroll
                for (int b = 0; b < NB; ++b) acc[b] = (f32x4){0.f, 0.f, 0.f, 0.f};
                const float* wp = w_ada + ((size_t)layer * D + kseg * 256) * (NMOD * D) + col;
                const float* cbase = cact + (kseg * 256) * 20;
#pragma unroll 1
                for (int k0 = 0; k0 < 256; k0 += 8) {
                    f32x4 wv8[8];
#pragma unroll
                    for (int q = 0; q < 8; ++q) wv8[q] = *(const GAS f32x4*)(wp + (size_t)(k0 + q) * (NMOD * D));
#pragma unroll
                    for (int q = 0; q < 8; ++q) { asm volatile("" ::: "memory");
                        const f32x4 wv = wv8[q]; const GAS f32x4* cp = (const GAS f32x4*)(cbase + (k0 + q) * 20);
                        const f32x4 c0 = cp[0], c1 = cp[1], c2 = cp[2], c3 = cp[3]; const f32x2 c4 = *(const GAS f32x2*)(cp + 4);
                        acc[0] += wv * c0.x; acc[1] += wv * c0.y; acc[2] += wv * c0.z; acc[3] += wv * c0.w;
                        acc[4] += wv * c1.x; acc[5] += wv * c1.y; acc[6] += wv * c1.z; acc[7] += wv * c1.w;
                        acc[8] += wv * c2.x; acc[9] += wv * c2.y; acc[10] += wv * c2.z; acc[11] += wv * c2.w;
                        acc[12] += wv * c3.x; acc[13] += wv * c3.y; acc[14] += wv * c3.z; acc[15] += wv * c3.w;
                        acc[16] += wv * c4.x; acc[17] += wv * c4.y; }
                }
#pragma unroll
                for (int b = 0; b < NB; ++b) *(GAS f32x4*)(modp + (((size_t)kseg * DEPTH + layer) * NB + b) * (NMOD * D) + col) = acc[b];
#endif
            } else if (it < N_MOD + N_G) {
                const int r = it - N_MOD;
#pragma unroll 2
                for (int i = 0; i < 8; ++i) { const int e0 = r * 4096 + i * 512 + lane * 8, row = e0 >> 9, c0 = e0 & 511, part = row >> 8, k1 = row & 255, cpart = c0 >> 8; float f[8];
#pragma unroll
                    for (int e = 0; e < 8; ++e) { const int n1 = (c0 + e) & 255; const float ph = (float)((k1 * n1) & 255) * (1.0f / 256.0f), cs = __builtin_amdgcn_cosf(ph), sn = __builtin_amdgcn_sinf(ph);
                        f[e] = (part == cpart ? cs : (part == 0 ? sn : -sn)) * 0.0625f; }
                    v4u o; o.x = pk2(f[0], f[1]); o.y = pk2(f[2], f[3]); o.z = pk2(f[4], f[5]); o.w = pk2(f[6], f[7]);
                    *(GAS v4u*)(GM + e0) = o; }
            } else {
                const int r = it - N_MOD - N_G;
#pragma unroll 2
                for (int i = 0; i < 8; ++i) { const int e0 = r * 4096 + i * 512 + lane * 8, row = e0 >> 8, c0 = e0 & 255, part = row >> 8, j = row & 255; float f[8];
#pragma unroll
                    for (int e = 0; e < 8; ++e) { const float ph = (float)((j * (c0 + e)) & 255) * (1.0f / 256.0f);
                        f[e] = (part ? -__builtin_amdgcn_sinf(ph) : __builtin_amdgcn_cosf(ph)) * 0.0625f; }
                    v4u o; o.x = pk2(f[0], f[1]); o.y = pk2(f[2], f[3]); o.z = pk2(f[4], f[5]); o.w = pk2(f[6], f[7]);
                    *(GAS v4u*)(FC + e0) = o; }
            }
        }
    }
    GRID_BAR();
    { FRESH_TID(tid); const float* b_ada = KA()->in[5]; float* mod = (float*)WSP(WS_MOD); const float* modp = (const float*)WSP(WS_MODP);
      constexpr int NV = DEPTH * NB * (NMOD * D) / 4;
      for (int i = blockIdx.x * (NWAVES * 64) + tid; i < NV; i += G * NWAVES * 64) {
          const int layer = i / (NB * (NMOD * D) / 4), col4 = i % ((NMOD * D) / 4);
          f32x4 v = ((const GAS f32x4*)(b_ada + (size_t)layer * (NMOD * D)))[col4];
#pragma unroll
          for (int ks = 0; ks < 8; ++ks) v += ((const GAS f32x4*)modp)[(size_t)ks * NV + i];
          ((GAS f32x4*)mod)[i] = v; } }
    GRID_BAR();

#define CONVERT_RANGE(lane_, lo_, hi_, first_, stride_) do { const float* w_o_ = KA()->in[9]; const float* w1_ = KA()->in[12]; const float* w2_ = KA()->in[14]; bf16* WO_ = (bf16*)WSP(WS_WO); bf16* W1_ = (bf16*)WSP(WS_W1); bf16* W2_ = (bf16*)WSP(WS_W2); \
        LAS float* scr2_ = (LAS float*)(lds + CONV_SCR_OFF); const int I_B_ = is_attn ? (AW / 64) * (D / 32) : 0, I_1_ = (D / 64) * (FF / 32), I_2_ = (FF / 64) * (D / 32); \
        const int hi__ = (hi_) < I_B_ + I_1_ + I_2_ ? (hi_) : I_B_ + I_1_ + I_2_; \
        for (int it_ = (lo_) + (first_); it_ < hi__; it_ += (stride_)) { int r_ = it_; \
            if (r_ < I_B_) { transpose_item(w_o_ + (size_t)l2 * AW * D, AW, D, WO_, scr2_, r_, lane_); continue; } r_ -= I_B_; \
            if (r_ < I_1_) { transpose_item(w1_ + (size_t)l * D * FF, D, FF, W1_, scr2_, r_, lane_); continue; } r_ -= I_1_; \
            transpose_item(w2_ + (size_t)l * FF * D, FF, D, W2_, scr2_, r_, lane_); } } while (0)
#ifndef QKV_TAIL_ITEMS
#define QKV_TAIL_ITEMS 12288
#endif
#ifndef REP_CV
#define REP_CV 1
#endif
#define CONVERT_REST(lane_) do { for (int rcv_ = 0; rcv_ < REP_CV; ++rcv_) CONVERT_RANGE(lane_, (is_attn ? QKV_TAIL_ITEMS : 0), 0x7fffffff, gw, NGW); } while (0)
#ifndef PG8_SP2_SHORT
#define PG8_SP2_SHORT false
#endif
#ifndef PG8_ALIGN_WIDE
#define PG8_ALIGN_WIDE PG8_ALIGN
#endif
#ifndef PG8_ALIGN_SHORT
#define PG8_ALIGN_SHORT false
#endif
#ifndef PG8_WGM_WIDE
#define PG8_WGM_WIDE 4
#endif
#ifndef REP_W1
#define REP_W1 1
#endif
#ifndef REP_QKV
#define REP_QKV 1
#endif
#ifndef REP_N
#define REP_N 1
#endif
#ifndef REP_AT
#define REP_AT 1
#endif
#ifndef REP_FB
#define REP_FB 1
#endif
#ifndef REP_F1A
#define REP_F1A 1
#endif
    for (int l = 0; l < DEPTH; ++l) {
        const bool is_attn = (l & 1) == 0; const int l2 = l >> 1;
#define MODL() ((const float*)WSP(WS_MOD) + (size_t)l * NB * (NMOD * D))
        for (int rep_ = 0; rep_ < REP_N; ++rep_) {
            FRESH_TID(tid_); const int lane = tid_ & 63;
            const float* w_qkv = KA()->in[8]; const float* w_f = KA()->in[10]; bf16* WQKV = (bf16*)WSP(WS_WQKV); bf16* WF = (bf16*)WSP(WS_WF);
            const int I_A = is_attn ? (D / 64) * (QKVW / 32) : (D / 64) * (D / 32);
            for (int rcv_ = 0; rcv_ < REP_CV; ++rcv_) for (int it = gw; it < I_A; it += NGW) { if (is_attn) transpose_item(w_qkv + (size_t)l2 * D * QKVW, D, QKVW, WQKV, scr, it, lane); else transpose_item(w_f + (size_t)l2 * D * D, D, D, WF, scr, it, lane); }
            const float* x_p = KA()->in[0]; const float* x_s = KA()->in[1]; const bf16* XB = (const bf16*)WSP(WS_XB); const float* norm1_g = KA()->in[6]; const float* modl = MODL(); bf16* HM = (bf16*)WSP(WS_HM);
            for (int it = gw; it < M / 8; it += NGW) {
                const int row0 = (M / 8 - 1 - it) * 8, b = batch_of_tile(row0 >> 8);
                const float* mb = modl + (size_t)b * (NMOD * D);
                if (l == 0) norm_chunk(row0 < MP ? x_p + (size_t)row0 * D : x_s + (size_t)(row0 - MP) * D, HM + (size_t)row0 * D, norm1_g + l * D, mb, mb + D, lane);
                else norm_chunk_b(XB + (size_t)row0 * D, HM + (size_t)row0 * D, norm1_g + l * D, mb, mb + D, lane);
            }
        }
        GRID_BAR();
        if (is_attn) {
            for (int rep_ = 0; rep_ < REP_QKV; ++rep_) { pg8::GemmDesc g = pg8::plain_gemm(WSP(WS_HM), WSP(WS_WQKV), D, D, D, M / 256); pg8::StaticOrder S; S.init(M / 256, QKVW / 256, G, (int)blockIdx.x, PG8_WGM_WIDE);
              pg8::EpiQKV E{(bf16*)WSP(WS_R), 0.08838834764831845f * LOG2E};
              pg8::gemm_phase<pg8::EpiQKV, pg8::StaticOrder, PG8_ALIGN_WIDE, PG8_SP2>(lds, g, S, E); }
            {
                const int nfull = (M / 256) * (QKVW / 256) - ((M / 256) * (QKVW / 256) / G) * G;
                if ((int)blockIdx.x >= nfull && QKV_TAIL_ITEMS > 0) { FRESH_TID(tid_);
#define CONV_SCR_OFF (wave * 16384)
                    for (int rcv_ = 0; rcv_ < REP_CV; ++rcv_) CONVERT_RANGE(tid_ & 63, 0, QKV_TAIL_ITEMS, ((int)blockIdx.x - nfull) * NWAVES + wave, (G - nfull) * NWAVES);
#undef CONV_SCR_OFF
                } }
            GRID_BAR();
#ifndef SKIP_ATTN
            { FRESH_TID(tid_); const bf16* RB = (const bf16*)WSP(WS_R); bf16* HM = (bf16*)WSP(WS_HM); float* lse = (float*)WSP(WS_LSE);
              const int vcu = (G % 8 == 0) ? ((int)blockIdx.x % 8) * (G / 8) + (int)blockIdx.x / 8 : (int)blockIdx.x;
              for (int rep_ = 0; rep_ < REP_AT; ++rep_) attn_phase_coop(lds, RB, HM, lse, vcu, G, wave, tid_ & 63);
#define CONV_SCR_OFF (wave * 16384)
              CONVERT_REST(tid_ & 63);
#undef CONV_SCR_OFF
            }
#endif
            GRID_BAR();
            { FRESH_TID(tid_); const int lane = tid_ & 63; bf16* HM = (bf16*)WSP(WS_HM); const float* lse = (const float*)WSP(WS_LSE);
            for (int m = gw * 2; m < M; m += NGW * 2) {
                v4u vv[9]; float al[9];
#pragma unroll
                for (int i = 0; i < 9; ++i) { const int cc = lane + 64 * i, rr = cc >= AW / 8 ? 1 : 0, c = cc - rr * (AW / 8), head = c >> 4, hh = head % 6; const float* lr = lse + (size_t)(m + rr) * NH;
                    const float l0 = lr[hh], l1 = lr[6 + hh], l2v = lr[12 + hh], mxl = fmaxf(l0, fmaxf(l1, l2v));
                    const float e0 = __expf(l0 - mxl), e1 = __expf(l1 - mxl), e2 = __expf(l2v - mxl); al[i] = (head < 6 ? e0 : (head < 12 ? e1 : e2)) * __builtin_amdgcn_rcpf(e0 + e1 + e2);
                    vv[i] = *((const GAS v4u*)(HM + (size_t)m * AW) + cc); }
#pragma unroll
                for (int i = 0; i < 9; ++i) { const int cc = lane + 64 * i; const v4u v = vv[i]; const float a = al[i]; v4u o;
                    o.x = pk2(bf_lo(v.x) * a, bf_hi(v.x) * a); o.y = pk2(bf_lo(v.y) * a, bf_hi(v.y) * a); o.z = pk2(bf_lo(v.z) * a, bf_hi(v.z) * a); o.w = pk2(bf_lo(v.w) * a, bf_hi(v.w) * a);
                    *((GAS v4u*)(HM + (size_t)m * AW) + cc) = o; }
            } }
            GRID_BAR();
            if (l == 0) { pg8::GemmDesc g = pg8::plain_gemm(WSP(WS_HM), WSP(WS_WO), AW, AW, AW, M / 256); pg8::StaticOrder S; S.init(M / 256, D / 256, G, (int)blockIdx.x, PG8_WGM, 1);
              pg8::EpiRes<true> E{KA()->in[0], KA()->in[1], (bf16*)WSP(WS_XB), nullptr, MODL() + 2 * D};
              pg8::gemm_phase<pg8::EpiRes<true>, pg8::StaticOrder, PG8_ALIGN, PG8_SP2>(lds, g, S, E); }
            else { pg8::GemmDesc g = pg8::plain_gemm(WSP(WS_HM), WSP(WS_WO), AW, AW, AW, M / 256); pg8::StaticOrder S; S.init(M / 256, D / 256, G, (int)blockIdx.x, PG8_WGM, 1);
              pg8::EpiRes<false> E{nullptr, nullptr, (bf16*)WSP(WS_XB), nullptr, MODL() + 2 * D};
              pg8::gemm_phase<pg8::EpiRes<false>, pg8::StaticOrder, PG8_ALIGN, PG8_SP2>(lds, g, S, E); }
        } else {
            for (int rep_ = 0; rep_ < REP_F1A; ++rep_) { pg8::GemmDesc g{(const char*)WSP(WS_FC), (const char*)WSP(WS_HM), 256, (SEQP / 256) * D, 256, 2, 8, 1, 0, 0, (long long)SEQP * D * 2, 512, (long long)D * 2, 0, 128}; pg8::StaticOrder S; S.init(NBP * 8 * 2, SEQP / 256, G, (int)blockIdx.x);
              pg8::EpiZT E{(bf16*)WSP(WS_R), 0, SEQP, SEQP / 256};
              pg8::gemm_phase<pg8::EpiZT, pg8::StaticOrder, PG8_ALIGN_SHORT, PG8_SP2_SHORT>(lds, g, S, E); }
            for (int rep_ = 0; rep_ < REP_F1A; ++rep_) { pg8::GemmDesc g{(const char*)WSP(WS_FC), (const char*)((bf16*)WSP(WS_HM) + (size_t)MP * D), 256, (SEQS / 256) * D, 256, 2, 8, 1, 0, 0, (long long)SEQS * D * 2, 512, (long long)D * 2, 0, 128}; pg8::StaticOrder S; S.init(NBS * 8 * 2, SEQS / 256, G, (int)blockIdx.x);
              pg8::EpiZT E{(bf16*)WSP(WS_R), MP, SEQS, SEQS / 256};
              pg8::gemm_phase<pg8::EpiZT, pg8::StaticOrder, PG8_ALIGN_SHORT, PG8_SP2_SHORT>(lds, g, S, E); }
            GRID_BAR();
            for (int rep_ = 0; rep_ < REP_F1A; ++rep_) { constexpr int N2 = SEQS / 256; pg8::GemmDesc g{(const char*)WSP(WS_G), (const char*)((bf16*)WSP(WS_R) + (size_t)4096 * MP), 512, N2 * 512, 512, 2, 1, 8, 0, 0, (long long)4096 * SEQS * 2, 0, 1024, (long long)256 * N2 * 1024, 128};
              pg8::StaticOrder S; S.init(NBS * 2, N2 * 8, G, (int)blockIdx.x, PG8_WGM, 1);
              pg8::EpiAO E{(bf16*)WSP(WS_AO), MP, SEQS, N2};
              pg8::gemm_phase<pg8::EpiAO, pg8::StaticOrder, PG8_ALIGN_SHORT, PG8_SP2_SHORT>(lds, g, S, E); }
            for (int rep_ = 0; rep_ < REP_F1A; ++rep_) { constexpr int N2 = SEQP / 256; pg8::GemmDesc g{(const char*)WSP(WS_G), (const char*)WSP(WS_R), 512, N2 * 512, 512, 2, 1, 8, 0, 0, (long long)4096 * SEQP * 2, 0, 1024, (long long)256 * N2 * 1024, 128};
              pg8::StaticOrder S; S.init(NBP * 2, N2 * 8, G, (int)blockIdx.x, PG8_WGM, 1);
              pg8::EpiAO E{(bf16*)WSP(WS_AO), 0, SEQP, N2};
              pg8::gemm_phase<pg8::EpiAO, pg8::StaticOrder, PG8_ALIGN_SHORT, PG8_SP2_SHORT>(lds, g, S, E); }
            GRID_BAR();
            for (int rep_ = 0; rep_ < REP_FB; ++rep_) { FRESH_TID(tid_); const int lane = tid_ & 63; const bf16* AO = (const bf16*)WSP(WS_AO); bf16* HM = (bf16*)WSP(WS_HM); LAS float* tw = (LAS float*)(lds + wave * 8192);
              for (int it = gw; it < NBP * 256 * 4; it += NGW) { const int b = it >> 10, k1 = (it >> 2) & 255, cg = it & 3;
                  fbc_item<SEQP / 256>(AO + (size_t)4096 * (b * SEQP), HM + (size_t)(b * SEQP) * D, k1, cg, tw, lane); }
              for (int it = gw; it < NBS * 256 * 4; it += NGW) { const int b = it >> 10, k1 = (it >> 2) & 255, cg = it & 3;
                  fbc_item<SEQS / 256>(AO + (size_t)4096 * (MP + b * SEQS), HM + (size_t)(MP + b * SEQS) * D, k1, cg, tw, lane); }
#define CONV_SCR_OFF (SCR2_OFF + wave * SCR2_STRIDE)
              if (rep_ == 0) CONVERT_REST(lane);
#undef CONV_SCR_OFF
            }
            GRID_BAR();
            { pg8::GemmDesc g = pg8::plain_gemm(WSP(WS_HM), WSP(WS_WF), D, D, D, M / 256); pg8::StaticOrder S; S.init(M / 256, D / 256, G, (int)blockIdx.x, PG8_WGM, 1);
              pg8::EpiRes<false> E{nullptr, nullptr, (bf16*)WSP(WS_XB), KA()->in[11] + (size_t)l2 * D, MODL() + 2 * D};
              pg8::gemm_phase<pg8::EpiRes<false>, pg8::StaticOrder, PG8_ALIGN, PG8_SP2>(lds, g, S, E); }
        }
        GRID_BAR();
        for (int rep_ = 0; rep_ < REP_N; ++rep_) { FRESH_TID(tid_); const int lane = tid_ & 63; const bf16* XB = (const bf16*)WSP(WS_XB); const float* norm2_g = KA()->in[7]; const float* modl = MODL(); bf16* HM = (bf16*)WSP(WS_HM);
        for (int it = gw; it < M / 8; it += NGW) {
            const int row0 = it * 8, b = batch_of_tile(row0 >> 8);
            const float* mb = modl + (size_t)b * (NMOD * D) + 3 * D;
            norm_chunk_b(XB + (size_t)row0 * D, HM + (size_t)row0 * D, norm2_g + l * D, mb, mb + D, lane);
        } }
        GRID_BAR();
        for (int rep_ = 0; rep_ < REP_W1; ++rep_) { pg8::GemmDesc g = pg8::plain_gemm(WSP(WS_HM), WSP(WS_W1), D, D, D, M / 256); pg8::StaticOrder S; S.init(M / 256, FF / 256, G, (int)blockIdx.x, PG8_WGM_WIDE, 1);
          pg8::EpiBf16<1, true> E{(bf16*)WSP(WS_R), FF, KA()->in[13] + (size_t)l * FF, 0};
          pg8::gemm_phase<pg8::EpiBf16<1, true>, pg8::StaticOrder, PG8_ALIGN_WIDE, PG8_SP2>(lds, g, S, E); }
        GRID_BAR();
#ifdef PROBE_W1NULL
        { pg8::GemmDesc g = pg8::plain_gemm(WSP(WS_HM), WSP(WS_W1), D, D, D, M / 256);
#if PROBE_W1NULL == 2
          g.nMb = 1; g.pB1 = 0;
#endif
 pg8::StaticOrder S; S.init(M / 256, FF / 256, G, (int)blockIdx.x, PG8_WGM_WIDE);
          pg8::EpiNull E{};
          pg8::gemm_phase<pg8::EpiNull, pg8::StaticOrder, PG8_ALIGN, PG8_SP2>(lds, g, S, E); }
#endif
#ifdef PROBE_W2
        { pg8::GemmDesc g = pg8::GemmDesc{(const char*)WSP(WS_R), (const char*)WSP(WS_W2), 64, FF, FF, 1, 1, 1, (long long)FF * 512, 0, 0, 0, 512ll * FF, 0, 32768};     pg8::StaticOrder S; S.init(M / 256, D / 256, G, (int)blockIdx.x);
          pg8::EpiBf16<0> E{(bf16*)WSP(WS_END), D, nullptr, 0};
          pg8::gemm_phase<pg8::EpiBf16<0>, pg8::StaticOrder, PG8_ALIGN, PG8_SP2>(lds, g, S, E); }
#endif
        { pg8::GemmDesc g = pg8::GemmDesc{(const char*)WSP(WS_R), (const char*)WSP(WS_W2), 64, FF, FF, 1, 1, 1, (long long)FF * 512, 0, 0, 0, 512ll * FF, 0, 32768};     pg8::StaticOrder S; S.init(M / 256, D / 256, G, (int)blockIdx.x);
          pg8::EpiRes<false> E{nullptr, nullptr, (bf16*)WSP(WS_XB), KA()->in[15] + (size_t)l * D, MODL() + 5 * D};
          pg8::gemm_phase<pg8::EpiRes<false>, pg8::StaticOrder, PG8_ALIGN, PG8_SP2>(lds, g, S, E); }
        GRID_BAR();
    }
#ifdef PROBE_STAMP
    {
        FRESH_TID(tid); float* yout = KA()->out; const unsigned long long* st = STAMPS();
        float va = 0.f, vb = 0.f;
        for (int k = 0; k < stamp_idx; ++k) { const float work = (k == 0) ? 0.f : (float)(st[2 * k] - st[2 * k - 1]) * 0.01f, wait = (float)(st[2 * k + 1] - st[2 * k]) * 0.01f;
            if (PROBE_SEL_A(k, 0)) va += work; if (PROBE_SEL_A(k, 1)) va += wait; if (PROBE_SEL_B(k, 0)) vb += work; if (PROBE_SEL_B(k, 1)) vb += wait; }
        va = __builtin_exp2f(rintf(__builtin_log2f(fmaxf(va, 1.f)) * 2.0600f) / 2.0600f); vb = __builtin_exp2f(rintf(__builtin_log2f(fmaxf(vb, 1.f)) * 2.0600f) / 2.0600f);
        const float cval = sqrtf(vb);
        for (size_t i = (size_t)blockIdx.x * (NWAVES * 64) + tid; i < (size_t)M * D; i += (size_t)G * NWAVES * 64) yout[i] = (i < (size_t)MP * D / 4) ? cval : (i == (size_t)MP * D ? va : 0.f);
        return;
    }
#endif
    FRESH_TID(tid_); const int lane = tid_ & 63; float* yout = KA()->out; const bf16* XB = (const bf16*)WSP(WS_XB); const float* final_g = KA()->in[16];
    for (int mf = gw; mf < M; mf += NGW) { const int m = M - 1 - mf;
        const GAS v4u* xr = (const GAS v4u*)(XB + (size_t)m * D) + lane;
        f32x4 v[4][2]; float ss = 0.f;
#pragma unroll
        for (int j = 0; j < 4; ++j) { const v4u w = xr[64 * j];
            v[j][0] = (f32x4){bf_lo(w.x), bf_hi(w.x), bf_lo(w.y), bf_hi(w.y)}; v[j][1] = (f32x4){bf_lo(w.z), bf_hi(w.z), bf_lo(w.w), bf_hi(w.w)};
#pragma unroll
            for (int e = 0; e < 2; ++e) ss += (v[j][e].x * v[j][e].x + v[j][e].y * v[j][e].y) + (v[j][e].z * v[j][e].z + v[j][e].w * v[j][e].w); }
        const float rstd = 1.0f / sqrtf(wave_sum(ss) * (1.0f / D) + RMS_EPS);
#pragma unroll
        for (int j = 0; j < 4; ++j)
#pragma unroll
            for (int e = 0; e < 2; ++e) { const int col = 8 * lane + 512 * j + 4 * e; *(GAS f32x4*)(yout + (size_t)m * D + col) = (v[j][e] * rstd) * *(const f32x4*)(final_g + col); }
    }
}

extern "C" void kernel_launch(void* const* d_in, const int* in_sizes, int n_in, void* d_out, int out_size, void* d_ws, size_t ws_size, hipStream_t stream) {
    static int grid = 0;
    if (grid == 0) {
        if (n_in != 17 || out_size != M * D || ws_size < WS_END) { fprintf(stderr, "kernel_launch: unexpected shapes (n_in %d, out %d, ws %zu < %zu); nothing launched\n", n_in, out_size, ws_size, (size_t)WS_END); grid = -1; return; }
        int dev = 0, cus = 0, per_cu = 0;
        if (hipGetDevice(&dev) != hipSuccess || hipDeviceGetAttribute(&cus, hipDeviceAttributeMultiprocessorCount, dev) != hipSuccess) { grid = -1; return; }
        if (hipFuncSetAttribute((const void*)fwd, hipFuncAttributeMaxDynamicSharedMemorySize, LDS_BYTES) != hipSuccess) { fprintf(stderr, "kernel_launch: hipFuncSetAttribute failed\n"); grid = -1; return; }
        if (hipOccupancyMaxActiveBlocksPerMultiprocessor(&per_cu, (const void*)fwd, NWAVES * 64, LDS_BYTES) != hipSuccess || per_cu < 1)
            fprintf(stderr, "kernel_launch: note: occupancy query reports %d workgroups per CU\n", per_cu);
        (void)hipGetLastError();
        grid = cus;
    }
    if (grid < 0) return;
    if (hipMemsetAsync((char*)d_ws + WS_CTL, 0, CTL_ZERO_BYTES, stream) != hipSuccess) { fprintf(stderr, "kernel_launch: hipMemsetAsync failed\n"); return; }
    Args a{};
    for (int i = 0; i < 17; ++i) a.in[i] = (const float*)d_in[i];
    a.out = (float*)d_out; a.ws = (unsigned char*)d_ws;
    hipLaunchKernelGGL(fwd, dim3(grid), dim3(NWAVES * 64), LDS_BYTES, stream, a);
    const hipError_t le = hipPeekAtLastError();
    if (le != hipSuccess) fprintf(stderr, "kernel_launch: launch failed: %s\n", hipGetErrorName(le));
}
```

```cpp
#include <hip/hip_runtime.h>
#include <cstdio>
#include <cstdint>

#ifndef PG8_SNAKE
#define PG8_SNAKE 1
#endif
#ifndef PG8_WGM
#define PG8_WGM 4
#endif
namespace pg8 {
#define PG8_LAS __attribute__((address_space(3)))
typedef unsigned short bf16_t;
typedef short bf16x8 __attribute__((ext_vector_type(8)));
typedef float f32x4 __attribute__((ext_vector_type(4)));
typedef float f32x2 __attribute__((ext_vector_type(2)));
typedef unsigned u32x4 __attribute__((ext_vector_type(4)));
constexpr int BM = 256, BK = 64, HALF = 128, HTB = HALF * BK * 2  , STAGE_BYTES = 8 * HTB, NXCD = 8, WGM = PG8_WGM;

__host__ __device__ __forceinline__ int lds_byte(int r, int c) { const int st = (r >> 4) * 2 + (c >> 5), rr = r & 15, cc = c & 31, ob = rr * 64 + cc * 2; return st * 1024 + (ob ^ (((ob >> 9) & 1) << 5)); }
__host__ __device__ __forceinline__ void stage_rc(int b, int& R, int& C) { const int st = b / 1024, sb = b % 1024, swz = sb ^ (((sb >> 9) & 1) << 5); R = (st >> 1) * 16 + swz / 64; C = (st & 1) * 32 + (swz % 64) / 2; }
__host__ __device__ __forceinline__ int perm32(int rho) { const int n = rho >> 4, i = rho & 15; return 8 * (i >> 2) + 4 * n + (i & 3); }

struct Unit { int pm, pn; };

struct GemmDesc {
    const char* A; const char* B;
    int lda, ldb, K;
    int nMb, zdiv, pdiv;
    long long sA1, sA2, sB1, sB2;
    long long pB1, pB2;
    int kstepA;
    int kstepB;
    __device__ __forceinline__ const char* aptr(const Unit& u) const { const int z = u.pm / nMb, pml = u.pm - z * nMb, z1 = z / zdiv, z2 = z - z1 * zdiv; return A + (long long)pml * (512ll * lda) + z1 * sA1 + z2 * sA2; }
    __device__ __forceinline__ const char* bptr(const Unit& u) const { const int z = u.pm / nMb, z1 = z / zdiv, z2 = z - z1 * zdiv, p1 = u.pn / pdiv, p2 = u.pn - p1 * pdiv; return B + p1 * pB1 + p2 * pB2 + z1 * sB1 + z2 * sB2; }
};
__device__ __forceinline__ GemmDesc plain_gemm(const void* A, const void* B, int lda, int ldb, int K, int nM) { return GemmDesc{(const char*)A, (const char*)B, lda, ldb, K, nM, 1, 1, 0, 0, 0, 0, 512ll * ldb, 0, 128, 128}; }
__device__ __forceinline__ GemmDesc wtm_gemm(const void* A, const void* B, int lda, int K, int nM) { return GemmDesc{(const char*)A, (const char*)B, lda, 64, K, nM, 1, 1, 0, 0, 0, 0, 512ll * K, 0, 128, 32768}; }

struct StaticOrder {
    int nM, nN, nwg, G, c, wgm, rev;
    __host__ __device__ void init(int nM_, int nN_, int G_, int c_, int wgm_ = WGM, int rev_ = 0) { nM = nM_; nN = nN_; nwg = nM * nN; G = G_; c = c_; wgm = wgm_; rev = rev_; }
    __host__ __device__ bool next(int i, Unit& u) const {
        const long L = (long)i * G + c; if (L >= nwg) return false;
        int wgid = (int)L; { const int q = nwg / NXCD, r = nwg % NXCD, xcd = wgid % NXCD, off = wgid / NXCD; wgid = (xcd < r ? xcd * (q + 1) : r * (q + 1) + (xcd - r) * q) + off; }
        const int nig = wgm * nN, gid = wgid / nig, fm = gid * wgm, gsz = (nM - fm) < wgm ? (nM - fm) : wgm;
        u.pm = fm + ((wgid % nig) % gsz); u.pn = (wgid % nig) / gsz; if (PG8_SNAKE && (gid & 1)) u.pn = nN - 1 - u.pn; if (rev) u.pm = nM - 1 - u.pm; return true;
    }
    __device__ __forceinline__ void a_ready(const Unit&) const {}
    __device__ __forceinline__ void done(const Unit&) const {}
#ifndef PG8_KROT
#define PG8_KROT 1
#endif
#ifndef PG8_STAG_TICKS
#define PG8_STAG_TICKS 0
#endif
    __device__ __forceinline__ void stagger() const { if (PG8_STAG_TICKS > 0) { const unsigned long long t0 = __builtin_amdgcn_s_memrealtime(), d = (unsigned long long)(((c >> 3) & 3) * PG8_STAG_TICKS);
        while (__builtin_amdgcn_s_memrealtime() - t0 < d) __builtin_amdgcn_s_sleep(4); } }
    __device__ __forceinline__ int krot(int nt) const { return PG8_KROT ? 2 * (((c & 7) * (nt >> 1)) >> 3) : 0; }
};

__device__ __forceinline__ unsigned cvt_pk_bf16(float lo, float hi) { unsigned r; asm volatile("v_cvt_pk_bf16_f32 %0, %1, %2" : "=v"(r) : "v"(lo), "v"(hi)); return r; }

template <class Epi, class Sched, bool ALIGN_EPI = false, bool SP2 = false>
__device__ __forceinline__ void gemm_phase(PG8_LAS unsigned char* lds, const GemmDesc g, const Sched& S, const Epi& E) {
    int tid_ = threadIdx.x; asm volatile("" : "+v"(tid_));
    const int tid = tid_, wid = __builtin_amdgcn_readfirstlane(tid >> 6), lane = tid & 63, wr = wid >> 2, wc = wid & 3, fr = lane & 15, fq = lane >> 4;
    const int K = g.K, nt = K / BK;
    unsigned voffA[2], voffB[2];
#pragma unroll
    for (int i = 0; i < 2; ++i) { int R, C; stage_rc(tid * 16 + i * 8192, R, C); const int Rb = Epi::PERM ? ((R & ~31) + perm32(R & 31)) : R;
        voffA[i] = (unsigned)(R * g.lda + C) * 2u; voffB[i] = (unsigned)(Rb * g.ldb + C) * 2u; }
    const size_t kstep = (size_t)g.kstepB, kA = (size_t)g.kstepA;
    const size_t hA = (size_t)HALF * g.lda * 2, hB = (size_t)HALF * g.ldb * 2;
    const unsigned ldsw = (unsigned)wid * 1024u;
    const int aoff = lds_byte(wr * 64 + fr, fq * 8), boff = lds_byte(wc * 32 + fr, fq * 8);
#define PG8_SA(b, h) (((b) * 2 + (h)) * HTB)
#define PG8_SB(b, h) ((4 + (b) * 2 + (h)) * HTB)
#define PG8_STAGE(bufoff, gbase, voff) do { _Pragma("unroll") for (int _i = 0; _i < 2; ++_i) \
        __builtin_amdgcn_global_load_lds((const unsigned*)((const char*)(gbase) + (voff)[_i]), (PG8_LAS unsigned*)(lds + (bufoff) + ldsw + _i * 8192), 16, 0, 0); } while (0)
#define PG8_LDA(dst, b, h) do { _Pragma("unroll") for (int m = 0; m < 4; ++m) _Pragma("unroll") for (int k = 0; k < 2; ++k) dst[m][k] = *(const PG8_LAS bf16x8*)(lds + PG8_SA(b, h) + aoff + m * 2048 + k * 1024); } while (0)
#define PG8_LDB(dst, b, h) do { _Pragma("unroll") for (int n = 0; n < 2; ++n) _Pragma("unroll") for (int k = 0; k < 2; ++k) dst[n][k] = *(const PG8_LAS bf16x8*)(lds + PG8_SB(b, h) + boff + n * 2048 + k * 1024); } while (0)
#define PG8_MMA(ai, bj, At, Bt) do { __builtin_amdgcn_s_setprio(1); _Pragma("unroll") for (int m = 0; m < 4; ++m) _Pragma("unroll") for (int n = 0; n < 2; ++n) _Pragma("unroll") for (int k = 0; k < 2; ++k) \
        acc[ai][bj][m][n] = __builtin_amdgcn_mfma_f32_16x16x32_bf16(Bt[n][k], At[m][k], acc[ai][bj][m][n], 0, 0, 0); __builtin_amdgcn_s_setprio(0); } while (0)
#define PG8_WAIT_V(n) asm volatile("s_waitcnt vmcnt(" #n ")" ::: "memory")
#define PG8_WAIT_L(n) asm volatile("s_waitcnt lgkmcnt(" #n ")" ::: "memory")
#define PG8_BAR __builtin_amdgcn_s_barrier()
#define PG8_SCHED __builtin_amdgcn_sched_barrier(0)
    Unit cur, nxt; int ui = 0;
    if (!S.next(0, cur)) return;
    S.stagger();
    f32x4 acc[2][2][4][2];
#pragma unroll
    for (int a = 0; a < 2; ++a)
#pragma unroll
        for (int b = 0; b < 2; ++b)
#pragma unroll
            for (int m = 0; m < 4; ++m)
#pragma unroll
                for (int n = 0; n < 2; ++n) acc[a][b][m][n] = (f32x4){0.f, 0.f, 0.f, 0.f};
    bf16x8 At[4][2], B0[2][2], B1[2][2];
    typename Epi::Pre pre;
    const char* cA = g.aptr(cur); const char* cB = g.bptr(cur);
    const int r0 = S.krot(nt); const size_t roff = (size_t)r0 * kstep, roffA = (size_t)r0 * kA;
    S.a_ready(cur);
    if constexpr (SP2) {
        PG8_STAGE(PG8_SB(0, 0), cB + roff, voffB); PG8_STAGE(PG8_SB(0, 1), cB + roff + hB, voffB); PG8_STAGE(PG8_SA(0, 0), cA + roffA, voffA); PG8_STAGE(PG8_SA(0, 1), cA + roffA + hA, voffA);
        if (wr == 1) PG8_BAR;
        PG8_WAIT_V(2); PG8_BAR;
        PG8_STAGE(PG8_SB(1, 0), cB + roff + kstep, voffB); PG8_STAGE(PG8_SA(1, 0), cA + roffA + kA, voffA); PG8_STAGE(PG8_SB(1, 1), cB + roff + hB + kstep, voffB);
        PG8_WAIT_V(6); PG8_BAR;
    } else {
        PG8_STAGE(PG8_SB(0, 0), cB + roff, voffB); PG8_STAGE(PG8_SA(0, 0), cA + roffA, voffA); PG8_STAGE(PG8_SB(0, 1), cB + roff + hB, voffB); PG8_STAGE(PG8_SA(0, 1), cA + roffA + hA, voffA);
        if (wr == 1) PG8_BAR;
        PG8_WAIT_V(4); PG8_BAR;
        PG8_STAGE(PG8_SB(1, 0), cB + roff + kstep, voffB); PG8_STAGE(PG8_SA(1, 0), cA + roffA + kA, voffA); PG8_STAGE(PG8_SB(1, 1), cB + roff + hB + kstep, voffB);
        PG8_WAIT_V(6); PG8_BAR;
    }
    for (;;) {
        const bool has_next = S.next(ui + 1, nxt);
        const char* nA = has_next ? g.aptr(nxt) : cA; const char* nB = has_next ? g.bptr(nxt) : cB;
        for (int t = 0; t < nt; t += 2) {
            const bool last = (t == nt - 2);
            int tt = t + r0; if (tt >= nt) tt -= nt; int tt2 = tt + 2; if (tt2 >= nt) tt2 -= nt;
            const char* a1 = cA + (size_t)(tt + 1) * kA;
            const char* a2 = last ? nA + roffA : cA + (size_t)tt2 * kA; const char* b2 = last ? nB + roff : cB + (size_t)tt2 * kstep;
            const char* a3 = a2 + kA; const char* b3 = b2 + kstep;
            if (last && has_next) S.a_ready(nxt);
            if (last) E.prefetch(pre, cur, wc, fq);
            if constexpr (SP2) {
            PG8_LDB(B0, 0, 0); PG8_LDB(B1, 0, 1); PG8_SCHED; PG8_LDA(At, 0, 0); PG8_STAGE(PG8_SA(1, 1), a1 + hA, voffA);
            PG8_WAIT_V(8); PG8_WAIT_L(0); PG8_BAR; PG8_MMA(0, 0, At, B0); PG8_MMA(0, 1, At, B1); PG8_BAR; PG8_SCHED;
            PG8_LDA(At, 0, 1); PG8_STAGE(PG8_SB(0, 0), b2, voffB); PG8_STAGE(PG8_SB(0, 1), b2 + hB, voffB); PG8_STAGE(PG8_SA(0, 0), a2, voffA);
            PG8_WAIT_V(8); PG8_WAIT_L(0); PG8_BAR; PG8_MMA(1, 0, At, B0); PG8_MMA(1, 1, At, B1); PG8_BAR; PG8_SCHED;
            PG8_LDB(B0, 1, 0); PG8_LDB(B1, 1, 1); PG8_SCHED; PG8_LDA(At, 1, 0); PG8_STAGE(PG8_SA(0, 1), a2 + hA, voffA);
            PG8_WAIT_V(8); PG8_WAIT_L(0); PG8_BAR; PG8_MMA(0, 0, At, B0); PG8_MMA(0, 1, At, B1); PG8_BAR; PG8_SCHED;
            PG8_LDA(At, 1, 1); PG8_STAGE(PG8_SB(1, 0), b3, voffB); PG8_STAGE(PG8_SB(1, 1), b3 + hB, voffB); PG8_STAGE(PG8_SA(1, 0), a3, voffA);
            PG8_WAIT_V(8); PG8_WAIT_L(0); PG8_BAR; PG8_MMA(1, 0, At, B0); PG8_MMA(1, 1, At, B1); PG8_BAR; PG8_SCHED;
            } else {
            PG8_LDB(B0, 0, 0); PG8_SCHED; PG8_LDA(At, 0, 0); PG8_STAGE(PG8_SA(1, 1), a1 + hA, voffA);
            PG8_WAIT_L(8); PG8_BAR; PG8_WAIT_L(0); PG8_MMA(0, 0, At, B0); PG8_BAR; PG8_SCHED;
            PG8_LDB(B1, 0, 1); PG8_STAGE(PG8_SB(0, 0), b2, voffB);
            PG8_BAR; PG8_WAIT_L(0); PG8_MMA(0, 1, At, B1); PG8_BAR;
            PG8_LDA(At, 0, 1); PG8_STAGE(PG8_SA(0, 0), a2, voffA);
            PG8_BAR; PG8_WAIT_L(0); PG8_MMA(1, 0, At, B0); PG8_BAR; PG8_SCHED;
            PG8_STAGE(PG8_SB(0, 1), b2 + hB, voffB);
            PG8_WAIT_V(6); PG8_BAR; PG8_MMA(1, 1, At, B1); PG8_BAR;
            PG8_LDB(B0, 1, 0); PG8_SCHED; PG8_LDA(At, 1, 0); PG8_STAGE(PG8_SA(0, 1), a2 + hA, voffA);
            PG8_WAIT_L(8); PG8_BAR; PG8_WAIT_L(0); PG8_MMA(0, 0, At, B0); PG8_BAR; PG8_SCHED;
            PG8_LDB(B1, 1, 1); PG8_STAGE(PG8_SB(1, 0), b3, voffB);
            PG8_BAR; PG8_WAIT_L(0); PG8_MMA(0, 1, At, B1); PG8_BAR;
            PG8_LDA(At, 1, 1); PG8_STAGE(PG8_SA(1, 0), a3, voffA);
            PG8_BAR; PG8_WAIT_L(0); PG8_MMA(1, 0, At, B0); PG8_BAR; PG8_SCHED;
            PG8_STAGE(PG8_SB(1, 1), b3 + hB, voffB);
            PG8_WAIT_V(6); PG8_BAR; PG8_MMA(1, 1, At, B1); PG8_BAR;
            }
        }
        if constexpr (ALIGN_EPI) { if (wr == 0) PG8_BAR; }
        if constexpr (!Epi::AFTER_DRAIN) { E(acc, cur, wr, wc, fr, fq, pre); S.done(cur); }
        if (!has_next) break;
#pragma unroll
        for (int a = 0; a < 2; ++a)
#pragma unroll
            for (int b = 0; b < 2; ++b)
#pragma unroll
                for (int m = 0; m < 4; ++m)
#pragma unroll
                    for (int n = 0; n < 2; ++n) acc[a][b][m][n] = (f32x4){0.f, 0.f, 0.f, 0.f};
        cur = nxt; cA = nA; cB = nB; ++ui;
        if constexpr (ALIGN_EPI) { if (wr == 1) PG8_BAR; }
    }
    PG8_WAIT_V(0);
    if constexpr (!ALIGN_EPI) { if (wr == 0) PG8_BAR; }
    PG8_BAR;
    if constexpr (Epi::AFTER_DRAIN) { E.fused(acc, cur, wr, wc, fr, fq, lds, wid, lane); S.done(cur); }
#undef PG8_SA
#undef PG8_SB
#undef PG8_STAGE
#undef PG8_LDA
#undef PG8_LDB
#undef PG8_MMA
#undef PG8_WAIT_V
#undef PG8_WAIT_L
#undef PG8_BAR
#undef PG8_SCHED
}
}

constexpr int D = 2048, SEQP = 8192, SEQS = 2048, NBP = 2, NBS = 16, NB = NBP + NBS;
constexpr int MP = NBP * SEQP, MS = NBS * SEQS, M = MP + MS;
constexpr int NH = 18, HD = 128, AW = NH * HD, QKVW = 3 * AW, FF = 4 * D, DEPTH = 4, NMOD = 6;
constexpr float RMS_EPS = 1e-6f, LOG2E = 1.4426950408889634f, LN2 = 0.6931471805599453f;
constexpr int NWAVES = 8;
#ifndef LDU_PAD
#define LDU_PAD 64
#endif
constexpr int LDU = FF + LDU_PAD;

constexpr size_t MiB = 1u << 20;
constexpr size_t WS_CTL = 0, CTL_ZERO_BYTES = 1 * MiB;
constexpr size_t WS_MOD = 1 * MiB;
constexpr size_t WS_CACT = 5 * MiB;
constexpr size_t WS_LSE = 6 * MiB;
constexpr size_t WS_FC = 10 * MiB;
constexpr size_t WS_G = 11 * MiB;
constexpr size_t WS_W = 12 * MiB;
constexpr size_t WS_WQKV = WS_W, WS_WF = WS_W, WS_WO = WS_W + 27 * MiB, WS_W1 = WS_W + 36 * MiB, WS_W2 = WS_W + 68 * MiB;
constexpr size_t WS_HM = 112 * MiB;
constexpr size_t WS_R = 328 * MiB;
constexpr size_t WS_AO = WS_R + 384 * MiB;
constexpr size_t WS_MODP = WS_AO;
constexpr size_t WS_XB = 1104 * MiB;
constexpr size_t WS_END = 1296 * MiB;
static_assert(WS_W2 + (size_t)D * FF * 2 <= WS_HM && WS_HM + (size_t)M * AW * 2 <= WS_R && WS_R + (size_t)M * LDU * 2 <= WS_XB && WS_XB + (size_t)M * D * 2 <= WS_END, "d_ws map");
static_assert((size_t)3 * NH * M * HD * 2 <= WS_XB - WS_R && (size_t)M * 2 * D * 2 <= WS_AO - WS_R && WS_AO + (size_t)M * 2 * D * 2 <= WS_XB, "d_ws map (R)");
constexpr int CW_BAR = 4096;

constexpr int RING_BYTES = 131072;
constexpr int LDS_BYTES = 147456;
constexpr int LDSCTL_OFF = LDS_BYTES - 512, MISC_OFF = LDSCTL_OFF + 320;
constexpr int SCR2_OFF = 65536, SCR2_STRIDE = 8448;
static_assert(SCR2_OFF + 8 * SCR2_STRIDE <= LDSCTL_OFF, "LDS map");

#define GAS __attribute__((address_space(1)))
#define LAS __attribute__((address_space(3)))
typedef unsigned short bf16;
typedef unsigned v4u __attribute__((ext_vector_type(4)));
typedef unsigned v2u __attribute__((ext_vector_type(2)));
typedef float f32x4 __attribute__((ext_vector_type(4)));
typedef float f32x2 __attribute__((ext_vector_type(2)));
typedef float f32x16 __attribute__((ext_vector_type(16)));
typedef short bf16x8 __attribute__((ext_vector_type(8)));
typedef short s16x4 __attribute__((ext_vector_type(4)));
typedef __bf16 bf16x2_t __attribute__((ext_vector_type(2)));
#define LDS_WAIT() asm volatile("s_waitcnt lgkmcnt(0)" ::: "memory")
__device__ __forceinline__ unsigned pk2(float lo, float hi) { f32x2 v = {lo, hi}; bf16x2_t b = __builtin_convertvector(v, bf16x2_t); return __builtin_bit_cast(unsigned, b); }
__device__ __forceinline__ float bf_lo(unsigned w) { return __builtin_bit_cast(float, w << 16); }
__device__ __forceinline__ float bf_hi(unsigned w) { return __builtin_bit_cast(float, w & 0xffff0000u); }
__device__ __forceinline__ float wave_sum(float v) {
#pragma unroll
    for (int o = 1; o < 64; o <<= 1) v += __shfl_xor(v, o);
    return v;
}
__device__ __forceinline__ int batch_of_tile(int pm) { return pm < 64 ? (pm >> 5) : 2 + ((pm - 64) >> 3); }

namespace pg8 {
struct NoPre {};
#ifndef PG8_NT
#define PG8_NT 0
#endif
#if PG8_NT
#define PG8_ST_STREAM(p, v) __builtin_nontemporal_store((v), (p))
#else
#define PG8_ST_STREAM(p, v) (*(p) = (v))
#endif
__device__ __forceinline__ u32x4 tperm16(u32x4 w, int src4) { u32x4 t; t.x = (unsigned)__builtin_amdgcn_ds_bpermute(src4, (int)w.x); t.y = (unsigned)__builtin_amdgcn_ds_bpermute(src4, (int)w.y); t.z = (unsigned)__builtin_amdgcn_ds_bpermute(src4, (int)w.z); t.w = (unsigned)__builtin_amdgcn_ds_bpermute(src4, (int)w.w); return t; }
#define PG8_TLANES(fr, fq) const int lane_ = (fq) * 16 + (fr), src4 = (((lane_ & 3) << 4) + (lane_ >> 2)) << 2, frT = lane_ >> 2, fqT = lane_ & 3
struct EpiQKV {
    static constexpr bool PERM = true, AFTER_DRAIN = false; typedef NoPre Pre;
    __device__ __forceinline__ void prefetch(Pre&, const Unit&, int, int) const {}
    bf16_t* O; float qscale;
    __device__ __forceinline__ void operator()(const f32x4 (&acc)[2][2][4][2], const Unit& u, int wr, int wc, int fr, int fq, const Pre& pre) const {
        PG8_TLANES(fr, fq);
        const int g = u.pn / 9, j = u.pn - 9 * g, which = j / 3, hp = (j - 3 * which) * 2, sh = 2 * g;
        int sstart, t0, lsh;
        if (u.pm < 64) { sstart = (u.pm >> 5) * SEQP; t0 = (u.pm & 31) * 256; lsh = 13 - sh; } else { const int q = u.pm - 64; sstart = MP + (q >> 3) * SEQS; t0 = (q & 7) * 256; lsh = 11 - sh; }
        const float sc = which == 0 ? qscale : 1.f;
#pragma unroll
        for (int ai = 0; ai < 2; ++ai)
#pragma unroll
            for (int m = 0; m < 4; ++m) { const int t = t0 + ai * HALF + wr * 64 + m * 16 + frT, prow = sstart + ((t & ((1 << sh) - 1)) << lsh) + (t >> sh);
#pragma unroll
                for (int bj = 0; bj < 2; ++bj) { const int head = g * 6 + hp + bj;
                    bf16_t* dst = O + ((size_t)(which * NH + head) * M + prow) * HD + wc * 32 + 8 * fqT;
                    const f32x4 v0 = acc[ai][bj][m][0] * sc, v1 = acc[ai][bj][m][1] * sc;
                    u32x4 w; w.x = cvt_pk_bf16(v0[0], v0[1]); w.y = cvt_pk_bf16(v0[2], v0[3]); w.z = cvt_pk_bf16(v1[0], v1[1]); w.w = cvt_pk_bf16(v1[2], v1[3]);
                    PG8_ST_STREAM((u32x4*)dst, tperm16(w, src4)); } }
    }
};
template <bool F32IN> struct EpiRes {
    static constexpr bool PERM = true, AFTER_DRAIN = false; typedef NoPre Pre;
    __device__ __forceinline__ void prefetch(Pre&, const Unit&, int, int) const {}
    const float* xin_p; const float* xin_s; bf16_t* xb; const float* bias; const float* gate;
    __device__ __forceinline__ void operator()(const f32x4 (&acc)[2][2][4][2], const Unit& u, int wr, int wc, int fr, int fq, const Pre& pre) const {
        PG8_TLANES(fr, fq);
        const int b = batch_of_tile(u.pm), col0 = u.pn * BM + wc * 32 + 8 * fq, colT = u.pn * BM + wc * 32 + 8 * fqT, rowT = u.pm * BM + wr * 64 + frT;
        const float* gp = gate + (size_t)b * (NMOD * D) + col0;
        f32x4 gv[2][2], bv[2][2];
#pragma unroll
        for (int bj = 0; bj < 2; ++bj)
#pragma unroll
            for (int n = 0; n < 2; ++n) { gv[bj][n] = *(const f32x4*)(gp + bj * HALF + 4 * n); bv[bj][n] = bias ? *(const f32x4*)(bias + col0 + bj * HALF + 4 * n) : (f32x4){0.f, 0.f, 0.f, 0.f}; }
#pragma unroll
        for (int ai = 0; ai < 2; ++ai) {
            if constexpr (F32IN) {
#pragma unroll
                for (int mh = 0; mh < 4; mh += 2) {
                    f32x4 xf[2][2][2];
#pragma unroll
                    for (int m = 0; m < 2; ++m) { const int row = rowT + ai * HALF + (mh + m) * 16; const float* xi = (row < MP ? xin_p + (size_t)row * D : xin_s + (size_t)(row - MP) * D) + colT;
#pragma unroll
                        for (int bj = 0; bj < 2; ++bj) { xf[m][bj][0] = *(const f32x4*)(xi + bj * HALF); xf[m][bj][1] = *(const f32x4*)(xi + bj * HALF + 4); } }
#pragma unroll
                    for (int m = 0; m < 2; ++m) { bf16_t* xo = xb + (size_t)(rowT + ai * HALF + (mh + m) * 16) * D + colT;
#pragma unroll
                        for (int bj = 0; bj < 2; ++bj) { const f32x4 y0 = gv[bj][0] * (acc[ai][bj][mh + m][0] + bv[bj][0]), y1 = gv[bj][1] * (acc[ai][bj][mh + m][1] + bv[bj][1]);
                            const u32x4 t0 = tperm16(__builtin_bit_cast(u32x4, y0), src4), t1 = tperm16(__builtin_bit_cast(u32x4, y1), src4);
                            const f32x4 v0 = xf[m][bj][0] + __builtin_bit_cast(f32x4, t0), v1 = xf[m][bj][1] + __builtin_bit_cast(f32x4, t1);
                            u32x4 o; o.x = cvt_pk_bf16(v0[0], v0[1]); o.y = cvt_pk_bf16(v0[2], v0[3]); o.z = cvt_pk_bf16(v1[0], v1[1]); o.w = cvt_pk_bf16(v1[2], v1[3]);
                            *(u32x4*)(xo + bj * HALF) = o; } }
                }
            } else {
                u32x4 xw[4][2];
#pragma unroll
                for (int m = 0; m < 4; ++m) { const bf16_t* xi = xb + (size_t)(rowT + ai * HALF + m * 16) * D + colT;
#pragma unroll
                    for (int bj = 0; bj < 2; ++bj) xw[m][bj] = *(const u32x4*)(xi + bj * HALF); }
#pragma unroll
                for (int m = 0; m < 4; ++m) { bf16_t* xo = xb + (size_t)(rowT + ai * HALF + m * 16) * D + colT;
#pragma unroll
                    for (int bj = 0; bj < 2; ++bj) { const u32x4 w = xw[m][bj];
                        const f32x4 x0 = {__builtin_bit_cast(float, w.x << 16), __builtin_bit_cast(float, w.x & 0xffff0000u), __builtin_bit_cast(float, w.y << 16), __builtin_bit_cast(float, w.y & 0xffff0000u)};
                        const f32x4 x1 = {__builtin_bit_cast(float, w.z << 16), __builtin_bit_cast(float, w.z & 0xffff0000u), __builtin_bit_cast(float, w.w << 16), __builtin_bit_cast(float, w.w & 0xffff0000u)};
                        const f32x4 y0 = gv[bj][0] * (acc[ai][bj][m][0] + bv[bj][0]), y1 = gv[bj][1] * (acc[ai][bj][m][1] + bv[bj][1]);
                        const u32x4 t0 = tperm16(__builtin_bit_cast(u32x4, y0), src4), t1 = tperm16(__builtin_bit_cast(u32x4, y1), src4);
                        const f32x4 v0 = x0 + __builtin_bit_cast(f32x4, t0), v1 = x1 + __builtin_bit_cast(f32x4, t1);
                        u32x4 o; o.x = cvt_pk_bf16(v0[0], v0[1]); o.y = cvt_pk_bf16(v0[2], v0[3]); o.z = cvt_pk_bf16(v1[0], v1[1]); o.w = cvt_pk_bf16(v1[2], v1[3]);
                        *(u32x4*)(xo + bj * HALF) = o; } }
            }
        }
    }
};
template <int ACT, bool TILEMAJOR = false> struct EpiBf16 {
    static constexpr bool PERM = true, AFTER_DRAIN = false;
    struct Pre { f32x4 bv[2][2]; };
    bf16_t* O; int ldc; const float* bias; int row_base;
    __device__ __forceinline__ void prefetch(Pre& p, const Unit& u, int wc, int fq) const {
        const int bcol0 = u.pn * BM + wc * 32 + 8 * fq;
#pragma unroll
        for (int bj = 0; bj < 2; ++bj)
#pragma unroll
            for (int n = 0; n < 2; ++n) p.bv[bj][n] = bias ? *(const f32x4*)(bias + bcol0 + bj * HALF + 4 * n) : (f32x4){0.f, 0.f, 0.f, 0.f};
    }
    __device__ __forceinline__ void operator()(const f32x4 (&acc)[2][2][4][2], const Unit& u, int wr, int wc, int fr_in, int fq, const Pre& pre) const {
        int fr = fr_in; asm volatile("" : "+v"(fr));
        PG8_TLANES(fr, fq);
        const int row0 = row_base + u.pm * BM + wr * 64 + frT, col0 = u.pn * BM + wc * 32 + 8 * fqT;
        const f32x4 (&bv)[2][2] = pre.bv;
#pragma unroll
        for (int ai = 0; ai < 2; ++ai)
#pragma unroll
            for (int m = 0; m < 4; ++m) { bf16_t* rowp = TILEMAJOR ? O + ((size_t)u.pm * (ldc / 64) + (u.pn * 4 + (wc >> 1))) * (256 * 64) + (size_t)(wr * 64 + frT + ai * HALF + m * 16) * 64 + (wc & 1) * 32 + 8 * fqT
                                                                   : O + (size_t)(row0 + ai * HALF + m * 16) * ldc + col0;
#pragma unroll
                for (int bj = 0; bj < 2; ++bj) { f32x4 v0 = acc[ai][bj][m][0] + bv[bj][0], v1 = acc[ai][bj][m][1] + bv[bj][1];
                    if (ACT == 1) {
#pragma unroll
                        for (int e = 0; e < 4; ++e) { const float a = fmaxf(v0[e], 0.f), b = fmaxf(v1[e], 0.f); v0[e] = a * a; v1[e] = b * b; } }
                    u32x4 w; w.x = cvt_pk_bf16(v0[0], v0[1]); w.y = cvt_pk_bf16(v0[2], v0[3]); w.z = cvt_pk_bf16(v1[0], v1[1]); w.w = cvt_pk_bf16(v1[2], v1[3]);
                    PG8_ST_STREAM((u32x4*)(rowp + (TILEMAJOR ? bj * 2 * (256 * 64) : bj * HALF)), tperm16(w, src4)); } }
    }
};
struct EpiZT {
    static constexpr bool PERM = true, AFTER_DRAIN = false; typedef NoPre Pre;
    __device__ __forceinline__ void prefetch(Pre&, const Unit&, int, int) const {}
    bf16_t* ZT; int seq0, S, N2;
    __device__ __forceinline__ void operator()(const f32x4 (&acc)[2][2][4][2], const Unit& u, int wr, int wc, int fr, int fq, const Pre& pre) const {
        PG8_TLANES(fr, fq);
        const int part = u.pm & 1, z = u.pm >> 1, b = z >> 3, g = z & 7;
        bf16_t* base = ZT + (size_t)4096 * (seq0 + b * S) + ((size_t)(g * 256 + wr * 64 + frT) * N2 + u.pn) * 512 + part * 256 + wc * 32 + 8 * fqT;
#pragma unroll
        for (int ai = 0; ai < 2; ++ai)
#pragma unroll
            for (int m = 0; m < 4; ++m) { bf16_t* rowp = base + (size_t)(ai * HALF + m * 16) * N2 * 512;
#pragma unroll
                for (int bj = 0; bj < 2; ++bj) { const f32x4 v0 = acc[ai][bj][m][0], v1 = acc[ai][bj][m][1];
                    u32x4 w; w.x = cvt_pk_bf16(v0[0], v0[1]); w.y = cvt_pk_bf16(v0[2], v0[3]); w.z = cvt_pk_bf16(v1[0], v1[1]); w.w = cvt_pk_bf16(v1[2], v1[3]);
                    PG8_ST_STREAM((u32x4*)(rowp + bj * HALF), tperm16(w, src4)); } }
    }
};
struct EpiAO {
    static constexpr bool PERM = true, AFTER_DRAIN = false; typedef NoPre Pre;
    __device__ __forceinline__ void prefetch(Pre&, const Unit&, int, int) const {}
    bf16_t* AO; int seq0, S, N2;
    __device__ __forceinline__ void operator()(const f32x4 (&acc)[2][2][4][2], const Unit& u, int wr, int wc, int fr, int fq, const Pre& pre) const {
        PG8_TLANES(fr, fq);
        const int part = u.pm & 1, b = u.pm >> 1, n2 = u.pn >> 3, cb = u.pn & 7;
        bf16_t* base = AO + (size_t)4096 * (seq0 + b * S) + ((size_t)(part * 256 + wr * 64 + frT) * N2 + n2) * 2048 + cb * 256 + wc * 32 + 8 * fqT;
#pragma unroll
        for (int ai = 0; ai < 2; ++ai)
#pragma unroll
            for (int m = 0; m < 4; ++m) { bf16_t* rowp = base + (size_t)(ai * HALF + m * 16) * N2 * 2048;
#pragma unroll
                for (int bj = 0; bj < 2; ++bj) { const f32x4 v0 = acc[ai][bj][m][0], v1 = acc[ai][bj][m][1];
                    u32x4 w; w.x = cvt_pk_bf16(v0[0], v0[1]); w.y = cvt_pk_bf16(v0[2], v0[3]); w.z = cvt_pk_bf16(v1[0], v1[1]); w.w = cvt_pk_bf16(v1[2], v1[3]);
                    PG8_ST_STREAM((u32x4*)(rowp + bj * HALF), tperm16(w, src4)); } }
    }
};
struct EpiNull {
    static constexpr bool PERM = true, AFTER_DRAIN = false; typedef NoPre Pre;
    __device__ __forceinline__ void prefetch(Pre&, const Unit&, int, int) const {}
    __device__ __forceinline__ void operator()(const f32x4 (&acc)[2][2][4][2], const Unit&, int, int, int, int, const Pre&) const {
#pragma unroll
        for (int a = 0; a < 2; ++a)
#pragma unroll
            for (int b = 0; b < 2; ++b)
#pragma unroll
                for (int m = 0; m < 4; ++m)
#pragma unroll
                    for (int n = 0; n < 2; ++n) asm volatile("" :: "v"(acc[a][b][m][n]));
    }
};
}

#ifndef PG8_SP2
#define PG8_SP2 true
#endif
#ifndef PG8_ALIGN
#define PG8_ALIGN true
#endif

#define XB_TMO      128
#define XB_XCNT(j)  (256  + 64 * (j))
#define XB_XSUB(j)  (1280 + 64 * (j))
#define XB_XGEN(j)  (2304 + 64 * (j))
#define XB_TOP      3328
#define XB_TOPGEN   3392
#define XCD_BAR_WORDS 3456
#define XB_SPIN_CAP (1u << 18)

__device__ __forceinline__ unsigned xb_ld(unsigned* p)              { return __hip_atomic_load(p, __ATOMIC_RELAXED, __HIP_MEMORY_SCOPE_AGENT); }
__device__ __forceinline__ unsigned xb_add(unsigned* p, unsigned v) { return __hip_atomic_fetch_add(p, v, __ATOMIC_RELAXED, __HIP_MEMORY_SCOPE_AGENT); }
__device__ __forceinline__ unsigned xb_xcc_id() { return (unsigned)__builtin_amdgcn_s_getreg((3 << 11) | 20) & 0xFu; }
#define XB_SPIN(cond, bar) do { unsigned _sp = 0; while (cond) { __builtin_amdgcn_s_sleep(1); \
    if ((++_sp & 255u) == 0u) { if (xb_ld(&(bar)[XB_TMO])) break; if (_sp > XB_SPIN_CAP) { atomicAdd(&(bar)[XB_TMO], 1u); break; } } } } while (0)

struct XcdBarrier {
    unsigned* bar; unsigned x;
    volatile LAS unsigned* st;
};

__device__ __forceinline__ XcdBarrier xcd_barrier_post(unsigned* bar, volatile LAS unsigned* st) {
    XcdBarrier b; b.bar = bar; b.x = xb_xcc_id(); b.st = st;
    if (threadIdx.x == 0) (void)xb_add(&bar[XB_XCNT(b.x)], 1u);
    return b;
}
__device__ __forceinline__ void xcd_barrier_complete(unsigned* bar, unsigned x, unsigned& nloc, unsigned& nx) {
    const unsigned G = gridDim.x * gridDim.y * gridDim.z;
    unsigned sum, cnt, mine, sp = 0u;
    for (;;) {
        sum = 0u; cnt = 0u; mine = 0u;
#pragma unroll
        for (unsigned j = 0; j < 16; ++j) { const unsigned c = xb_ld(&bar[XB_XCNT(j)]); sum += c; cnt += (c > 0u) ? 1u : 0u; mine = (j == x) ? c : mine; }
        if (sum == G) break;
        __builtin_amdgcn_s_sleep(1);
        if ((++sp & 255u) == 0u) { if (xb_ld(&bar[XB_TMO])) break; if (sp > XB_SPIN_CAP) { atomicAdd(&bar[XB_TMO], 1u); break; } }
    }
    nloc = mine > 0u ? mine : 1u; nx = cnt > 0u ? cnt : 1u;
}

__device__ __forceinline__ void xcd_barrier(const XcdBarrier& b) {
    asm volatile("s_waitcnt vmcnt(0)" ::: "memory");
    __syncthreads();
    if (threadIdx.x == 0) {
        unsigned* bar = b.bar;
        __builtin_amdgcn_s_waitcnt(0);
        unsigned nloc = b.st[0], nx = b.st[1];
        if (nloc == 0u) { xcd_barrier_complete(bar, b.x, nloc, nx); b.st[0] = nloc; b.st[1] = nx; }
        const unsigned old = xb_add(&bar[XB_XSUB(b.x)], 1u);
        const unsigned gen = old / nloc;
        if (old + 1u == (gen + 1u) * nloc) {
            __builtin_amdgcn_fence(__ATOMIC_RELEASE, "agent");
            asm volatile("s_waitcnt vmcnt(0)" ::: "memory");
            const unsigned og = xb_add(&bar[XB_TOP], 1u);
            const unsigned tg = og / nx;
            if (og + 1u == (tg + 1u) * nx) xb_add(&bar[XB_TOPGEN], 1u);
            else XB_SPIN(xb_ld(&bar[XB_TOPGEN]) == tg, bar);
            __builtin_amdgcn_fence(__ATOMIC_ACQUIRE, "agent");
            xb_add(&bar[XB_XGEN(b.x)], 1u);
            asm volatile("s_waitcnt vmcnt(0)" ::: "memory");
        } else {
            XB_SPIN(xb_ld(&bar[XB_XGEN(b.x)]) == gen, bar);
            __builtin_amdgcn_fence(__ATOMIC_ACQUIRE, "agent");
            asm volatile("s_waitcnt vmcnt(0)" ::: "memory");
        }
    }
    __syncthreads();
}


__device__ __forceinline__ void transpose_item(const float* W, int K, int N, bf16* WT, LAS float* scr, int item, int lane) {
    const int nblk = N / 32, kb = item / nblk, nb = item % nblk, k0 = 64 * kb, n0 = 32 * nb;
    float wv[32];
#pragma unroll
    for (int i = 0; i < 32; ++i) wv[i] = W[(size_t)(k0 + 2 * i + (lane >> 5)) * N + n0 + (lane & 31)];
#pragma unroll
    for (int i = 0; i < 32; ++i) scr[(2 * i + (lane >> 5)) * 33 + (lane & 31)] = wv[i];
    LDS_WAIT(); asm volatile("" ::: "memory");
    const int c = lane & 7;
#pragma unroll
    for (int j = 0; j < 4; ++j) { const int n = (lane >> 3) + 8 * j; const LAS float* s = scr + (8 * c) * 33 + n;
        v4u o; o.x = pk2(s[0 * 33], s[1 * 33]); o.y = pk2(s[2 * 33], s[3 * 33]); o.z = pk2(s[4 * 33], s[5 * 33]); o.w = pk2(s[6 * 33], s[7 * 33]);
        *(GAS v4u*)(WT + ((size_t)((n0 + n) >> 8) * (K / 64) + kb) * 16384 + ((n0 + n) & 255) * 64 + 8 * c) = o; }
    LDS_WAIT(); asm volatile("" ::: "memory");
}

__device__ __forceinline__ void norm_chunk(const float* xrow0, bf16* hrow0, const float* gain, const float* shift, const float* scale, int lane) {
    f32x4 A[8], B[8];
#pragma unroll
    for (int j = 0; j < 8; ++j) { const int col = 4 * lane + 256 * j; const f32x4 gn = *(const f32x4*)(gain + col), sc = *(const f32x4*)(scale + col); A[j] = gn * (sc + 1.0f); B[j] = *(const f32x4*)(shift + col); }
    for (int rr = 0; rr < 8; ++rr) {
        const GAS f32x4* xr = (const GAS f32x4*)(xrow0 + (size_t)rr * D) + lane;
        f32x4 v[8]; float ss = 0.f;
#pragma unroll
        for (int j = 0; j < 8; ++j) { v[j] = xr[64 * j]; ss += (v[j].x * v[j].x + v[j].y * v[j].y) + (v[j].z * v[j].z + v[j].w * v[j].w); }
        const float rstd = 1.0f / sqrtf(wave_sum(ss) * (1.0f / D) + RMS_EPS);
        GAS v2u* o8 = (GAS v2u*)(hrow0 + (size_t)rr * D) + lane;
#pragma unroll
        for (int j = 0; j < 8; ++j) { const f32x4 y = (v[j] * rstd) * A[j] + B[j]; v2u w; w.x = pk2(y.x, y.y); w.y = pk2(y.z, y.w); o8[64 * j] = w; }
    }
}

__device__ __forceinline__ void norm_chunk_b(const bf16* xrow0, bf16* hrow0, const float* gain, const float* shift, const float* scale, int lane) {
    f32x4 A[4][2], B[4][2];
#pragma unroll
    for (int j = 0; j < 4; ++j)
#pragma unroll
        for (int e = 0; e < 2; ++e) { const int col = 8 * lane + 512 * j + 4 * e; const f32x4 gn = *(const f32x4*)(gain + col), sc = *(const f32x4*)(scale + col); A[j][e] = gn * (sc + 1.0f); B[j][e] = *(const f32x4*)(shift + col); }
#pragma unroll 1
    for (int r4 = 0; r4 < 8; r4 += 4) {
        v4u w[4][4];
#pragma unroll
        for (int rr = 0; rr < 4; ++rr) { const GAS v4u* xr = (const GAS v4u*)(xrow0 + (size_t)(r4 + rr) * D) + lane;
#pragma unroll
            for (int j = 0; j < 4; ++j) w[rr][j] = xr[64 * j]; }
#pragma unroll
        for (int rr = 0; rr < 4; ++rr) {
            f32x4 v[4][2]; float ss = 0.f;
#pragma unroll
            for (int j = 0; j < 4; ++j) { const v4u q = w[rr][j];
                v[j][0] = (f32x4){bf_lo(q.x), bf_hi(q.x), bf_lo(q.y), bf_hi(q.y)}; v[j][1] = (f32x4){bf_lo(q.z), bf_hi(q.z), bf_lo(q.w), bf_hi(q.w)};
#pragma unroll
                for (int e = 0; e < 2; ++e) ss += (v[j][e].x * v[j][e].x + v[j][e].y * v[j][e].y) + (v[j][e].z * v[j][e].z + v[j][e].w * v[j][e].w); }
            const float rstd = 1.0f / sqrtf(wave_sum(ss) * (1.0f / D) + RMS_EPS);
            GAS v4u* o16 = (GAS v4u*)(hrow0 + (size_t)(r4 + rr) * D) + lane;
#pragma unroll
            for (int j = 0; j < 4; ++j) { const f32x4 y0 = (v[j][0] * rstd) * A[j][0] + B[j][0], y1 = (v[j][1] * rstd) * A[j][1] + B[j][1];
                v4u o; o.x = pk2(y0.x, y0.y); o.y = pk2(y0.z, y0.w); o.z = pk2(y1.x, y1.y); o.w = pk2(y1.z, y1.w); o16[64 * j] = o; }
        }
    }
}

__device__ __forceinline__ unsigned vimg_off(unsigned row, unsigned ch) { return 256u * row + 16u * (ch ^ (((row & 3) << 2) | ((row >> 2) & 3))); }
__device__ __forceinline__ s16x4 vtr(LAS unsigned char* p) { return __builtin_bit_cast(s16x4, __builtin_amdgcn_ds_read_tr16_b64_v4i16((LAS s16x4*)p)); }
#define MFMA32(a, b, c) __builtin_amdgcn_mfma_f32_32x32x16_bf16((a), (b), (c), 0, 0, 0)

__device__ __forceinline__ void attn_wave_unit(int w, LAS unsigned char* wl, const bf16* QKV, bf16* mixed, float* lse, int lane_in) {
    int lane = lane_in; asm volatile("" : "+v"(lane));
    const int n = lane & 31, h = lane >> 5, lrow = lane >> 4, lch = lane & 15;
    LAS unsigned char* kl = wl; LAS unsigned char* vl = wl + 8192;
    const int g = w / 9216; int w1 = w - g * 9216;
    int hh, w3, lsh, sstart;
    if (w1 < 3072) { const int bb = w1 / 1536, w2 = w1 - bb * 1536; hh = w2 >> 8; w3 = w2 & 255; sstart = bb * SEQP; lsh = 13 - 2 * g; }
    else { w1 -= 3072; const int bb = w1 / 384, w2 = w1 - bb * 384; hh = w2 >> 6; w3 = w2 & 63; sstart = MP + bb * SEQS; lsh = 11 - 2 * g; }
    const int head = g * 6 + hh, L = 1 << lsh, pos0 = w3 * 32, r = pos0 >> lsh, u0 = pos0 & (L - 1), seqlo = sstart + (r << lsh);
    const bf16* Qh = QKV + ((size_t)(0 * NH + head) * M + seqlo) * HD;
    const bf16* Kh = QKV + ((size_t)(1 * NH + head) * M + seqlo) * HD;
    const bf16* Vh = QKV + ((size_t)(2 * NH + head) * M + seqlo) * HD;
#define ATT_LDBLK(dst, base, ubase) do { _Pragma("unroll") for (int i = 0; i < 8; ++i) { int ku_ = (ubase) + lrow + 4 * i; ku_ = ku_ < 0 ? 0 : (ku_ > L - 1 ? L - 1 : ku_); \
        dst[i] = *(const GAS v4u*)((const GAS unsigned char*)(base) + (unsigned)(ku_ * 256 + lch * 16)); } } while (0)
#define ATT_STBLK(img, src) do { _Pragma("unroll") for (int i = 0; i < 8; ++i) *(LAS v4u*)((img) + vimg_off((unsigned)(lrow + 4 * i), (unsigned)lch)) = src[i]; } while (0)
    v4u ra[8], rb[8];
    ATT_LDBLK(ra, Qh, u0);
    ATT_STBLK(kl, ra);
    asm volatile("s_waitcnt lgkmcnt(0)" ::: "memory");
    ATT_LDBLK(ra, Kh, u0 - 64);
    bf16x8 qf[8];
#pragma unroll
    for (int ks = 0; ks < 8; ++ks) qf[ks] = *(const LAS bf16x8*)(kl + vimg_off((unsigned)n, (unsigned)(2 * ks + h)));
    asm volatile("s_waitcnt lgkmcnt(0)" ::: "memory");
    const float slope2 = exp2f(-8.0f * (float)(head + 1) / 18.0f) * (float)(1 << (2 * g)) * LOG2E;
    f32x16 s[5];
#pragma unroll
    for (int kb = 0; kb < 5; ++kb) {
        LAS unsigned char* img = ((kb + 1) & 1) ? vl : kl;
        ATT_STBLK(img, ra);
        asm volatile("s_waitcnt lgkmcnt(0)" ::: "memory");
        if (kb + 1 < 5) ATT_LDBLK(ra, Kh, u0 - 64 + 32 * (kb + 1));
        asm volatile("" ::: "memory");
        f32x16 acc;
#pragma unroll
        for (int i = 0; i < 16; ++i) acc[i] = 0.f;
#pragma unroll
        for (int kh = 0; kh < 4; ++kh) { bf16x8 kf[2];
#pragma unroll
            for (int k4 = 0; k4 < 2; ++k4) kf[k4] = *(const LAS bf16x8*)(img + vimg_off((unsigned)n, (unsigned)(2 * (2 * kh + k4) + h)));
#pragma unroll
            for (int k4 = 0; k4 < 2; ++k4) acc = MFMA32(kf[k4], qf[2 * kh + k4], acc);
            asm volatile("" ::: "memory"); }
        asm volatile("s_waitcnt lgkmcnt(0)" ::: "memory");
#pragma unroll
        for (int i = 0; i < 16; ++i) {
            const int krow = (i & 3) + 8 * (i >> 2) + 4 * h, kuu = u0 - 64 + 32 * kb + krow, du = -64 + 32 * kb + krow - n;
            bool ok = (unsigned)kuu < (unsigned)L;
            if (kb == 0) ok = ok && (du >= -64);
            if (kb == 4) ok = ok && (du <= 64);
            s[kb][i] = ok ? acc[i] - slope2 * fabsf((float)du) : -1e30f;
        }
    }
    asm volatile("" ::: "memory");
    ATT_LDBLK(rb, Vh, u0 - 64); ATT_LDBLK(ra, Vh, u0 - 64 + 32);
    asm volatile("" ::: "memory");
    float mx = -1e30f;
#pragma unroll
    for (int kb = 0; kb < 5; ++kb)
#pragma unroll
        for (int i = 0; i < 16; ++i) mx = fmaxf(mx, s[kb][i]);
    mx = fmaxf(mx, __shfl_xor(mx, 32));
    float lsum = 0.f;
    v4u pw[5][2];
#pragma unroll
    for (int kb = 0; kb < 5; ++kb)
#pragma unroll
        for (int s2 = 0; s2 < 2; ++s2) { float p[8];
#pragma unroll
            for (int e = 0; e < 8; ++e) { p[e] = __builtin_amdgcn_exp2f(s[kb][8 * s2 + e] - mx); lsum += p[e]; }
            pw[kb][s2].x = pk2(p[0], p[1]); pw[kb][s2].y = pk2(p[2], p[3]); pw[kb][s2].z = pk2(p[4], p[5]); pw[kb][s2].w = pk2(p[6], p[7]); }
    lsum += __shfl_xor(lsum, 32);
    f32x16 o[4];
#pragma unroll
    for (int c = 0; c < 4; ++c)
#pragma unroll
        for (int i = 0; i < 16; ++i) o[c][i] = 0.f;
    const unsigned q4 = (lane & 15) >> 2, p4 = lane & 3, blk = (lane >> 4) & 1;
#pragma unroll
    for (int kb = 0; kb < 5; ++kb) {
        LAS unsigned char* img = (kb & 1) ? vl : kl;
        if (kb & 1) ATT_STBLK(img, ra); else ATT_STBLK(img, rb);
        asm volatile("s_waitcnt lgkmcnt(0)" ::: "memory");
        if (kb + 2 < 5) { if (kb & 1) ATT_LDBLK(ra, Vh, u0 - 64 + 32 * (kb + 2)); else ATT_LDBLK(rb, Vh, u0 - 64 + 32 * (kb + 2)); }
        asm volatile("" ::: "memory");
#pragma unroll
        for (int s2 = 0; s2 < 2; ++s2) {
            const bf16x8 pf = __builtin_bit_cast(bf16x8, pw[kb][s2]);
#pragma unroll
            for (int c = 0; c < 4; ++c) {
                const unsigned ch = 4 * c + 2 * blk + (p4 >> 1);
                const s16x4 lo = vtr(img + vimg_off(16 * s2 + 0 + 4 * h + q4, ch) + 8 * (p4 & 1));
                const s16x4 hi = vtr(img + vimg_off(16 * s2 + 8 + 4 * h + q4, ch) + 8 * (p4 & 1));
                const bf16x8 vf = __builtin_shufflevector(lo, hi, 0, 1, 2, 3, 4, 5, 6, 7);
                o[c] = MFMA32(vf, pf, o[c]);
            }
        }
        asm volatile("s_waitcnt lgkmcnt(0)" ::: "memory");
    }
#undef ATT_LDBLK
#undef ATT_STBLK
    const float inv = 1.0f / lsum;
#pragma unroll
    for (int c = 0; c < 4; ++c)
#pragma unroll
        for (int k4 = 0; k4 < 4; ++k4) { v2u wv; wv.x = pk2(o[c][4 * k4 + 0] * inv, o[c][4 * k4 + 1] * inv); wv.y = pk2(o[c][4 * k4 + 2] * inv, o[c][4 * k4 + 3] * inv);
            *(LAS v2u*)(vl + vimg_off((unsigned)n, (unsigned)(4 * c + k4)) + 8 * h) = wv; }
    asm volatile("s_waitcnt lgkmcnt(0)" ::: "memory");
#pragma unroll
    for (int i = 0; i < 8; ++i) { const int q = lrow + 4 * i; const v4u ov = *(const LAS v4u*)(vl + vimg_off((unsigned)q, (unsigned)lch));
        const int mrow_q = sstart + ((u0 + q) << (2 * g)) + r;
        *(GAS v4u*)(mixed + (size_t)mrow_q * AW + head * HD + 8 * lch) = ov; }
    asm volatile("s_waitcnt lgkmcnt(0)" ::: "memory");
    if (h == 0) { const int mrow = sstart + ((u0 + n) << (2 * g)) + r; lse[(size_t)mrow * NH + head] = (mx + __builtin_amdgcn_logf(lsum)) * LN2; }
}

struct AttGroup { int g, head, sstart, slen, p0g; };
__device__ __forceinline__ AttGroup att_group(int gi) {
    AttGroup a; const int w = gi * 8; a.g = w / 9216; int w1 = w - a.g * 9216; int hh, w3;
    if (w1 < 3072) { const int bb = w1 / 1536, w2 = w1 - bb * 1536; hh = w2 >> 8; w3 = w2 & 255; a.sstart = bb * SEQP; a.slen = SEQP; }
    else { w1 -= 3072; const int bb = w1 / 384, w2 = w1 - bb * 384; hh = w2 >> 6; w3 = w2 & 63; a.sstart = MP + bb * SEQS; a.slen = SEQS; }
    a.head = a.g * 6 + hh; a.p0g = w3 * 32; return a;
}
#define ATTG_LD(dst, base, ag) do { _Pragma("unroll") for (int i = 0; i < 12; ++i) { int rr_ = (ag).p0g - 64 + 4 * (12 * wave + i) + (lane >> 4); rr_ = rr_ < 0 ? 0 : (rr_ > (ag).slen - 1 ? (ag).slen - 1 : rr_); \
        dst[i] = *(const GAS v4u*)((const GAS unsigned char*)(base) + (size_t)((ag).sstart + rr_) * 256 + (lane & 15) * 16); } } while (0)
#define ATTG_ST(src) do { _Pragma("unroll") for (int i = 0; i < 12; ++i) { const unsigned rr_ = 4 * (12 * wave + i) + (lane >> 4); \
        *(LAS v4u*)(lds + (rr_ >> 5) * 8192 + vimg_off(rr_ & 31, (unsigned)(lane & 15))) = src[i]; } } while (0)
#define ATTG_BAR() do { asm volatile("s_waitcnt lgkmcnt(0)" ::: "memory"); __builtin_amdgcn_s_barrier(); asm volatile("" ::: "memory"); } while (0)
__device__ __forceinline__ void attn_phase_coop(LAS unsigned char* lds, const bf16* QKV, bf16* mixed, float* lse, int vcu, int G, int wave, int lane_in) {
    constexpr int NGRP = 27648 / 8;
    if (vcu >= NGRP) return;
    int lane = lane_in;
    AttGroup ag = att_group(vcu);
    for (int gi = vcu; gi < NGRP; gi += G) {
        ag = att_group(gi);
        v4u kr[12], vr[12];
        ATTG_LD(kr, QKV + ((size_t)(1 * NH + ag.head) * M) * HD, ag);
        asm volatile("" : "+v"(lane));
        const int n = lane & 31, h = lane >> 5, lrow = lane >> 4, lch = lane & 15;
        const int g = ag.g, head = ag.head, sstart = ag.sstart, lsh = (ag.slen == SEQP ? 13 : 11) - 2 * g, L = 1 << lsh;
        const int pos0 = ag.p0g + 32 * wave, r = pos0 >> lsh, u0 = pos0 & (L - 1);
        ATTG_ST(kr);
        bf16x8 qf[8];
        { const GAS bf16x8* qp = (const GAS bf16x8*)(QKV + ((size_t)(0 * NH + head) * M + sstart + pos0 + n) * HD + 8 * h);
#pragma unroll
          for (int ks = 0; ks < 8; ++ks) qf[ks] = qp[2 * ks]; }
        ATTG_LD(vr, QKV + ((size_t)(2 * NH + head) * M) * HD, ag);
        ATTG_BAR();
        const float slope2 = exp2f(-8.0f * (float)(head + 1) / 18.0f) * (float)(1 << (2 * g)) * LOG2E;
        f32x16 s[5];
#pragma unroll
        for (int kb = 0; kb < 5; ++kb) {
            LAS unsigned char* img = lds + (wave + kb) * 8192;
            f32x16 acc;
#pragma unroll
            for (int i = 0; i < 16; ++i) acc[i] = 0.f;
#pragma unroll
            for (int kh = 0; kh < 4; ++kh) { bf16x8 kf[2];
#pragma unroll
                for (int k4 = 0; k4 < 2; ++k4) kf[k4] = *(const LAS bf16x8*)(img + vimg_off((unsigned)n, (unsigned)(2 * (2 * kh + k4) + h)));
#pragma unroll
                for (int k4 = 0; k4 < 2; ++k4) acc = MFMA32(kf[k4], qf[2 * kh + k4], acc);
                asm volatile("" ::: "memory"); }
#pragma unroll
            for (int i = 0; i < 16; ++i) {
                const int krow = (i & 3) + 8 * (i >> 2) + 4 * h, kuu = u0 - 64 + 32 * kb + krow, du = -64 + 32 * kb + krow - n;
                bool ok = (unsigned)kuu < (unsigned)L;
                if (kb == 0) ok = ok && (du >= -64);
                if (kb == 4) ok = ok && (du <= 64);
                s[kb][i] = ok ? acc[i] - slope2 * fabsf((float)du) : -1e30f;
            }
        }
        float mx = -1e30f;
#pragma unroll
        for (int kb = 0; kb < 5; ++kb)
#pragma unroll
            for (int i = 0; i < 16; ++i) mx = fmaxf(mx, s[kb][i]);
        mx = fmaxf(mx, __shfl_xor(mx, 32));
        float lsum = 0.f;
        v4u pw[5][2];
#pragma unroll
        for (int kb = 0; kb < 5; ++kb)
#pragma unroll
            for (int s2 = 0; s2 < 2; ++s2) { float p[8];
#pragma unroll
                for (int e = 0; e < 8; ++e) { p[e] = __builtin_amdgcn_exp2f(s[kb][8 * s2 + e] - mx); lsum += p[e]; }
                pw[kb][s2].x = pk2(p[0], p[1]); pw[kb][s2].y = pk2(p[2], p[3]); pw[kb][s2].z = pk2(p[4], p[5]); pw[kb][s2].w = pk2(p[6], p[7]); }
        lsum += __shfl_xor(lsum, 32);
        ATTG_BAR();
        ATTG_ST(vr);
        ATTG_BAR();
        f32x16 o[4];
#pragma unroll
        for (int c = 0; c < 4; ++c)
#pragma unroll
            for (int i = 0; i < 16; ++i) o[c][i] = 0.f;
        const unsigned q4 = (lane & 15) >> 2, p4 = lane & 3, blk = (lane >> 4) & 1;
#pragma unroll
        for (int kb = 0; kb < 5; ++kb) {
            LAS unsigned char* img = lds + (wave + kb) * 8192;
#pragma unroll
            for (int s2 = 0; s2 < 2; ++s2) {
                const bf16x8 pf = __builtin_bit_cast(bf16x8, pw[kb][s2]);
#pragma unroll
                for (int c = 0; c < 4; ++c) {
                    const unsigned ch = 4 * c + 2 * blk + (p4 >> 1);
                    const s16x4 lo = vtr(img + vimg_off(16 * s2 + 0 + 4 * h + q4, ch) + 8 * (p4 & 1));
                    const s16x4 hi = vtr(img + vimg_off(16 * s2 + 8 + 4 * h + q4, ch) + 8 * (p4 & 1));
                    const bf16x8 vf = __builtin_shufflevector(lo, hi, 0, 1, 2, 3, 4, 5, 6, 7);
                    o[c] = MFMA32(vf, pf, o[c]);
                }
            }
            asm volatile("" ::: "memory");
        }
        ATTG_BAR();
        LAS unsigned char* ol = lds + wave * 8192;
        const float inv = 1.0f / lsum;
#pragma unroll
        for (int c = 0; c < 4; ++c)
#pragma unroll
            for (int k4 = 0; k4 < 4; ++k4) { v2u wv; wv.x = pk2(o[c][4 * k4 + 0] * inv, o[c][4 * k4 + 1] * inv); wv.y = pk2(o[c][4 * k4 + 2] * inv, o[c][4 * k4 + 3] * inv);
                *(LAS v2u*)(ol + vimg_off((unsigned)n, (unsigned)(4 * c + k4)) + 8 * h) = wv; }
        asm volatile("s_waitcnt lgkmcnt(0)" ::: "memory");
#pragma unroll
        for (int i = 0; i < 8; ++i) { const int q = lrow + 4 * i; const v4u ov = *(const LAS v4u*)(ol + vimg_off((unsigned)q, (unsigned)lch));
            const int mrow_q = sstart + ((u0 + q) << (2 * g)) + r;
            *(GAS v4u*)(mixed + (size_t)mrow_q * AW + head * HD + 8 * lch) = ov; }
        if (h == 0) { const int mrow = sstart + ((u0 + n) << (2 * g)) + r; lse[(size_t)mrow * NH + head] = (mx + __builtin_amdgcn_logf(lsum)) * LN2; }
        ATTG_BAR();
    }
}
#undef ATTG_LD
#undef ATTG_ST
#undef ATTG_BAR

template <int N2> __device__ __forceinline__ void fbc_item(const bf16* AOb, bf16* outb, int k1, int cg, LAS float* tw, int lane) {
    constexpr int S = 256 * N2; constexpr float scale = (N2 == 32) ? 0.17677669529663687f : 0.35355339059327373f;
    for (int idx = lane; idx < N2 * N2; idx += 64) { const int n2 = idx / N2, k2 = idx % N2; const float ph = (float)((n2 * (k1 + 256 * k2)) & (S - 1)) * (1.0f / S);
        *(LAS f32x2*)(tw + 2 * idx) = (f32x2){__builtin_amdgcn_cosf(ph) * scale, __builtin_amdgcn_sinf(ph) * scale}; }
    asm volatile("s_waitcnt lgkmcnt(0)" ::: "memory");
    for (int ch = 0; ch < 2; ++ch) {
        const int col = (cg * 2 + ch) * 256 + lane * 4;
        const GAS v2u* pr = (const GAS v2u*)(AOb + ((size_t)k1 * N2) * 2048 + col);
        const GAS v2u* pi = (const GAS v2u*)(AOb + ((size_t)(256 + k1) * N2) * 2048 + col);
        f32x4 acc[N2];
#pragma unroll
        for (int k2 = 0; k2 < N2; ++k2) acc[k2] = (f32x4){0.f, 0.f, 0.f, 0.f};
#pragma unroll 1
        for (int n2b = 0; n2b < N2; n2b += 8) {
            v2u rr[8], ii[8];
#pragma unroll
            for (int q = 0; q < 8; ++q) { rr[q] = pr[(size_t)(n2b + q) * 512]; ii[q] = pi[(size_t)(n2b + q) * 512]; }
#pragma unroll
            for (int q = 0; q < 8; ++q) { asm volatile("" ::: "memory"); const int n2 = n2b + q; const v2u r = rr[q], im = ii[q];
            const f32x4 xr = {bf_lo(r.x), bf_hi(r.x), bf_lo(r.y), bf_hi(r.y)}, xi = {bf_lo(im.x), bf_hi(im.x), bf_lo(im.y), bf_hi(im.y)};
#pragma unroll
            for (int k2 = 0; k2 < N2; ++k2) { const f32x2 cs = *(const LAS f32x2*)(tw + 2 * (n2 * N2 + k2)); acc[k2] += xr * cs.x + xi * cs.y; }
            }
        }
#pragma unroll
        for (int k2 = 0; k2 < N2; ++k2) { v2u w; w.x = pk2(acc[k2].x, acc[k2].y); w.y = pk2(acc[k2].z, acc[k2].w); *(GAS v2u*)(outb + (size_t)(k1 + 256 * k2) * D + col) = w; }
    }
    asm volatile("s_waitcnt lgkmcnt(0)" ::: "memory");
}

struct Args { const float* in[17]; float* out; unsigned char* ws; };
typedef const Args __attribute__((address_space(4)))* KArgs;
__device__ __forceinline__ KArgs kargs() { KArgs p = (KArgs)__builtin_amdgcn_kernarg_segment_ptr(); asm volatile("" : "+s"(p)); return p; }
__global__ void __launch_bounds__(NWAVES * 64, 2) fwd(Args args) {
    extern __shared__ __attribute__((aligned(16))) unsigned char lds_raw[];
    LAS unsigned char* lds = (LAS unsigned char*)lds_raw;
    const int wave = __builtin_amdgcn_readfirstlane((int)threadIdx.x >> 6), G = gridDim.x;
#define FRESH_TID(name) int name = threadIdx.x; asm volatile("" : "+v"(name))
    const int gw = blockIdx.x * NWAVES + wave, NGW = G * NWAVES;
    unsigned* ctl = (unsigned*)(kargs()->ws + WS_CTL);
    { FRESH_TID(tid); for (int u = tid; u < (LDS_BYTES - LDSCTL_OFF) / 4; u += NWAVES * 64) ((LAS unsigned*)(lds + LDSCTL_OFF))[u] = 0u; }
    __syncthreads();
    (void)xcd_barrier_post(ctl + CW_BAR, (volatile LAS unsigned*)(lds + MISC_OFF) + 8);
#ifdef PROBE_STAMP
    int stamp_idx = 0;
#define STAMPS() ((unsigned long long*)(kargs()->ws + WS_CTL + 524288))
#define GRID_BAR() do { if (blockIdx.x == 0 && threadIdx.x == 0) STAMPS()[2 * stamp_idx] = __builtin_amdgcn_s_memrealtime(); GRID_BAR_() ; if (blockIdx.x == 0 && threadIdx.x == 0) STAMPS()[2 * stamp_idx + 1] = __builtin_amdgcn_s_memrealtime(); ++stamp_idx; } while (0)
#elif defined(PROBE_DOUBLE_BAR)
#define GRID_BAR() do { GRID_BAR_(); GRID_BAR_(); } while (0)
#else
#define GRID_BAR() GRID_BAR_()
#endif
#define GRID_BAR_() do { XcdBarrier bar_; bar_.bar = (unsigned*)(kargs()->ws + WS_CTL) + CW_BAR; bar_.x = xb_xcc_id(); bar_.st = (volatile LAS unsigned*)(lds + MISC_OFF) + 8; xcd_barrier(bar_); } while (0)

#define KA() kargs()
#define WSP(off) (KA()->ws + (off))
    LAS float* scr = (LAS float*)(lds + wave * 16384);

    { FRESH_TID(tid); const float* c_p = KA()->in[2]; const float* c_s = KA()->in[3]; float* cact = (float*)WSP(WS_CACT);
    for (int idx = blockIdx.x * (NWAVES * 64) + tid; idx < D * 20; idx += G * NWAVES * 64) {
        const int k = idx / 20, b = idx - 20 * k; float v = 0.f;
        if (b < NBP) v = c_p[b * D + k]; else if (b < NB) v = c_s[(b - NBP) * D + k];
        cact[idx] = v / (1.0f + __expf(-v));
    } }
    GRID_BAR();

    {
        FRESH_TID(tid_); const int lane = tid_ & 63;
        const float* w_ada = KA()->in[4]; float* modp = (float*)WSP(WS_MODP); const float* cact = (const float*)WSP(WS_CACT);
        bf16* FC = (bf16*)WSP(WS_FC); bf16* GM = (bf16*)WSP(WS_G);
        constexpr int N_MOD = DEPTH * 48 * 8, N_G = 64, N_FC = 32, N_ALL = N_MOD + N_G + N_FC;
        for (int it = gw; it < N_ALL; it += NGW) {
            if (it < N_MOD) {
#ifndef SKIP_MOD
                const int kseg = it & 7, cb = (it >> 3) % 48, layer = it / 384, col = cb * 256 + lane * 4;
                f32x4 acc[NB];
#pragma unroll
                for (int b = 0; b < NB; ++b) acc[b] = (f32x4){0.f, 0.f, 0.f, 0.f};
                const float* wp = w_ada + ((size_t)layer * D + kseg * 256) * (NMOD * D) + col;
                const float* cbase = cact + (kseg * 256) * 20;
#pragma unroll 1
                for (int k0 = 0; k0 < 256; k0 += 8) {
                    f32x4 wv8[8];
#pragma unroll
                    for (int q = 0; q < 8; ++q) wv8[q] = *(const GAS f32x4*)(wp + (size_t)(k0 + q) * (NMOD * D));
#pragma unroll
                    for (int q = 0; q < 8; ++q) { asm volatile("" ::: "memory");
                        const f32x4 wv = wv8[q]; const GAS f32x4* cp = (const GAS f32x4*)(cbase + (k0 + q) * 20);
                        const f32x4 c0 = cp[0], c1 = cp[1], c2 = cp[2], c3 = cp[3]; const f32x2 c4 = *(const GAS f32x2*)(cp + 4);
                        acc[0] += wv * c0.x; acc[1] += wv * c0.y; acc[2] += wv * c0.z; acc[3] += wv * c0.w;
                        acc[4] += wv * c1.x; acc[5] += wv * c1.y; acc[6] += wv * c1.z; acc[7] += wv * c1.w;
                        acc[8] += wv * c2.x; acc[9] += wv * c2.y; acc[10] += wv * c2.z; acc[11] += wv * c2.w;
                        acc[12] += wv * c3.x; acc[13] += wv * c3.y; acc[14] += wv * c3.z; acc[15] += wv * c3.w;
                        acc[16] += wv * c4.x; acc[17] += wv * c4.y; }
                }
#pragma unroll
                for (int b = 0; b < NB; ++b) *(GAS f32x4*)(modp + (((size_t)kseg * DEPTH + layer) * NB + b) * (NMOD * D) + col) = acc[b];
#endif
            } else if (it < N_MOD + N_G) {
                const int r = it - N_MOD;
#pragma unroll 2
                for (int i = 0; i < 8; ++i) { const int e0 = r * 4096 + i * 512 + lane * 8, row = e0 >> 9, c0 = e0 & 511, part = row >> 8, k1 = row & 255, cpart = c0 >> 8; float f[8];
#pragma unroll
                    for (int e = 0; e < 8; ++e) { const int n1 = (c0 + e) & 255; const float ph = (float)((k1 * n1) & 255) * (1.0f / 256.0f), cs = __builtin_amdgcn_cosf(ph), sn = __builtin_amdgcn_sinf(ph);
                        f[e] = (part == cpart ? cs : (part == 0 ? sn : -sn)) * 0.0625f; }
                    v4u o; o.x = pk2(f[0], f[1]); o.y = pk2(f[2], f[3]); o.z = pk2(f[4], f[5]); o.w = pk2(f[6], f[7]);
                    *(GAS v4u*)(GM + e0) = o; }
            } else {
                const int r = it - N_MOD - N_G;
#pragma unroll 2
                for (int i = 0; i < 8; ++i) { const int e0 = r * 4096 + i * 512 + lane * 8, row = e0 >> 8, c0 = e0 & 255, part = row >> 8, j = row & 255; float f[8];
#pragma unroll
                    for (int e = 0; e < 8; ++e) { const float ph = (float)((j * (c0 + e)) & 255) * (1.0f / 256.0f);
                        f[e] = (part ? -__builtin_amdgcn_sinf(ph) : __builtin_amdgcn_cosf(ph)) * 0.0625f; }
                    v4u o; o.x = pk2(f[0], f[1]); o.y = pk2(f[2], f[3]); o.z = pk2(f[4], f[5]); o.w = pk2(f[6], f[7]);
                    *(GAS v4u*)(FC + e0) = o; }
            }
        }
    }
    GRID_BAR();
    { FRESH_TID(tid); const float* b_ada = KA()->in[5]; float* mod = (float*)WSP(WS_MOD); const float* modp = (const float*)WSP(WS_MODP);
      constexpr int NV = DEPTH * NB * (NMOD * D) / 4;
      for (int i = blockIdx.x * (NWAVES * 64) + tid; i < NV; i += G * NWAVES * 64) {
          const int layer = i / (NB * (NMOD * D) / 4), col4 = i % ((NMOD * D) / 4);
          f32x4 v = ((const GAS f32x4*)(b_ada + (size_t)layer * (NMOD * D)))[col4];
#pragma unroll
          for (int ks = 0; ks < 8; ++ks) v += ((const GAS f32x4*)modp)[(size_t)ks * NV + i];
          ((GAS f32x4*)mod)[i] = v; } }
    GRID_BAR();

#define CONVERT_RANGE(lane_, lo_, hi_, first_, stride_) do { const float* w_o_ = KA()->in[9]; const float* w1_ = KA()->in[12]; const float* w2_ = KA()->in[14]; bf16* WO_ = (bf16*)WSP(WS_WO); bf16* W1_ = (bf16*)WSP(WS_W1); bf16* W2_ = (bf16*)WSP(WS_W2); \
        LAS float* scr2_ = (LAS float*)(lds + CONV_SCR_OFF); const int I_B_ = is_attn ? (AW / 64) * (D / 32) : 0, I_1_ = (D / 64) * (FF / 32), I_2_ = (FF / 64) * (D / 32); \
        const int hi__ = (hi_) < I_B_ + I_1_ + I_2_ ? (hi_) : I_B_ + I_1_ + I_2_; \
        for (int it_ = (lo_) + (first_); it_ < hi__; it_ += (stride_)) { int r_ = it_; \
            if (r_ < I_B_) { transpose_item(w_o_ + (size_t)l2 * AW * D, AW, D, WO_, scr2_, r_, lane_); continue; } r_ -= I_B_; \
            if (r_ < I_1_) { transpose_item(w1_ + (size_t)l * D * FF, D, FF, W1_, scr2_, r_, lane_); continue; } r_ -= I_1_; \
            transpose_item(w2_ + (size_t)l * FF * D, FF, D, W2_, scr2_, r_, lane_); } } while (0)
#ifndef QKV_TAIL_ITEMS
#define QKV_TAIL_ITEMS 12288
#endif
#ifndef REP_CV
#define REP_CV 1
#endif
#define CONVERT_REST(lane_) do { for (int rcv_ = 0; rcv_ < REP_CV; ++rcv_) CONVERT_RANGE(lane_, (is_attn ? QKV_TAIL_ITEMS : 0), 0x7fffffff, gw, NGW); } while (0)
#ifndef PG8_SP2_SHORT
#define PG8_SP2_SHORT false
#endif
#ifndef PG8_ALIGN_WIDE
#define PG8_ALIGN_WIDE PG8_ALIGN
#endif
#ifndef PG8_ALIGN_SHORT
#define PG8_ALIGN_SHORT false
#endif
#ifndef PG8_WGM_WIDE
#define PG8_WGM_WIDE 4
#endif
#ifndef REP_W1
#define REP_W1 1
#endif
#ifndef REP_QKV
#define REP_QKV 1
#endif
#ifndef REP_N
#define REP_N 1
#endif
#ifndef REP_AT
#define REP_AT 1
#endif
#ifndef REP_FB
#define REP_FB 1
#endif
#ifndef REP_F1A
#define REP_F1A 1
#endif
    for (int l = 0; l < DEPTH; ++l) {
        const bool is_attn = (l & 1) == 0; const int l2 = l >> 1;
#define MODL() ((const float*)WSP(WS_MOD) + (size_t)l * NB * (NMOD * D))
        for (int rep_ = 0; rep_ < REP_N; ++rep_) {
            FRESH_TID(tid_); const int lane = tid_ & 63;
            const float* w_qkv = KA()->in[8]; const float* w_f = KA()->in[10]; bf16* WQKV = (bf16*)WSP(WS_WQKV); bf16* WF = (bf16*)WSP(WS_WF);
            const int I_A = is_attn ? (D / 64) * (QKVW / 32) : (D / 64) * (D / 32);
            for (int rcv_ = 0; rcv_ < REP_CV; ++rcv_) for (int it = gw; it < I_A; it += NGW) { if (is_attn) transpose_item(w_qkv + (size_t)l2 * D * QKVW, D, QKVW, WQKV, scr, it, lane); else transpose_item(w_f + (size_t)l2 * D * D, D, D, WF, scr, it, lane); }
            const float* x_p = KA()->in[0]; const float* x_s = KA()->in[1]; const bf16* XB = (const bf16*)WSP(WS_XB); const float* norm1_g = KA()->in[6]; const float* modl = MODL(); bf16* HM = (bf16*)WSP(WS_HM);
            for (int it = gw; it < M / 8; it += NGW) {
                const int row0 = (M / 8 - 1 - it) * 8, b = batch_of_tile(row0 >> 8);
                const float* mb = modl + (size_t)b * (NMOD * D);
                if (l == 0) norm_chunk(row0 < MP ? x_p + (size_t)row0 * D : x_s + (size_t)(row0 - MP) * D, HM + (size_t)row0 * D, norm1_g + l * D, mb, mb + D, lane);
                else norm_chunk_b(XB + (size_t)row0 * D, HM + (size_t)row0 * D, norm1_g + l * D, mb, mb + D, lane);
            }
        }
        GRID_BAR();
        if (is_attn) {
            for (int rep_ = 0; rep_ < REP_QKV; ++rep_) { pg8::GemmDesc g = pg8::wtm_gemm(WSP(WS_HM), WSP(WS_WQKV), D, D, M / 256); pg8::StaticOrder S; S.init(M / 256, QKVW / 256, G, (int)blockIdx.x, PG8_WGM_WIDE);
              pg8::EpiQKV E{(bf16*)WSP(WS_R), 0.08838834764831845f * LOG2E};
              pg8::gemm_phase<pg8::EpiQKV, pg8::StaticOrder, PG8_ALIGN_WIDE, PG8_SP2>(lds, g, S, E); }
            {
                const int nfull = (M / 256) * (QKVW / 256) - ((M / 256) * (QKVW / 256) / G) * G;
                if ((int)blockIdx.x >= nfull && QKV_TAIL_ITEMS > 0) { FRESH_TID(tid_);
#define CONV_SCR_OFF (wave * 16384)
                    for (int rcv_ = 0; rcv_ < REP_CV; ++rcv_) CONVERT_RANGE(tid_ & 63, 0, QKV_TAIL_ITEMS, ((int)blockIdx.x - nfull) * NWAVES + wave, (G - nfull) * NWAVES);
#undef CONV_SCR_OFF
                } }
            GRID_BAR();
#ifndef SKIP_ATTN
            { FRESH_TID(tid_); const bf16* RB = (const bf16*)WSP(WS_R); bf16* HM = (bf16*)WSP(WS_HM); float* lse = (float*)WSP(WS_LSE);
              const int vcu = (G % 8 == 0) ? ((int)blockIdx.x % 8) * (G / 8) + (int)blockIdx.x / 8 : (int)blockIdx.x;
              for (int rep_ = 0; rep_ < REP_AT; ++rep_) attn_phase_coop(lds, RB, HM, lse, vcu, G, wave, tid_ & 63);
#define CONV_SCR_OFF (wave * 16384)
              CONVERT_REST(tid_ & 63);
#undef CONV_SCR_OFF
            }
#endif
            GRID_BAR();
            { FRESH_TID(tid_); const int lane = tid_ & 63; bf16* HM = (bf16*)WSP(WS_HM); const float* lse = (const float*)WSP(WS_LSE);
            for (int m = gw * 2; m < M; m += NGW * 2) {
                v4u vv[9]; float al[9];
#pragma unroll
                for (int i = 0; i < 9; ++i) { const int cc = lane + 64 * i, rr = cc >= AW / 8 ? 1 : 0, c = cc - rr * (AW / 8), head = c >> 4, hh = head % 6; const float* lr = lse + (size_t)(m + rr) * NH;
                    const float l0 = lr[hh], l1 = lr[6 + hh], l2v = lr[12 + hh], mxl = fmaxf(l0, fmaxf(l1, l2v));
                    const float e0 = __expf(l0 - mxl), e1 = __expf(l1 - mxl), e2 = __expf(l2v - mxl); al[i] = (head < 6 ? e0 : (head < 12 ? e1 : e2)) * __builtin_amdgcn_rcpf(e0 + e1 + e2);
                    vv[i] = *((const GAS v4u*)(HM + (size_t)m * AW) + cc); }
#pragma unroll
                for (int i = 0; i < 9; ++i) { const int cc = lane + 64 * i; const v4u v = vv[i]; const float a = al[i]; v4u o;
                    o.x = pk2(bf_lo(v.x) * a, bf_hi(v.x) * a); o.y = pk2(bf_lo(v.y) * a, bf_hi(v.y) * a); o.z = pk2(bf_lo(v.z) * a, bf_hi(v.z) * a); o.w = pk2(bf_lo(v.w) * a, bf_hi(v.w) * a);
                    *((GAS v4u*)(HM + (size_t)m * AW) + cc) = o; }
            } }
            GRID_BAR();
            if (l == 0) { pg8::GemmDesc g = pg8::wtm_gemm(WSP(WS_HM), WSP(WS_WO), AW, AW, M / 256); pg8::StaticOrder S; S.init(M / 256, D / 256, G, (int)blockIdx.x, PG8_WGM, 1);
              pg8::EpiRes<true> E{KA()->in[0], KA()->in[1], (bf16*)WSP(WS_XB), nullptr, MODL() + 2 * D};
              pg8::gemm_phase<pg8::EpiRes<true>, pg8::StaticOrder, PG8_ALIGN, PG8_SP2>(lds, g, S, E); }
            else { pg8::GemmDesc g = pg8::wtm_gemm(WSP(WS_HM), WSP(WS_WO), AW, AW, M / 256); pg8::StaticOrder S; S.init(M / 256, D / 256, G, (int)blockIdx.x, PG8_WGM, 1);
              pg8::EpiRes<false> E{nullptr, nullptr, (bf16*)WSP(WS_XB), nullptr, MODL() + 2 * D};
              pg8::gemm_phase<pg8::EpiRes<false>, pg8::StaticOrder, PG8_ALIGN, PG8_SP2>(lds, g, S, E); }
        } else {
            for (int rep_ = 0; rep_ < REP_F1A; ++rep_) { pg8::GemmDesc g{(const char*)WSP(WS_FC), (const char*)WSP(WS_HM), 256, (SEQP / 256) * D, 256, 2, 8, 1, 0, 0, (long long)SEQP * D * 2, 512, (long long)D * 2, 0, 128, 128}; pg8::StaticOrder S; S.init(NBP * 8 * 2, SEQP / 256, G, (int)blockIdx.x);
              pg8::EpiZT E{(bf16*)WSP(WS_R), 0, SEQP, SEQP / 256};
              pg8::gemm_phase<pg8::EpiZT, pg8::StaticOrder, PG8_ALIGN_SHORT, PG8_SP2_SHORT>(lds, g, S, E); }
            for (int rep_ = 0; rep_ < REP_F1A; ++rep_) { pg8::GemmDesc g{(const char*)WSP(WS_FC), (const char*)((bf16*)WSP(WS_HM) + (size_t)MP * D), 256, (SEQS / 256) * D, 256, 2, 8, 1, 0, 0, (long long)SEQS * D * 2, 512, (long long)D * 2, 0, 128, 128}; pg8::StaticOrder S; S.init(NBS * 8 * 2, SEQS / 256, G, (int)blockIdx.x);
              pg8::EpiZT E{(bf16*)WSP(WS_R), MP, SEQS, SEQS / 256};
              pg8::gemm_phase<pg8::EpiZT, pg8::StaticOrder, PG8_ALIGN_SHORT, PG8_SP2_SHORT>(lds, g, S, E); }
            GRID_BAR();
            for (int rep_ = 0; rep_ < REP_F1A; ++rep_) { constexpr int N2 = SEQP / 256; pg8::GemmDesc g{(const char*)WSP(WS_G), (const char*)WSP(WS_R), 512, N2 * 512, 512, 2, 1, 8, 0, 0, (long long)4096 * SEQP * 2, 0, 1024, (long long)256 * N2 * 1024, 128, 128};
              pg8::StaticOrder S; S.init(NBP * 2, N2 * 8, G, (int)blockIdx.x);
              pg8::EpiAO E{(bf16*)WSP(WS_AO), 0, SEQP, N2};
              pg8::gemm_phase<pg8::EpiAO, pg8::StaticOrder, PG8_ALIGN_SHORT, PG8_SP2_SHORT>(lds, g, S, E); }
            for (int rep_ = 0; rep_ < REP_F1A; ++rep_) { constexpr int N2 = SEQS / 256; pg8::GemmDesc g{(const char*)WSP(WS_G), (const char*)((bf16*)WSP(WS_R) + (size_t)4096 * MP), 512, N2 * 512, 512, 2, 1, 8, 0, 0, (long long)4096 * SEQS * 2, 0, 1024, (long long)256 * N2 * 1024, 128, 128};
              pg8::StaticOrder S; S.init(NBS * 2, N2 * 8, G, (int)blockIdx.x);
              pg8::EpiAO E{(bf16*)WSP(WS_AO), MP, SEQS, N2};
              pg8::gemm_phase<pg8::EpiAO, pg8::StaticOrder, PG8_ALIGN_SHORT, PG8_SP2_SHORT>(lds, g, S, E); }
            GRID_BAR();
            for (int rep_ = 0; rep_ < REP_FB; ++rep_) { FRESH_TID(tid_); const int lane = tid_ & 63; const bf16* AO = (const bf16*)WSP(WS_AO); bf16* HM = (bf16*)WSP(WS_HM); LAS float* tw = (LAS float*)(lds + wave * 8192);
              for (int it = gw; it < NBP * 256 * 4; it += NGW) { const int b = it >> 10, k1 = (it >> 2) & 255, cg = it & 3;
                  fbc_item<SEQP / 256>(AO + (size_t)4096 * (b * SEQP), HM + (size_t)(b * SEQP) * D, k1, cg, tw, lane); }
              for (int it = gw; it < NBS * 256 * 4; it += NGW) { const int b = it >> 10, k1 = (it >> 2) & 255, cg = it & 3;
                  fbc_item<SEQS / 256>(AO + (size_t)4096 * (MP + b * SEQS), HM + (size_t)(MP + b * SEQS) * D, k1, cg, tw, lane); }
#define CONV_SCR_OFF (SCR2_OFF + wave * SCR2_STRIDE)
              if (rep_ == 0) CONVERT_REST(lane);
#undef CONV_SCR_OFF
            }
            GRID_BAR();
            { pg8::GemmDesc g = pg8::wtm_gemm(WSP(WS_HM), WSP(WS_WF), D, D, M / 256); pg8::StaticOrder S; S.init(M / 256, D / 256, G, (int)blockIdx.x, PG8_WGM, 1);
              pg8::EpiRes<false> E{nullptr, nullptr, (bf16*)WSP(WS_XB), KA()->in[11] + (size_t)l2 * D, MODL() + 2 * D};
              pg8::gemm_phase<pg8::EpiRes<false>, pg8::StaticOrder, PG8_ALIGN, PG8_SP2>(lds, g, S, E); }
        }
        GRID_BAR();
        for (int rep_ = 0; rep_ < REP_N; ++rep_) { FRESH_TID(tid_); const int lane = tid_ & 63; const bf16* XB = (const bf16*)WSP(WS_XB); const float* norm2_g = KA()->in[7]; const float* modl = MODL(); bf16* HM = (bf16*)WSP(WS_HM);
        for (int it = gw; it < M / 8; it += NGW) {
            const int row0 = it * 8, b = batch_of_tile(row0 >> 8);
            const float* mb = modl + (size_t)b * (NMOD * D) + 3 * D;
            norm_chunk_b(XB + (size_t)row0 * D, HM + (size_t)row0 * D, norm2_g + l * D, mb, mb + D, lane);
        } }
        GRID_BAR();
        for (int rep_ = 0; rep_ < REP_W1; ++rep_) { pg8::GemmDesc g = pg8::wtm_gemm(WSP(WS_HM), WSP(WS_W1), D, D, M / 256); pg8::StaticOrder S; S.init(M / 256, FF / 256, G, (int)blockIdx.x, PG8_WGM_WIDE, 1);
          pg8::EpiBf16<1, true> E{(bf16*)WSP(WS_R), FF, KA()->in[13] + (size_t)l * FF, 0};
          pg8::gemm_phase<pg8::EpiBf16<1, true>, pg8::StaticOrder, PG8_ALIGN_WIDE, PG8_SP2>(lds, g, S, E); }
        GRID_BAR();
#ifdef PROBE_W1NULL
        { pg8::GemmDesc g = pg8::wtm_gemm(WSP(WS_HM), WSP(WS_W1), D, D, M / 256);
#if PROBE_W1NULL == 2
          g.nMb = 1; g.pB1 = 0;
#endif
 pg8::StaticOrder S; S.init(M / 256, FF / 256, G, (int)blockIdx.x, PG8_WGM_WIDE);
          pg8::EpiNull E{};
          pg8::gemm_phase<pg8::EpiNull, pg8::StaticOrder, PG8_ALIGN, PG8_SP2>(lds, g, S, E); }
#endif
#ifdef PROBE_W2
        { pg8::GemmDesc g = pg8::GemmDesc{(const char*)WSP(WS_R), (const char*)WSP(WS_W2), 64, 64, FF, 1, 1, 1, (long long)FF * 512, 0, 0, 0, 512ll * FF, 0, 32768, 32768};     pg8::StaticOrder S; S.init(M / 256, D / 256, G, (int)blockIdx.x);
          pg8::EpiBf16<0> E{(bf16*)WSP(WS_END), D, nullptr, 0};
          pg8::gemm_phase<pg8::EpiBf16<0>, pg8::StaticOrder, PG8_ALIGN, PG8_SP2>(lds, g, S, E); }
#endif
        { pg8::GemmDesc g = pg8::GemmDesc{(const char*)WSP(WS_R), (const char*)WSP(WS_W2), 64, 64, FF, 1, 1, 1, (long long)FF * 512, 0, 0, 0, 512ll * FF, 0, 32768, 32768};     pg8::StaticOrder S; S.init(M / 256, D / 256, G, (int)blockIdx.x);
          pg8::EpiRes<false> E{nullptr, nullptr, (bf16*)WSP(WS_XB), KA()->in[15] + (size_t)l * D, MODL() + 5 * D};
          pg8::gemm_phase<pg8::EpiRes<false>, pg8::StaticOrder, PG8_ALIGN, PG8_SP2>(lds, g, S, E); }
        GRID_BAR();
    }
#ifdef PROBE_STAMP
    {
        FRESH_TID(tid); float* yout = KA()->out; const unsigned long long* st = STAMPS();
        float va = 0.f, vb = 0.f;
        for (int k = 0; k < stamp_idx; ++k) { const float work = (k == 0) ? 0.f : (float)(st[2 * k] - st[2 * k - 1]) * 0.01f, wait = (float)(st[2 * k + 1] - st[2 * k]) * 0.01f;
            if (PROBE_SEL_A(k, 0)) va += work; if (PROBE_SEL_A(k, 1)) va += wait; if (PROBE_SEL_B(k, 0)) vb += work; if (PROBE_SEL_B(k, 1)) vb += wait; }
        va = __builtin_exp2f(rintf(__builtin_log2f(fmaxf(va, 1.f)) * 2.0600f) / 2.0600f); vb = __builtin_exp2f(rintf(__builtin_log2f(fmaxf(vb, 1.f)) * 2.0600f) / 2.0600f);
        const float cval = sqrtf(vb);
        for (size_t i = (size_t)blockIdx.x * (NWAVES * 64) + tid; i < (size_t)M * D; i += (size_t)G * NWAVES * 64) yout[i] = (i < (size_t)MP * D / 4) ? cval : (i == (size_t)MP * D ? va : 0.f);
        return;
    }
#endif
    FRESH_TID(tid_); const int lane = tid_ & 63; float* yout = KA()->out; const bf16* XB = (const bf16*)WSP(WS_XB); const float* final_g = KA()->in[16];
    for (int mf = gw; mf < M; mf += NGW) { const int m = M - 1 - mf;
        const GAS v4u* xr = (const GAS v4u*)(XB + (size_t)m * D) + lane;
        f32x4 v[4][2]; float ss = 0.f;
#pragma unroll
        for (int j = 0; j < 4; ++j) { const v4u w = xr[64 * j];
            v[j][0] = (f32x4){bf_lo(w.x), bf_hi(w.x), bf_lo(w.y), bf_hi(w.y)}; v[j][1] = (f32x4){bf_lo(w.z), bf_hi(w.z), bf_lo(w.w), bf_hi(w.w)};
#pragma unroll
            for (int e = 0; e < 2; ++e) ss += (v[j][e].x * v[j][e].x + v[j][e].y * v[j][e].y) + (v[j][e].z * v[j][e].z + v[j][e].w * v[j][e].w); }
        const float rstd = 1.0f / sqrtf(wave_sum(ss) * (1.0f / D) + RMS_EPS);
#pragma unroll
        for (int j = 0; j < 4; ++j)
#pragma unroll
            for (int e = 0; e < 2; ++e) { const int col = 8 * lane + 512 * j + 4 * e; *(GAS f32x4*)(yout + (size_t)m * D + col) = (v[j][e] * rstd) * *(const f32x4*)(final_g + col); }
    }
}

extern "C" void kernel_launch(void* const* d_in, const int* in_sizes, int n_in, void* d_out, int out_size, void* d_ws, size_t ws_size, hipStream_t stream) {
    static int grid = 0;
    if (grid == 0) {
        if (n_in != 17 || out_size != M * D || ws_size < WS_END) { fprintf(stderr, "kernel_launch: unexpected shapes (n_in %d, out %d, ws %zu < %zu); nothing launched\n", n_in, out_size, ws_size, (size_t)WS_END); grid = -1; return; }
        int dev = 0, cus = 0, per_cu = 0;
        if (hipGetDevice(&dev) != hipSuccess || hipDeviceGetAttribute(&cus, hipDeviceAttributeMultiprocessorCount, dev) != hipSuccess) { grid = -1; return; }
        if (hipFuncSetAttribute((const void*)fwd, hipFuncAttributeMaxDynamicSharedMemorySize, LDS_BYTES) != hipSuccess) { fprintf(stderr, "kernel_launch: hipFuncSetAttribute failed\n"); grid = -1; return; }
        if (hipOccupancyMaxActiveBlocksPerMultiprocessor(&per_cu, (const void*)fwd, NWAVES * 64, LDS_BYTES) != hipSuccess || per_cu < 1)
            fprintf(stderr, "kernel_launch: note: occupancy query reports %d workgroups per CU\n", per_cu);
        (void)hipGetLastError();
        grid = cus;
    }
    if (grid < 0) return;
    if (hipMemsetAsync((char*)d_ws + WS_CTL, 0, CTL_ZERO_BYTES, stream) != hipSuccess) { fprintf(stderr, "kernel_launch: hipMemsetAsync failed\n"); return; }
    Args a{};
    for (int i = 0; i < 17; ++i) a.in[i] = (const float*)d_in[i];
    a.out = (float*)d_out; a.ws = (unsigned char*)d_ws;
    hipLaunchKernelGGL(fwd, dim3(grid), dim3(NWAVES * 64), LDS_BYTES, stream, a);
    const hipError_t le = hipPeekAtLastError();
    if (le != hipSuccess) fprintf(stderr, "kernel_launch: launch failed: %s\n", hipGetErrorName(le));
}
```

```cpp
#include <hip/hip_runtime.h>
#include <cstdio>
#include <cstdint>

#ifndef PG8_SNAKE
#define PG8_SNAKE 1
#endif
#ifndef PG8_WGM
#define PG8_WGM 4
#endif
namespace pg8 {
#define PG8_LAS __attribute__((address_space(3)))
typedef unsigned short bf16_t;
typedef short bf16x8 __attribute__((ext_vector_type(8)));
typedef float f32x4 __attribute__((ext_vector_type(4)));
typedef float f32x2 __attribute__((ext_vector_type(2)));
typedef unsigned u32x4 __attribute__((ext_vector_type(4)));
constexpr int BM = 256, BK = 64, HALF = 128, HTB = HALF * BK * 2  , STAGE_BYTES = 8 * HTB, NXCD = 8, WGM = PG8_WGM;

__host__ __device__ __forceinline__ int lds_byte(int r, int c) { const int st = (r >> 4) * 2 + (c >> 5), rr = r & 15, cc = c & 31, ob = rr * 64 + cc * 2; return st * 1024 + (ob ^ (((ob >> 9) & 1) << 5)); }
__host__ __device__ __forceinline__ void stage_rc(int b, int& R, int& C) { const int st = b / 1024, sb = b % 1024, swz = sb ^ (((sb >> 9) & 1) << 5); R = (st >> 1) * 16 + swz / 64; C = (st & 1) * 32 + (swz % 64) / 2; }
__host__ __device__ __forceinline__ int perm32(int rho) { const int n = rho >> 4, i = rho & 15; return 8 * (i >> 2) + 4 * n + (i & 3); }

struct Unit { int pm, pn; };

struct GemmDesc {
    const char* A; const char* B;
    int lda, ldb, K;
    int nMb, zdiv, pdiv;
    long long sA1, sA2, sB1, sB2;
    long long pB1, pB2;
    int kstepA;
    int kstepB;
    __device__ __forceinline__ const char* aptr(const Unit& u) const { const int z = u.pm / nMb, pml = u.pm - z * nMb, z1 = z / zdiv, z2 = z - z1 * zdiv; return A + (long long)pml * (512ll * lda) + z1 * sA1 + z2 * sA2; }
    __device__ __forceinline__ const char* bptr(const Unit& u) const { const int z = u.pm / nMb, z1 = z / zdiv, z2 = z - z1 * zdiv, p1 = u.pn / pdiv, p2 = u.pn - p1 * pdiv; return B + p1 * pB1 + p2 * pB2 + z1 * sB1 + z2 * sB2; }
};
__device__ __forceinline__ GemmDesc plain_gemm(const void* A, const void* B, int lda, int ldb, int K, int nM) { return GemmDesc{(const char*)A, (const char*)B, lda, ldb, K, nM, 1, 1, 0, 0, 0, 0, 512ll * ldb, 0, 128, 128}; }
__device__ __forceinline__ GemmDesc wtm_gemm(const void* A, const void* B, int lda, int K, int nM) { return GemmDesc{(const char*)A, (const char*)B, lda, 64, K, nM, 1, 1, 0, 0, 0, 0, 512ll * K, 0, 128, 32768}; }

struct StaticOrder {
    int nM, nN, nwg, G, c, wgm, rev;
    __host__ __device__ void init(int nM_, int nN_, int G_, int c_, int wgm_ = WGM, int rev_ = 0) { nM = nM_; nN = nN_; nwg = nM * nN; G = G_; c = c_; wgm = wgm_; rev = rev_; }
    __host__ __device__ bool next(int i, Unit& u) const {
        const long L = (long)i * G + c; if (L >= nwg) return false;
        int wgid = (int)L; { const int q = nwg / NXCD, r = nwg % NXCD, xcd = wgid % NXCD, off = wgid / NXCD; wgid = (xcd < r ? xcd * (q + 1) : r * (q + 1) + (xcd - r) * q) + off; }
        const int nig = wgm * nN, gid = wgid / nig, fm = gid * wgm, gsz = (nM - fm) < wgm ? (nM - fm) : wgm;
        u.pm = fm + ((wgid % nig) % gsz); u.pn = (wgid % nig) / gsz; if (PG8_SNAKE && (gid & 1)) u.pn = nN - 1 - u.pn; if (rev) u.pm = nM - 1 - u.pm; return true;
    }
    __device__ __forceinline__ void a_ready(const Unit&) const {}
    __device__ __forceinline__ void done(const Unit&) const {}
#ifndef PG8_KROT
#define PG8_KROT 1
#endif
#ifndef PG8_STAG_TICKS
#define PG8_STAG_TICKS 0
#endif
    __device__ __forceinline__ void stagger() const { if (PG8_STAG_TICKS > 0) { const unsigned long long t0 = __builtin_amdgcn_s_memrealtime(), d = (unsigned long long)(((c >> 3) & 3) * PG8_STAG_TICKS);
        while (__builtin_amdgcn_s_memrealtime() - t0 < d) __builtin_amdgcn_s_sleep(4); } }
    __device__ __forceinline__ int krot(int nt) const { return PG8_KROT ? 2 * (((c & 7) * (nt >> 1)) >> 3) : 0; }
};

__device__ __forceinline__ unsigned cvt_pk_bf16(float lo, float hi) { unsigned r; asm volatile("v_cvt_pk_bf16_f32 %0, %1, %2" : "=v"(r) : "v"(lo), "v"(hi)); return r; }

template <class Epi, class Sched, bool ALIGN_EPI = false, bool SP2 = false>
__device__ __forceinline__ void gemm_phase(PG8_LAS unsigned char* lds, const GemmDesc g, const Sched& S, const Epi& E) {
    int tid_ = threadIdx.x; asm volatile("" : "+v"(tid_));
    const int tid = tid_, wid = __builtin_amdgcn_readfirstlane(tid >> 6), lane = tid & 63, wr = wid >> 2, wc = wid & 3, fr = lane & 15, fq = lane >> 4;
    const int K = g.K, nt = K / BK;
    unsigned voffA[2], voffB[2];
#pragma unroll
    for (int i = 0; i < 2; ++i) { int R, C; stage_rc(tid * 16 + i * 8192, R, C); const int Rb = Epi::PERM ? ((R & ~31) + perm32(R & 31)) : R;
        voffA[i] = (unsigned)(R * g.lda + C) * 2u; voffB[i] = (unsigned)(Rb * g.ldb + C) * 2u; }
    const size_t kstep = (size_t)g.kstepB, kA = (size_t)g.kstepA;
    const size_t hA = (size_t)HALF * g.lda * 2, hB = (size_t)HALF * g.ldb * 2;
    const unsigned ldsw = (unsigned)wid * 1024u;
    const int aoff = lds_byte(wr * 64 + fr, fq * 8), boff = lds_byte(wc * 32 + fr, fq * 8);
#define PG8_SA(b, h) (((b) * 2 + (h)) * HTB)
#define PG8_SB(b, h) ((4 + (b) * 2 + (h)) * HTB)
#define PG8_STAGE(bufoff, gbase, voff) do { _Pragma("unroll") for (int _i = 0; _i < 2; ++_i) \
        __builtin_amdgcn_global_load_lds((const unsigned*)((const char*)(gbase) + (voff)[_i]), (PG8_LAS unsigned*)(lds + (bufoff) + ldsw + _i * 8192), 16, 0, 0); } while (0)
#define PG8_LDA(dst, b, h) do { _Pragma("unroll") for (int m = 0; m < 4; ++m) _Pragma("unroll") for (int k = 0; k < 2; ++k) dst[m][k] = *(const PG8_LAS bf16x8*)(lds + PG8_SA(b, h) + aoff + m * 2048 + k * 1024); } while (0)
#define PG8_LDB(dst, b, h) do { _Pragma("unroll") for (int n = 0; n < 2; ++n) _Pragma("unroll") for (int k = 0; k < 2; ++k) dst[n][k] = *(const PG8_LAS bf16x8*)(lds + PG8_SB(b, h) + boff + n * 2048 + k * 1024); } while (0)
#define PG8_MMA(ai, bj, At, Bt) do { __builtin_amdgcn_s_setprio(1); _Pragma("unroll") for (int m = 0; m < 4; ++m) _Pragma("unroll") for (int n = 0; n < 2; ++n) _Pragma("unroll") for (int k = 0; k < 2; ++k) \
        acc[ai][bj][m][n] = __builtin_amdgcn_mfma_f32_16x16x32_bf16(Bt[n][k], At[m][k], acc[ai][bj][m][n], 0, 0, 0); __builtin_amdgcn_s_setprio(0); } while (0)
#define PG8_WAIT_V(n) asm volatile("s_waitcnt vmcnt(" #n ")" ::: "memory")
#define PG8_WAIT_L(n) asm volatile("s_waitcnt lgkmcnt(" #n ")" ::: "memory")
#define PG8_BAR __builtin_amdgcn_s_barrier()
#define PG8_SCHED __builtin_amdgcn_sched_barrier(0)
    Unit cur, nxt; int ui = 0;
    if (!S.next(0, cur)) return;
    S.stagger();
    f32x4 acc[2][2][4][2];
#pragma unroll
    for (int a = 0; a < 2; ++a)
#pragma unroll
        for (int b = 0; b < 2; ++b)
#pragma unroll
            for (int m = 0; m < 4; ++m)
#pragma unroll
                for (int n = 0; n < 2; ++n) acc[a][b][m][n] = (f32x4){0.f, 0.f, 0.f, 0.f};
    bf16x8 At[4][2], B0[2][2], B1[2][2];
    typename Epi::Pre pre;
    const char* cA = g.aptr(cur); const char* cB = g.bptr(cur);
    const int r0 = S.krot(nt); const size_t roff = (size_t)r0 * kstep, roffA = (size_t)r0 * kA;
    S.a_ready(cur);
    if constexpr (SP2) {
        PG8_STAGE(PG8_SB(0, 0), cB + roff, voffB); PG8_STAGE(PG8_SB(0, 1), cB + roff + hB, voffB); PG8_STAGE(PG8_SA(0, 0), cA + roffA, voffA); PG8_STAGE(PG8_SA(0, 1), cA + roffA + hA, voffA);
        if (wr == 1) PG8_BAR;
        PG8_WAIT_V(2); PG8_BAR;
        PG8_STAGE(PG8_SB(1, 0), cB + roff + kstep, voffB); PG8_STAGE(PG8_SA(1, 0), cA + roffA + kA, voffA); PG8_STAGE(PG8_SB(1, 1), cB + roff + hB + kstep, voffB);
        PG8_WAIT_V(6); PG8_BAR;
    } else {
        PG8_STAGE(PG8_SB(0, 0), cB + roff, voffB); PG8_STAGE(PG8_SA(0, 0), cA + roffA, voffA); PG8_STAGE(PG8_SB(0, 1), cB + roff + hB, voffB); PG8_STAGE(PG8_SA(0, 1), cA + roffA + hA, voffA);
        if (wr == 1) PG8_BAR;
        PG8_WAIT_V(4); PG8_BAR;
        PG8_STAGE(PG8_SB(1, 0), cB + roff + kstep, voffB); PG8_STAGE(PG8_SA(1, 0), cA + roffA + kA, voffA); PG8_STAGE(PG8_SB(1, 1), cB + roff + hB + kstep, voffB);
        PG8_WAIT_V(6); PG8_BAR;
    }
    for (;;) {
        const bool has_next = S.next(ui + 1, nxt);
        const char* nA = has_next ? g.aptr(nxt) : cA; const char* nB = has_next ? g.bptr(nxt) : cB;
        for (int t = 0; t < nt; t += 2) {
            const bool last = (t == nt - 2);
            int tt = t + r0; if (tt >= nt) tt -= nt; int tt2 = tt + 2; if (tt2 >= nt) tt2 -= nt;
            const char* a1 = cA + (size_t)(tt + 1) * kA;
            const char* a2 = last ? nA + roffA : cA + (size_t)tt2 * kA; const char* b2 = last ? nB + roff : cB + (size_t)tt2 * kstep;
            const char* a3 = a2 + kA; const char* b3 = b2 + kstep;
            if (last && has_next) S.a_ready(nxt);
            if (last) E.prefetch(pre, cur, wc, fq);
            if constexpr (SP2) {
            PG8_LDB(B0, 0, 0); PG8_LDB(B1, 0, 1); PG8_SCHED; PG8_LDA(At, 0, 0); PG8_STAGE(PG8_SA(1, 1), a1 + hA, voffA);
            PG8_WAIT_V(8); PG8_WAIT_L(0); PG8_BAR; PG8_MMA(0, 0, At, B0); PG8_MMA(0, 1, At, B1); PG8_BAR; PG8_SCHED;
            PG8_LDA(At, 0, 1); PG8_STAGE(PG8_SB(0, 0), b2, voffB); PG8_STAGE(PG8_SB(0, 1), b2 + hB, voffB); PG8_STAGE(PG8_SA(0, 0), a2, voffA);
            PG8_WAIT_V(8); PG8_WAIT_L(0); PG8_BAR; PG8_MMA(1, 0, At, B0); PG8_MMA(1, 1, At, B1); PG8_BAR; PG8_SCHED;
            PG8_LDB(B0, 1, 0); PG8_LDB(B1, 1, 1); PG8_SCHED; PG8_LDA(At, 1, 0); PG8_STAGE(PG8_SA(0, 1), a2 + hA, voffA);
            PG8_WAIT_V(8); PG8_WAIT_L(0); PG8_BAR; PG8_MMA(0, 0, At, B0); PG8_MMA(0, 1, At, B1); PG8_BAR; PG8_SCHED;
            PG8_LDA(At, 1, 1); PG8_STAGE(PG8_SB(1, 0), b3, voffB); PG8_STAGE(PG8_SB(1, 1), b3 + hB, voffB); PG8_STAGE(PG8_SA(1, 0), a3, voffA);
            PG8_WAIT_V(8); PG8_WAIT_L(0); PG8_BAR; PG8_MMA(1, 0, At, B0); PG8_MMA(1, 1, At, B1); PG8_BAR; PG8_SCHED;
            } else {
            PG8_LDB(B0, 0, 0); PG8_SCHED; PG8_LDA(At, 0, 0); PG8_STAGE(PG8_SA(1, 1), a1 + hA, voffA);
            PG8_WAIT_L(8); PG8_BAR; PG8_WAIT_L(0); PG8_MMA(0, 0, At, B0); PG8_BAR; PG8_SCHED;
            PG8_LDB(B1, 0, 1); PG8_STAGE(PG8_SB(0, 0), b2, voffB);
            PG8_BAR; PG8_WAIT_L(0); PG8_MMA(0, 1, At, B1); PG8_BAR;
            PG8_LDA(At, 0, 1); PG8_STAGE(PG8_SA(0, 0), a2, voffA);
            PG8_BAR; PG8_WAIT_L(0); PG8_MMA(1, 0, At, B0); PG8_BAR; PG8_SCHED;
            PG8_STAGE(PG8_SB(0, 1), b2 + hB, voffB);
            PG8_WAIT_V(6); PG8_BAR; PG8_MMA(1, 1, At, B1); PG8_BAR;
            PG8_LDB(B0, 1, 0); PG8_SCHED; PG8_LDA(At, 1, 0); PG8_STAGE(PG8_SA(0, 1), a2 + hA, voffA);
            PG8_WAIT_L(8); PG8_BAR; PG8_WAIT_L(0); PG8_MMA(0, 0, At, B0); PG8_BAR; PG8_SCHED;
            PG8_LDB(B1, 1, 1); PG8_STAGE(PG8_SB(1, 0), b3, voffB);
            PG8_BAR; PG8_WAIT_L(0); PG8_MMA(0, 1, At, B1); PG8_BAR;
            PG8_LDA(At, 1, 1); PG8_STAGE(PG8_SA(1, 0), a3, voffA);
            PG8_BAR; PG8_WAIT_L(0); PG8_MMA(1, 0, At, B0); PG8_BAR; PG8_SCHED;
            PG8_STAGE(PG8_SB(1, 1), b3 + hB, voffB);
            PG8_WAIT_V(6); PG8_BAR; PG8_MMA(1, 1, At, B1); PG8_BAR;
            }
        }
        if constexpr (ALIGN_EPI) { if (wr == 0) PG8_BAR; }
        if constexpr (!Epi::AFTER_DRAIN) { E(acc, cur, wr, wc, fr, fq, pre); S.done(cur); }
        if (!has_next) break;
#pragma unroll
        for (int a = 0; a < 2; ++a)
#pragma unroll
            for (int b = 0; b < 2; ++b)
#pragma unroll
                for (int m = 0; m < 4; ++m)
#pragma unroll
                    for (int n = 0; n < 2; ++n) acc[a][b][m][n] = (f32x4){0.f, 0.f, 0.f, 0.f};
        cur = nxt; cA = nA; cB = nB; ++ui;
        if constexpr (ALIGN_EPI) { if (wr == 1) PG8_BAR; }
    }
    PG8_WAIT_V(0);
    if constexpr (!ALIGN_EPI) { if (wr == 0) PG8_BAR; }
    PG8_BAR;
    if constexpr (Epi::AFTER_DRAIN) { E.fused(acc, cur, wr, wc, fr, fq, lds, wid, lane); S.done(cur); }
#undef PG8_SA
#undef PG8_SB
#undef PG8_STAGE
#undef PG8_LDA
#undef PG8_LDB
#undef PG8_MMA
#undef PG8_WAIT_V
#undef PG8_WAIT_L
#undef PG8_BAR
#undef PG8_SCHED
}
}

constexpr int D = 2048, SEQP = 8192, SEQS = 2048, NBP = 2, NBS = 16, NB = NBP + NBS;
constexpr int MP = NBP * SEQP, MS = NBS * SEQS, M = MP + MS;
constexpr int NH = 18, HD = 128, AW = NH * HD, QKVW = 3 * AW, FF = 4 * D, DEPTH = 4, NMOD = 6;
constexpr float RMS_EPS = 1e-6f, LOG2E = 1.4426950408889634f, LN2 = 0.6931471805599453f;
constexpr int NWAVES = 8;
#ifndef LDU_PAD
#define LDU_PAD 64
#endif
constexpr int LDU = FF + LDU_PAD;

constexpr size_t MiB = 1u << 20;
constexpr size_t WS_CTL = 0, CTL_ZERO_BYTES = 1 * MiB;
constexpr size_t WS_MOD = 1 * MiB;
constexpr size_t WS_CACT = 5 * MiB;
constexpr size_t WS_LSE = 6 * MiB;
constexpr size_t WS_FC = 10 * MiB;
constexpr size_t WS_G = 11 * MiB;
constexpr size_t WS_W = 12 * MiB;
constexpr size_t WS_WQKV = WS_W, WS_WF = WS_W, WS_WO = WS_W + 27 * MiB, WS_W1 = WS_W + 36 * MiB, WS_W2 = WS_W + 68 * MiB;
constexpr size_t WS_HM = 112 * MiB;
constexpr size_t WS_R = 328 * MiB;
constexpr size_t WS_AO = WS_R + 384 * MiB;
constexpr size_t WS_MODP = WS_AO;
constexpr size_t WS_XB = 1104 * MiB;
constexpr size_t WS_END = 1296 * MiB;
static_assert(WS_W2 + (size_t)D * FF * 2 <= WS_HM && WS_HM + (size_t)M * AW * 2 <= WS_R && WS_R + (size_t)M * LDU * 2 <= WS_XB && WS_XB + (size_t)M * D * 2 <= WS_END, "d_ws map");
static_assert((size_t)3 * NH * M * HD * 2 <= WS_XB - WS_R && (size_t)M * 2 * D * 2 <= WS_AO - WS_R && WS_AO + (size_t)M * 2 * D * 2 <= WS_XB, "d_ws map (R)");
constexpr int CW_BAR = 4096;

constexpr int RING_BYTES = 131072;
constexpr int LDS_BYTES = 147456;
constexpr int LDSCTL_OFF = LDS_BYTES - 512, MISC_OFF = LDSCTL_OFF + 320;
constexpr int SCR2_OFF = 65536, SCR2_STRIDE = 8448;
static_assert(SCR2_OFF + 8 * SCR2_STRIDE <= LDSCTL_OFF, "LDS map");

#define GAS __attribute__((address_space(1)))
#define LAS __attribute__((address_space(3)))
typedef unsigned short bf16;
typedef unsigned v4u __attribute__((ext_vector_type(4)));
typedef unsigned v2u __attribute__((ext_vector_type(2)));
typedef float f32x4 __attribute__((ext_vector_type(4)));
typedef float f32x2 __attribute__((ext_vector_type(2)));
typedef float f32x16 __attribute__((ext_vector_type(16)));
typedef short bf16x8 __attribute__((ext_vector_type(8)));
typedef short s16x4 __attribute__((ext_vector_type(4)));
typedef __bf16 bf16x2_t __attribute__((ext_vector_type(2)));
#define LDS_WAIT() asm volatile("s_waitcnt lgkmcnt(0)" ::: "memory")
__device__ __forceinline__ unsigned pk2(float lo, float hi) { f32x2 v = {lo, hi}; bf16x2_t b = __builtin_convertvector(v, bf16x2_t); return __builtin_bit_cast(unsigned, b); }
__device__ __forceinline__ float bf_lo(unsigned w) { return __builtin_bit_cast(float, w << 16); }
__device__ __forceinline__ float bf_hi(unsigned w) { return __builtin_bit_cast(float, w & 0xffff0000u); }
__device__ __forceinline__ float wave_sum(float v) {
#pragma unroll
    for (int o = 1; o < 64; o <<= 1) v += __shfl_xor(v, o);
    return v;
}
__device__ __forceinline__ int batch_of_tile(int pm) { return pm < 64 ? (pm >> 5) : 2 + ((pm - 64) >> 3); }

namespace pg8 {
struct NoPre {};
#ifndef PG8_NT
#define PG8_NT 0
#endif
#if PG8_NT
#define PG8_ST_STREAM(p, v) __builtin_nontemporal_store((v), (p))
#else
#define PG8_ST_STREAM(p, v) (*(p) = (v))
#endif
__device__ __forceinline__ u32x4 tperm16(u32x4 w, int src4) { u32x4 t; t.x = (unsigned)__builtin_amdgcn_ds_bpermute(src4, (int)w.x); t.y = (unsigned)__builtin_amdgcn_ds_bpermute(src4, (int)w.y); t.z = (unsigned)__builtin_amdgcn_ds_bpermute(src4, (int)w.z); t.w = (unsigned)__builtin_amdgcn_ds_bpermute(src4, (int)w.w); return t; }
#define PG8_TLANES(fr, fq) const int lane_ = (fq) * 16 + (fr), src4 = (((lane_ & 3) << 4) + (lane_ >> 2)) << 2, frT = lane_ >> 2, fqT = lane_ & 3
struct EpiQKV {
    static constexpr bool PERM = true, AFTER_DRAIN = false; typedef NoPre Pre;
    __device__ __forceinline__ void prefetch(Pre&, const Unit&, int, int) const {}
    bf16_t* O; float qscale;
    __device__ __forceinline__ void operator()(const f32x4 (&acc)[2][2][4][2], const Unit& u, int wr, int wc, int fr, int fq, const Pre& pre) const {
        PG8_TLANES(fr, fq);
        const int g = u.pn / 9, j = u.pn - 9 * g, which = j / 3, hp = (j - 3 * which) * 2, sh = 2 * g;
        int sstart, t0, lsh;
        if (u.pm < 64) { sstart = (u.pm >> 5) * SEQP; t0 = (u.pm & 31) * 256; lsh = 13 - sh; } else { const int q = u.pm - 64; sstart = MP + (q >> 3) * SEQS; t0 = (q & 7) * 256; lsh = 11 - sh; }
        const float sc = which == 0 ? qscale : 1.f;
#pragma unroll
        for (int ai = 0; ai < 2; ++ai)
#pragma unroll
            for (int m = 0; m < 4; ++m) { const int t = t0 + ai * HALF + wr * 64 + m * 16 + frT, prow = sstart + ((t & ((1 << sh) - 1)) << lsh) + (t >> sh);
#pragma unroll
                for (int bj = 0; bj < 2; ++bj) { const int head = g * 6 + hp + bj;
                    bf16_t* dst = O + ((size_t)(which * NH + head) * M + prow) * HD + wc * 32 + 8 * fqT;
                    const f32x4 v0 = acc[ai][bj][m][0] * sc, v1 = acc[ai][bj][m][1] * sc;
                    u32x4 w; w.x = cvt_pk_bf16(v0[0], v0[1]); w.y = cvt_pk_bf16(v0[2], v0[3]); w.z = cvt_pk_bf16(v1[0], v1[1]); w.w = cvt_pk_bf16(v1[2], v1[3]);
                    PG8_ST_STREAM((u32x4*)dst, tperm16(w, src4)); } }
    }
};
template <bool F32IN> struct EpiRes {
    static constexpr bool PERM = true, AFTER_DRAIN = false; typedef NoPre Pre;
    __device__ __forceinline__ void prefetch(Pre&, const Unit&, int, int) const {}
    const float* xin_p; const float* xin_s; bf16_t* xb; const float* bias; const float* gate;
    __device__ __forceinline__ void operator()(const f32x4 (&acc)[2][2][4][2], const Unit& u, int wr, int wc, int fr, int fq, const Pre& pre) const {
        PG8_TLANES(fr, fq);
        const int b = batch_of_tile(u.pm), col0 = u.pn * BM + wc * 32 + 8 * fq, colT = u.pn * BM + wc * 32 + 8 * fqT, rowT = u.pm * BM + wr * 64 + frT;
        const float* gp = gate + (size_t)b * (NMOD * D) + col0;
        f32x4 gv[2][2], bv[2][2];
#pragma unroll
        for (int bj = 0; bj < 2; ++bj)
#pragma unroll
            for (int n = 0; n < 2; ++n) { gv[bj][n] = *(const f32x4*)(gp + bj * HALF + 4 * n); bv[bj][n] = bias ? *(const f32x4*)(bias + col0 + bj * HALF + 4 * n) : (f32x4){0.f, 0.f, 0.f, 0.f}; }
#pragma unroll
        for (int ai = 0; ai < 2; ++ai) {
            if constexpr (F32IN) {
#pragma unroll
                for (int mh = 0; mh < 4; mh += 2) {
                    f32x4 xf[2][2][2];
#pragma unroll
                    for (int m = 0; m < 2; ++m) { const int row = rowT + ai * HALF + (mh + m) * 16; const float* xi = (row < MP ? xin_p + (size_t)row * D : xin_s + (size_t)(row - MP) * D) + colT;
#pragma unroll
                        for (int bj = 0; bj < 2; ++bj) { xf[m][bj][0] = *(const f32x4*)(xi + bj * HALF); xf[m][bj][1] = *(const f32x4*)(xi + bj * HALF + 4); } }
#pragma unroll
                    for (int m = 0; m < 2; ++m) { bf16_t* xo = xb + (size_t)(rowT + ai * HALF + (mh + m) * 16) * D + colT;
#pragma unroll
                        for (int bj = 0; bj < 2; ++bj) { const f32x4 y0 = gv[bj][0] * (acc[ai][bj][mh + m][0] + bv[bj][0]), y1 = gv[bj][1] * (acc[ai][bj][mh + m][1] + bv[bj][1]);
                            const u32x4 t0 = tperm16(__builtin_bit_cast(u32x4, y0), src4), t1 = tperm16(__builtin_bit_cast(u32x4, y1), src4);
                            const f32x4 v0 = xf[m][bj][0] + __builtin_bit_cast(f32x4, t0), v1 = xf[m][bj][1] + __builtin_bit_cast(f32x4, t1);
                            u32x4 o; o.x = cvt_pk_bf16(v0[0], v0[1]); o.y = cvt_pk_bf16(v0[2], v0[3]); o.z = cvt_pk_bf16(v1[0], v1[1]); o.w = cvt_pk_bf16(v1[2], v1[3]);
                            *(u32x4*)(xo + bj * HALF) = o; } }
                }
            } else {
                u32x4 xw[4][2];
#pragma unroll
                for (int m = 0; m < 4; ++m) { const bf16_t* xi = xb + (size_t)(rowT + ai * HALF + m * 16) * D + colT;
#pragma unroll
                    for (int bj = 0; bj < 2; ++bj) xw[m][bj] = *(const u32x4*)(xi + bj * HALF); }
#pragma unroll
                for (int m = 0; m < 4; ++m) { bf16_t* xo = xb + (size_t)(rowT + ai * HALF + m * 16) * D + colT;
#pragma unroll
                    for (int bj = 0; bj < 2; ++bj) { const u32x4 w = xw[m][bj];
                        const f32x4 x0 = {__builtin_bit_cast(float, w.x << 16), __builtin_bit_cast(float, w.x & 0xffff0000u), __builtin_bit_cast(float, w.y << 16), __builtin_bit_cast(float, w.y & 0xffff0000u)};
                        const f32x4 x1 = {__builtin_bit_cast(float, w.z << 16), __builtin_bit_cast(float, w.z & 0xffff0000u), __builtin_bit_cast(float, w.w << 16), __builtin_bit_cast(float, w.w & 0xffff0000u)};
                        const f32x4 y0 = gv[bj][0] * (acc[ai][bj][m][0] + bv[bj][0]), y1 = gv[bj][1] * (acc[ai][bj][m][1] + bv[bj][1]);
                        const u32x4 t0 = tperm16(__builtin_bit_cast(u32x4, y0), src4), t1 = tperm16(__builtin_bit_cast(u32x4, y1), src4);
                        const f32x4 v0 = x0 + __builtin_bit_cast(f32x4, t0), v1 = x1 + __builtin_bit_cast(f32x4, t1);
                        u32x4 o; o.x = cvt_pk_bf16(v0[0], v0[1]); o.y = cvt_pk_bf16(v0[2], v0[3]); o.z = cvt_pk_bf16(v1[0], v1[1]); o.w = cvt_pk_bf16(v1[2], v1[3]);
                        *(u32x4*)(xo + bj * HALF) = o; } }
            }
        }
    }
};
template <int ACT, bool TILEMAJOR = false> struct EpiBf16 {
    static constexpr bool PERM = true, AFTER_DRAIN = false;
    struct Pre { f32x4 bv[2][2]; };
    bf16_t* O; int ldc; const float* bias; int row_base;
    __device__ __forceinline__ void prefetch(Pre& p, const Unit& u, int wc, int fq) const {
        const int bcol0 = u.pn * BM + wc * 32 + 8 * fq;
#pragma unroll
        for (int bj = 0; bj < 2; ++bj)
#pragma unroll
            for (int n = 0; n < 2; ++n) p.bv[bj][n] = bias ? *(const f32x4*)(bias + bcol0 + bj * HALF + 4 * n) : (f32x4){0.f, 0.f, 0.f, 0.f};
    }
    __device__ __forceinline__ void operator()(const f32x4 (&acc)[2][2][4][2], const Unit& u, int wr, int wc, int fr_in, int fq, const Pre& pre) const {
        int fr = fr_in; asm volatile("" : "+v"(fr));
        PG8_TLANES(fr, fq);
        const int row0 = row_base + u.pm * BM + wr * 64 + frT, col0 = u.pn * BM + wc * 32 + 8 * fqT;
        const f32x4 (&bv)[2][2] = pre.bv;
#pragma unroll
        for (int ai = 0; ai < 2; ++ai)
#pragma unroll
            for (int m = 0; m < 4; ++m) { bf16_t* rowp = TILEMAJOR ? O + ((size_t)u.pm * (ldc / 64) + (u.pn * 4 + (wc >> 1))) * (256 * 64) + (size_t)(wr * 64 + frT + ai * HALF + m * 16) * 64 + (wc & 1) * 32 + 8 * fqT
                                                                   : O + (size_t)(row0 + ai * HALF + m * 16) * ldc + col0;
#pragma unroll
                for (int bj = 0; bj < 2; ++bj) { f32x4 v0 = acc[ai][bj][m][0] + bv[bj][0], v1 = acc[ai][bj][m][1] + bv[bj][1];
                    if (ACT == 1) {
#pragma unroll
                        for (int e = 0; e < 4; ++e) { v0[e] = fmaxf(v0[e], 0.f); v1[e] = fmaxf(v1[e], 0.f); }
                        v0 = v0 * v0; v1 = v1 * v1; }
                    u32x4 w; w.x = cvt_pk_bf16(v0[0], v0[1]); w.y = cvt_pk_bf16(v0[2], v0[3]); w.z = cvt_pk_bf16(v1[0], v1[1]); w.w = cvt_pk_bf16(v1[2], v1[3]);
                    PG8_ST_STREAM((u32x4*)(rowp + (TILEMAJOR ? bj * 2 * (256 * 64) : bj * HALF)), tperm16(w, src4)); } }
    }
};
struct EpiZT {
    static constexpr bool PERM = true, AFTER_DRAIN = false; typedef NoPre Pre;
    __device__ __forceinline__ void prefetch(Pre&, const Unit&, int, int) const {}
    bf16_t* ZT; int seq0, S, N2;
    __device__ __forceinline__ void operator()(const f32x4 (&acc)[2][2][4][2], const Unit& u, int wr, int wc, int fr, int fq, const Pre& pre) const {
        PG8_TLANES(fr, fq);
        const int part = u.pm & 1, z = u.pm >> 1, b = z >> 3, g = z & 7;
        bf16_t* base = ZT + (size_t)4096 * (seq0 + b * S) + ((size_t)(g * 256 + wr * 64 + frT) * N2 + u.pn) * 512 + part * 256 + wc * 32 + 8 * fqT;
#pragma unroll
        for (int ai = 0; ai < 2; ++ai)
#pragma unroll
            for (int m = 0; m < 4; ++m) { bf16_t* rowp = base + (size_t)(ai * HALF + m * 16) * N2 * 512;
#pragma unroll
                for (int bj = 0; bj < 2; ++bj) { const f32x4 v0 = acc[ai][bj][m][0], v1 = acc[ai][bj][m][1];
                    u32x4 w; w.x = cvt_pk_bf16(v0[0], v0[1]); w.y = cvt_pk_bf16(v0[2], v0[3]); w.z = cvt_pk_bf16(v1[0], v1[1]); w.w = cvt_pk_bf16(v1[2], v1[3]);
                    PG8_ST_STREAM((u32x4*)(rowp + bj * HALF), tperm16(w, src4)); } }
    }
};
struct EpiAO {
    static constexpr bool PERM = true, AFTER_DRAIN = false; typedef NoPre Pre;
    __device__ __forceinline__ void prefetch(Pre&, const Unit&, int, int) const {}
    bf16_t* AO; int seq0, S, N2;
    __device__ __forceinline__ void operator()(const f32x4 (&acc)[2][2][4][2], const Unit& u, int wr, int wc, int fr, int fq, const Pre& pre) const {
        PG8_TLANES(fr, fq);
        const int part = u.pm & 1, b = u.pm >> 1, n2 = u.pn >> 3, cb = u.pn & 7;
        bf16_t* base = AO + (size_t)4096 * (seq0 + b * S) + ((size_t)(part * 256 + wr * 64 + frT) * N2 + n2) * 2048 + cb * 256 + wc * 32 + 8 * fqT;
#pragma unroll
        for (int ai = 0; ai < 2; ++ai)
#pragma unroll
            for (int m = 0; m < 4; ++m) { bf16_t* rowp = base + (size_t)(ai * HALF + m * 16) * N2 * 2048;
#pragma unroll
                for (int bj = 0; bj < 2; ++bj) { const f32x4 v0 = acc[ai][bj][m][0], v1 = acc[ai][bj][m][1];
                    u32x4 w; w.x = cvt_pk_bf16(v0[0], v0[1]); w.y = cvt_pk_bf16(v0[2], v0[3]); w.z = cvt_pk_bf16(v1[0], v1[1]); w.w = cvt_pk_bf16(v1[2], v1[3]);
                    PG8_ST_STREAM((u32x4*)(rowp + bj * HALF), tperm16(w, src4)); } }
    }
};
struct EpiNull {
    static constexpr bool PERM = true, AFTER_DRAIN = false; typedef NoPre Pre;
    __device__ __forceinline__ void prefetch(Pre&, const Unit&, int, int) const {}
    __device__ __forceinline__ void operator()(const f32x4 (&acc)[2][2][4][2], const Unit&, int, int, int, int, const Pre&) const {
#pragma unroll
        for (int a = 0; a < 2; ++a)
#pragma unroll
            for (int b = 0; b < 2; ++b)
#pragma unroll
                for (int m = 0; m < 4; ++m)
#pragma unroll
                    for (int n = 0; n < 2; ++n) asm volatile("" :: "v"(acc[a][b][m][n]));
    }
};
}

#ifndef PG8_SP2
#define PG8_SP2 true
#endif
#ifndef PG8_ALIGN
#define PG8_ALIGN true
#endif

#define XB_TMO      128
#define XB_XCNT(j)  (256  + 64 * (j))
#define XB_XSUB(j)  (1280 + 64 * (j))
#define XB_XGEN(j)  (2304 + 64 * (j))
#define XB_TOP      3328
#define XB_TOPGEN   3392
#define XCD_BAR_WORDS 3456
#define XB_SPIN_CAP (1u << 18)

__device__ __forceinline__ unsigned xb_ld(unsigned* p)              { return __hip_atomic_load(p, __ATOMIC_RELAXED, __HIP_MEMORY_SCOPE_AGENT); }
__device__ __forceinline__ unsigned xb_add(unsigned* p, unsigned v) { return __hip_atomic_fetch_add(p, v, __ATOMIC_RELAXED, __HIP_MEMORY_SCOPE_AGENT); }
__device__ __forceinline__ unsigned xb_xcc_id() { return (unsigned)__builtin_amdgcn_s_getreg((3 << 11) | 20) & 0xFu; }
#define XB_SPIN(cond, bar) do { unsigned _sp = 0; while (cond) { __builtin_amdgcn_s_sleep(1); \
    if ((++_sp & 255u) == 0u) { if (xb_ld(&(bar)[XB_TMO])) break; if (_sp > XB_SPIN_CAP) { atomicAdd(&(bar)[XB_TMO], 1u); break; } } } } while (0)

struct XcdBarrier {
    unsigned* bar; unsigned x;
    volatile LAS unsigned* st;
};

__device__ __forceinline__ XcdBarrier xcd_barrier_post(unsigned* bar, volatile LAS unsigned* st) {
    XcdBarrier b; b.bar = bar; b.x = xb_xcc_id(); b.st = st;
    if (threadIdx.x == 0) (void)xb_add(&bar[XB_XCNT(b.x)], 1u);
    return b;
}
__device__ __forceinline__ void xcd_barrier_complete(unsigned* bar, unsigned x, unsigned& nloc, unsigned& nx) {
    const unsigned G = gridDim.x * gridDim.y * gridDim.z;
    unsigned sum, cnt, mine, sp = 0u;
    for (;;) {
        sum = 0u; cnt = 0u; mine = 0u;
#pragma unroll
        for (unsigned j = 0; j < 16; ++j) { const unsigned c = xb_ld(&bar[XB_XCNT(j)]); sum += c; cnt += (c > 0u) ? 1u : 0u; mine = (j == x) ? c : mine; }
        if (sum == G) break;
        __builtin_amdgcn_s_sleep(1);
        if ((++sp & 255u) == 0u) { if (xb_ld(&bar[XB_TMO])) break; if (sp > XB_SPIN_CAP) { atomicAdd(&bar[XB_TMO], 1u); break; } }
    }
    nloc = mine > 0u ? mine : 1u; nx = cnt > 0u ? cnt : 1u;
}

__device__ __forceinline__ void xcd_barrier(const XcdBarrier& b) {
    asm volatile("s_waitcnt vmcnt(0)" ::: "memory");
    __syncthreads();
    if (threadIdx.x == 0) {
        unsigned* bar = b.bar;
        __builtin_amdgcn_s_waitcnt(0);
        unsigned nloc = b.st[0], nx = b.st[1];
        if (nloc == 0u) { xcd_barrier_complete(bar, b.x, nloc, nx); b.st[0] = nloc; b.st[1] = nx; }
        const unsigned old = xb_add(&bar[XB_XSUB(b.x)], 1u);
        const unsigned gen = old / nloc;
        if (old + 1u == (gen + 1u) * nloc) {
            __builtin_amdgcn_fence(__ATOMIC_RELEASE, "agent");
            asm volatile("s_waitcnt vmcnt(0)" ::: "memory");
            const unsigned og = xb_add(&bar[XB_TOP], 1u);
            const unsigned tg = og / nx;
            if (og + 1u == (tg + 1u) * nx) xb_add(&bar[XB_TOPGEN], 1u);
            else XB_SPIN(xb_ld(&bar[XB_TOPGEN]) == tg, bar);
            __builtin_amdgcn_fence(__ATOMIC_ACQUIRE, "agent");
            xb_add(&bar[XB_XGEN(b.x)], 1u);
            asm volatile("s_waitcnt vmcnt(0)" ::: "memory");
        } else {
            XB_SPIN(xb_ld(&bar[XB_XGEN(b.x)]) == gen, bar);
            __builtin_amdgcn_fence(__ATOMIC_ACQUIRE, "agent");
            asm volatile("s_waitcnt vmcnt(0)" ::: "memory");
        }
    }
    __syncthreads();
}


__device__ __forceinline__ void transpose_item(const float* W, int K, int N, bf16* WT, LAS float* scr, int item, int lane) {
    const int nblk = N / 32, kb = item / nblk, nb = item % nblk, k0 = 64 * kb, n0 = 32 * nb;
    float wv[32];
#pragma unroll
    for (int i = 0; i < 32; ++i) wv[i] = W[(size_t)(k0 + 2 * i + (lane >> 5)) * N + n0 + (lane & 31)];
#pragma unroll
    for (int i = 0; i < 32; ++i) scr[(2 * i + (lane >> 5)) * 33 + (lane & 31)] = wv[i];
    LDS_WAIT(); asm volatile("" ::: "memory");
    const int c = lane & 7;
#pragma unroll
    for (int j = 0; j < 4; ++j) { const int n = (lane >> 3) + 8 * j; const LAS float* s = scr + (8 * c) * 33 + n;
        v4u o; o.x = pk2(s[0 * 33], s[1 * 33]); o.y = pk2(s[2 * 33], s[3 * 33]); o.z = pk2(s[4 * 33], s[5 * 33]); o.w = pk2(s[6 * 33], s[7 * 33]);
        *(GAS v4u*)(WT + ((size_t)((n0 + n) >> 8) * (K / 64) + kb) * 16384 + ((n0 + n) & 255) * 64 + 8 * c) = o; }
    LDS_WAIT(); asm volatile("" ::: "memory");
}

__device__ __forceinline__ void norm_chunk(const float* xrow0, bf16* hrow0, const float* gain, const float* shift, const float* scale, int lane) {
    f32x4 A[8], B[8];
#pragma unroll
    for (int j = 0; j < 8; ++j) { const int col = 4 * lane + 256 * j; const f32x4 gn = *(const f32x4*)(gain + col), sc = *(const f32x4*)(scale + col); A[j] = gn * (sc + 1.0f); B[j] = *(const f32x4*)(shift + col); }
    for (int rr = 0; rr < 8; ++rr) {
        const GAS f32x4* xr = (const GAS f32x4*)(xrow0 + (size_t)rr * D) + lane;
        f32x4 v[8]; float ss = 0.f;
#pragma unroll
        for (int j = 0; j < 8; ++j) { v[j] = xr[64 * j]; ss += (v[j].x * v[j].x + v[j].y * v[j].y) + (v[j].z * v[j].z + v[j].w * v[j].w); }
        const float rstd = 1.0f / sqrtf(wave_sum(ss) * (1.0f / D) + RMS_EPS);
        GAS v2u* o8 = (GAS v2u*)(hrow0 + (size_t)rr * D) + lane;
#pragma unroll
        for (int j = 0; j < 8; ++j) { const f32x4 y = (v[j] * rstd) * A[j] + B[j]; v2u w; w.x = pk2(y.x, y.y); w.y = pk2(y.z, y.w); o8[64 * j] = w; }
    }
}

__device__ __forceinline__ void norm_chunk_b(const bf16* xrow0, bf16* hrow0, const float* gain, const float* shift, const float* scale, int lane) {
    f32x4 A[4][2], B[4][2];
#pragma unroll
    for (int j = 0; j < 4; ++j)
#pragma unroll
        for (int e = 0; e < 2; ++e) { const int col = 8 * lane + 512 * j + 4 * e; const f32x4 gn = *(const f32x4*)(gain + col), sc = *(const f32x4*)(scale + col); A[j][e] = gn * (sc + 1.0f); B[j][e] = *(const f32x4*)(shift + col); }
#pragma unroll 1
    for (int r4 = 0; r4 < 8; r4 += 4) {
        v4u w[4][4];
#pragma unroll
        for (int rr = 0; rr < 4; ++rr) { const GAS v4u* xr = (const GAS v4u*)(xrow0 + (size_t)(r4 + rr) * D) + lane;
#pragma unroll
            for (int j = 0; j < 4; ++j) w[rr][j] = xr[64 * j]; }
#pragma unroll
        for (int rr = 0; rr < 4; ++rr) {
            f32x4 v[4][2]; float ss = 0.f;
#pragma unroll
            for (int j = 0; j < 4; ++j) { const v4u q = w[rr][j];
                v[j][0] = (f32x4){bf_lo(q.x), bf_hi(q.x), bf_lo(q.y), bf_hi(q.y)}; v[j][1] = (f32x4){bf_lo(q.z), bf_hi(q.z), bf_lo(q.w), bf_hi(q.w)};
#pragma unroll
                for (int e = 0; e < 2; ++e) ss += (v[j][e].x * v[j][e].x + v[j][e].y * v[j][e].y) + (v[j][e].z * v[j][e].z + v[j][e].w * v[j][e].w); }
            const float rstd = 1.0f / sqrtf(wave_sum(ss) * (1.0f / D) + RMS_EPS);
            GAS v4u* o16 = (GAS v4u*)(hrow0 + (size_t)(r4 + rr) * D) + lane;
#pragma unroll
            for (int j = 0; j < 4; ++j) { const f32x4 y0 = (v[j][0] * rstd) * A[j][0] + B[j][0], y1 = (v[j][1] * rstd) * A[j][1] + B[j][1];
                v4u o; o.x = pk2(y0.x, y0.y); o.y = pk2(y0.z, y0.w); o.z = pk2(y1.x, y1.y); o.w = pk2(y1.z, y1.w); o16[64 * j] = o; }
        }
    }
}

__device__ __forceinline__ unsigned vimg_off(unsigned row, unsigned ch) { return 256u * row + 16u * (ch ^ (((row & 3) << 2) | ((row >> 2) & 3))); }
__device__ __forceinline__ s16x4 vtr(LAS unsigned char* p) { return __builtin_bit_cast(s16x4, __builtin_amdgcn_ds_read_tr16_b64_v4i16((LAS s16x4*)p)); }
#define MFMA32(a, b, c) __builtin_amdgcn_mfma_f32_32x32x16_bf16((a), (b), (c), 0, 0, 0)

__device__ __forceinline__ void attn_wave_unit(int w, LAS unsigned char* wl, const bf16* QKV, bf16* mixed, float* lse, int lane_in) {
    int lane = lane_in; asm volatile("" : "+v"(lane));
    const int n = lane & 31, h = lane >> 5, lrow = lane >> 4, lch = lane & 15;
    LAS unsigned char* kl = wl; LAS unsigned char* vl = wl + 8192;
    const int g = w / 9216; int w1 = w - g * 9216;
    int hh, w3, lsh, sstart;
    if (w1 < 3072) { const int bb = w1 / 1536, w2 = w1 - bb * 1536; hh = w2 >> 8; w3 = w2 & 255; sstart = bb * SEQP; lsh = 13 - 2 * g; }
    else { w1 -= 3072; const int bb = w1 / 384, w2 = w1 - bb * 384; hh = w2 >> 6; w3 = w2 & 63; sstart = MP + bb * SEQS; lsh = 11 - 2 * g; }
    const int head = g * 6 + hh, L = 1 << lsh, pos0 = w3 * 32, r = pos0 >> lsh, u0 = pos0 & (L - 1), seqlo = sstart + (r << lsh);
    const bf16* Qh = QKV + ((size_t)(0 * NH + head) * M + seqlo) * HD;
    const bf16* Kh = QKV + ((size_t)(1 * NH + head) * M + seqlo) * HD;
    const bf16* Vh = QKV + ((size_t)(2 * NH + head) * M + seqlo) * HD;
#define ATT_LDBLK(dst, base, ubase) do { _Pragma("unroll") for (int i = 0; i < 8; ++i) { int ku_ = (ubase) + lrow + 4 * i; ku_ = ku_ < 0 ? 0 : (ku_ > L - 1 ? L - 1 : ku_); \
        dst[i] = *(const GAS v4u*)((const GAS unsigned char*)(base) + (unsigned)(ku_ * 256 + lch * 16)); } } while (0)
#define ATT_STBLK(img, src) do { _Pragma("unroll") for (int i = 0; i < 8; ++i) *(LAS v4u*)((img) + vimg_off((unsigned)(lrow + 4 * i), (unsigned)lch)) = src[i]; } while (0)
    v4u ra[8], rb[8];
    ATT_LDBLK(ra, Qh, u0);
    ATT_STBLK(kl, ra);
    asm volatile("s_waitcnt lgkmcnt(0)" ::: "memory");
    ATT_LDBLK(ra, Kh, u0 - 64);
    bf16x8 qf[8];
#pragma unroll
    for (int ks = 0; ks < 8; ++ks) qf[ks] = *(const LAS bf16x8*)(kl + vimg_off((unsigned)n, (unsigned)(2 * ks + h)));
    asm volatile("s_waitcnt lgkmcnt(0)" ::: "memory");
    const float slope2 = exp2f(-8.0f * (float)(head + 1) / 18.0f) * (float)(1 << (2 * g)) * LOG2E;
    f32x16 s[5];
#pragma unroll
    for (int kb = 0; kb < 5; ++kb) {
        LAS unsigned char* img = ((kb + 1) & 1) ? vl : kl;
        ATT_STBLK(img, ra);
        asm volatile("s_waitcnt lgkmcnt(0)" ::: "memory");
        if (kb + 1 < 5) ATT_LDBLK(ra, Kh, u0 - 64 + 32 * (kb + 1));
        asm volatile("" ::: "memory");
        f32x16 acc;
#pragma unroll
        for (int i = 0; i < 16; ++i) acc[i] = 0.f;
#pragma unroll
        for (int kh = 0; kh < 4; ++kh) { bf16x8 kf[2];
#pragma unroll
            for (int k4 = 0; k4 < 2; ++k4) kf[k4] = *(const LAS bf16x8*)(img + vimg_off((unsigned)n, (unsigned)(2 * (2 * kh + k4) + h)));
#pragma unroll
            for (int k4 = 0; k4 < 2; ++k4) acc = MFMA32(kf[k4], qf[2 * kh + k4], acc);
            asm volatile("" ::: "memory"); }
        asm volatile("s_waitcnt lgkmcnt(0)" ::: "memory");
#pragma unroll
        for (int i = 0; i < 16; ++i) {
            const int krow = (i & 3) + 8 * (i >> 2) + 4 * h, kuu = u0 - 64 + 32 * kb + krow, du = -64 + 32 * kb + krow - n;
            bool ok = (unsigned)kuu < (unsigned)L;
            if (kb == 0) ok = ok && (du >= -64);
            if (kb == 4) ok = ok && (du <= 64);
            s[kb][i] = ok ? acc[i] - slope2 * fabsf((float)du) : -1e30f;
        }
    }
    asm volatile("" ::: "memory");
    ATT_LDBLK(rb, Vh, u0 - 64); ATT_LDBLK(ra, Vh, u0 - 64 + 32);
    asm volatile("" ::: "memory");
    float mx = -1e30f;
#pragma unroll
    for (int kb = 0; kb < 5; ++kb)
#pragma unroll
        for (int i = 0; i < 16; ++i) mx = fmaxf(mx, s[kb][i]);
    mx = fmaxf(mx, __shfl_xor(mx, 32));
    float lsum = 0.f;
    v4u pw[5][2];
#pragma unroll
    for (int kb = 0; kb < 5; ++kb)
#pragma unroll
        for (int s2 = 0; s2 < 2; ++s2) { float p[8];
#pragma unroll
            for (int e = 0; e < 8; ++e) { p[e] = __builtin_amdgcn_exp2f(s[kb][8 * s2 + e] - mx); lsum += p[e]; }
            pw[kb][s2].x = pk2(p[0], p[1]); pw[kb][s2].y = pk2(p[2], p[3]); pw[kb][s2].z = pk2(p[4], p[5]); pw[kb][s2].w = pk2(p[6], p[7]); }
    lsum += __shfl_xor(lsum, 32);
    f32x16 o[4];
#pragma unroll
    for (int c = 0; c < 4; ++c)
#pragma unroll
        for (int i = 0; i < 16; ++i) o[c][i] = 0.f;
    const unsigned q4 = (lane & 15) >> 2, p4 = lane & 3, blk = (lane >> 4) & 1;
#pragma unroll
    for (int kb = 0; kb < 5; ++kb) {
        LAS unsigned char* img = (kb & 1) ? vl : kl;
        if (kb & 1) ATT_STBLK(img, ra); else ATT_STBLK(img, rb);
        asm volatile("s_waitcnt lgkmcnt(0)" ::: "memory");
        if (kb + 2 < 5) { if (kb & 1) ATT_LDBLK(ra, Vh, u0 - 64 + 32 * (kb + 2)); else ATT_LDBLK(rb, Vh, u0 - 64 + 32 * (kb + 2)); }
        asm volatile("" ::: "memory");
#pragma unroll
        for (int s2 = 0; s2 < 2; ++s2) {
            const bf16x8 pf = __builtin_bit_cast(bf16x8, pw[kb][s2]);
#pragma unroll
            for (int c = 0; c < 4; ++c) {
                const unsigned ch = 4 * c + 2 * blk + (p4 >> 1);
                const s16x4 lo = vtr(img + vimg_off(16 * s2 + 0 + 4 * h + q4, ch) + 8 * (p4 & 1));
                const s16x4 hi = vtr(img + vimg_off(16 * s2 + 8 + 4 * h + q4, ch) + 8 * (p4 & 1));
                const bf16x8 vf = __builtin_shufflevector(lo, hi, 0, 1, 2, 3, 4, 5, 6, 7);
                o[c] = MFMA32(vf, pf, o[c]);
            }
        }
        asm volatile("s_waitcnt lgkmcnt(0)" ::: "memory");
    }
#undef ATT_LDBLK
#undef ATT_STBLK
    const float inv = 1.0f / lsum;
#pragma unroll
    for (int c = 0; c < 4; ++c)
#pragma unroll
        for (int k4 = 0; k4 < 4; ++k4) { v2u wv; wv.x = pk2(o[c][4 * k4 + 0] * inv, o[c][4 * k4 + 1] * inv); wv.y = pk2(o[c][4 * k4 + 2] * inv, o[c][4 * k4 + 3] * inv);
            *(LAS v2u*)(vl + vimg_off((unsigned)n, (unsigned)(4 * c + k4)) + 8 * h) = wv; }
    asm volatile("s_waitcnt lgkmcnt(0)" ::: "memory");
#pragma unroll
    for (int i = 0; i < 8; ++i) { const int q = lrow + 4 * i; const v4u ov = *(const LAS v4u*)(vl + vimg_off((unsigned)q, (unsigned)lch));
        const int mrow_q = sstart + ((u0 + q) << (2 * g)) + r;
        *(GAS v4u*)(mixed + (size_t)mrow_q * AW + head * HD + 8 * lch) = ov; }
    asm volatile("s_waitcnt lgkmcnt(0)" ::: "memory");
    if (h == 0) { const int mrow = sstart + ((u0 + n) << (2 * g)) + r; lse[(size_t)mrow * NH + head] = (mx + __builtin_amdgcn_logf(lsum)) * LN2; }
}

struct AttGroup { int g, head, sstart, slen, p0g; };
__device__ __forceinline__ AttGroup att_group(int gi) {
    AttGroup a; const int w = gi * 8; a.g = w / 9216; int w1 = w - a.g * 9216; int hh, w3;
    if (w1 < 3072) { const int bb = w1 / 1536, w2 = w1 - bb * 1536; hh = w2 >> 8; w3 = w2 & 255; a.sstart = bb * SEQP; a.slen = SEQP; }
    else { w1 -= 3072; const int bb = w1 / 384, w2 = w1 - bb * 384; hh = w2 >> 6; w3 = w2 & 63; a.sstart = MP + bb * SEQS; a.slen = SEQS; }
    a.head = a.g * 6 + hh; a.p0g = w3 * 32; return a;
}
#define ATTG_LD(dst, base, ag) do { _Pragma("unroll") for (int i = 0; i < 12; ++i) { int rr_ = (ag).p0g - 64 + 4 * (12 * wave + i) + (lane >> 4); rr_ = rr_ < 0 ? 0 : (rr_ > (ag).slen - 1 ? (ag).slen - 1 : rr_); \
        dst[i] = *(const GAS v4u*)((const GAS unsigned char*)(base) + (size_t)((ag).sstart + rr_) * 256 + (lane & 15) * 16); } } while (0)
#define ATTG_ST(src) do { _Pragma("unroll") for (int i = 0; i < 12; ++i) { const unsigned rr_ = 4 * (12 * wave + i) + (lane >> 4); \
        *(LAS v4u*)(lds + (rr_ >> 5) * 8192 + vimg_off(rr_ & 31, (unsigned)(lane & 15))) = src[i]; } } while (0)
#define ATTG_BAR() do { asm volatile("s_waitcnt lgkmcnt(0)" ::: "memory"); __builtin_amdgcn_s_barrier(); asm volatile("" ::: "memory"); } while (0)
__device__ __forceinline__ void attn_phase_coop(LAS unsigned char* lds, const bf16* QKV, bf16* mixed, float* lse, int vcu, int G, int wave, int lane_in) {
    constexpr int NGRP = 27648 / 8;
    if (vcu >= NGRP) return;
    int lane = lane_in;
    AttGroup ag = att_group(vcu);
    for (int gi = vcu; gi < NGRP; gi += G) {
        ag = att_group(gi);
        v4u kr[12], vr[12];
        ATTG_LD(kr, QKV + ((size_t)(1 * NH + ag.head) * M) * HD, ag);
        asm volatile("" : "+v"(lane));
        const int n = lane & 31, h = lane >> 5, lrow = lane >> 4, lch = lane & 15;
        const int g = ag.g, head = ag.head, sstart = ag.sstart, lsh = (ag.slen == SEQP ? 13 : 11) - 2 * g, L = 1 << lsh;
        const int pos0 = ag.p0g + 32 * wave, r = pos0 >> lsh, u0 = pos0 & (L - 1);
        ATTG_ST(kr);
        bf16x8 qf[8];
        { const GAS bf16x8* qp = (const GAS bf16x8*)(QKV + ((size_t)(0 * NH + head) * M + sstart + pos0 + n) * HD + 8 * h);
#pragma unroll
          for (int ks = 0; ks < 8; ++ks) qf[ks] = qp[2 * ks]; }
        ATTG_LD(vr, QKV + ((size_t)(2 * NH + head) * M) * HD, ag);
        ATTG_BAR();
        const float slope2 = exp2f(-8.0f * (float)(head + 1) / 18.0f) * (float)(1 << (2 * g)) * LOG2E;
        f32x16 s[5];
#pragma unroll
        for (int kb = 0; kb < 5; ++kb) {
            LAS unsigned char* img = lds + (wave + kb) * 8192;
            f32x16 acc;
#pragma unroll
            for (int i = 0; i < 16; ++i) acc[i] = 0.f;
#pragma unroll
            for (int kh = 0; kh < 4; ++kh) { bf16x8 kf[2];
#pragma unroll
                for (int k4 = 0; k4 < 2; ++k4) kf[k4] = *(const LAS bf16x8*)(img + vimg_off((unsigned)n, (unsigned)(2 * (2 * kh + k4) + h)));
#pragma unroll
                for (int k4 = 0; k4 < 2; ++k4) acc = MFMA32(kf[k4], qf[2 * kh + k4], acc);
                asm volatile("" ::: "memory"); }
#pragma unroll
            for (int i = 0; i < 16; ++i) {
                const int krow = (i & 3) + 8 * (i >> 2) + 4 * h, kuu = u0 - 64 + 32 * kb + krow, du = -64 + 32 * kb + krow - n;
                bool ok = (unsigned)kuu < (unsigned)L;
                if (kb == 0) ok = ok && (du >= -64);
                if (kb == 4) ok = ok && (du <= 64);
                s[kb][i] = ok ? acc[i] - slope2 * fabsf((float)du) : -1e30f;
            }
        }
        float mx = -1e30f;
#pragma unroll
        for (int kb = 0; kb < 5; ++kb)
#pragma unroll
            for (int i = 0; i < 16; ++i) mx = fmaxf(mx, s[kb][i]);
        mx = fmaxf(mx, __shfl_xor(mx, 32));
        float lsum = 0.f;
        v4u pw[5][2];
#pragma unroll
        for (int kb = 0; kb < 5; ++kb)
#pragma unroll
            for (int s2 = 0; s2 < 2; ++s2) { float p[8];
#pragma unroll
                for (int e = 0; e < 8; ++e) { p[e] = __builtin_amdgcn_exp2f(s[kb][8 * s2 + e] - mx); lsum += p[e]; }
                pw[kb][s2].x = pk2(p[0], p[1]); pw[kb][s2].y = pk2(p[2], p[3]); pw[kb][s2].z = pk2(p[4], p[5]); pw[kb][s2].w = pk2(p[6], p[7]); }
        lsum += __shfl_xor(lsum, 32);
        ATTG_BAR();
        ATTG_ST(vr);
        ATTG_BAR();
        f32x16 o[4];
#pragma unroll
        for (int c = 0; c < 4; ++c)
#pragma unroll
            for (int i = 0; i < 16; ++i) o[c][i] = 0.f;
        const unsigned q4 = (lane & 15) >> 2, p4 = lane & 3, blk = (lane >> 4) & 1;
#pragma unroll
        for (int kb = 0; kb < 5; ++kb) {
            LAS unsigned char* img = lds + (wave + kb) * 8192;
#pragma unroll
            for (int s2 = 0; s2 < 2; ++s2) {
                const bf16x8 pf = __builtin_bit_cast(bf16x8, pw[kb][s2]);
#pragma unroll
                for (int c = 0; c < 4; ++c) {
                    const unsigned ch = 4 * c + 2 * blk + (p4 >> 1);
                    const s16x4 lo = vtr(img + vimg_off(16 * s2 + 0 + 4 * h + q4, ch) + 8 * (p4 & 1));
                    const s16x4 hi = vtr(img + vimg_off(16 * s2 + 8 + 4 * h + q4, ch) + 8 * (p4 & 1));
                    const bf16x8 vf = __builtin_shufflevector(lo, hi, 0, 1, 2, 3, 4, 5, 6, 7);
                    o[c] = MFMA32(vf, pf, o[c]);
                }
            }
            asm volatile("" ::: "memory");
        }
        ATTG_BAR();
        LAS unsigned char* ol = lds + wave * 8192;
        const float inv = 1.0f / lsum;
#pragma unroll
        for (int c = 0; c < 4; ++c)
#pragma unroll
            for (int k4 = 0; k4 < 4; ++k4) { v2u wv; wv.x = pk2(o[c][4 * k4 + 0] * inv, o[c][4 * k4 + 1] * inv); wv.y = pk2(o[c][4 * k4 + 2] * inv, o[c][4 * k4 + 3] * inv);
                *(LAS v2u*)(ol + vimg_off((unsigned)n, (unsigned)(4 * c + k4)) + 8 * h) = wv; }
        asm volatile("s_waitcnt lgkmcnt(0)" ::: "memory");
#pragma unroll
        for (int i = 0; i < 8; ++i) { const int q = lrow + 4 * i; const v4u ov = *(const LAS v4u*)(ol + vimg_off((unsigned)q, (unsigned)lch));
            const int mrow_q = sstart + ((u0 + q) << (2 * g)) + r;
            *(GAS v4u*)(mixed + (size_t)mrow_q * AW + head * HD + 8 * lch) = ov; }
        if (h == 0) { const int mrow = sstart + ((u0 + n) << (2 * g)) + r; lse[(size_t)mrow * NH + head] = (mx + __builtin_amdgcn_logf(lsum)) * LN2; }
        ATTG_BAR();
    }
}
#undef ATTG_LD
#undef ATTG_ST
#undef ATTG_BAR

template <int N2> __device__ __forceinline__ void fbc_item(const bf16* AOb, bf16* outb, int k1, int cg, LAS float* tw, int lane) {
    constexpr int S = 256 * N2; constexpr float scale = (N2 == 32) ? 0.17677669529663687f : 0.35355339059327373f;
    for (int idx = lane; idx < N2 * N2; idx += 64) { const int n2 = idx / N2, k2 = idx % N2; const float ph = (float)((n2 * (k1 + 256 * k2)) & (S - 1)) * (1.0f / S);
        *(LAS f32x2*)(tw + 2 * idx) = (f32x2){__builtin_amdgcn_cosf(ph) * scale, __builtin_amdgcn_sinf(ph) * scale}; }
    asm volatile("s_waitcnt lgkmcnt(0)" ::: "memory");
    for (int ch = 0; ch < 2; ++ch) {
        const int col = (cg * 2 + ch) * 256 + lane * 4;
        const GAS v2u* pr = (const GAS v2u*)(AOb + ((size_t)k1 * N2) * 2048 + col);
        const GAS v2u* pi = (const GAS v2u*)(AOb + ((size_t)(256 + k1) * N2) * 2048 + col);
        f32x4 acc[N2];
#pragma unroll
        for (int k2 = 0; k2 < N2; ++k2) acc[k2] = (f32x4){0.f, 0.f, 0.f, 0.f};
#pragma unroll 1
        for (int n2b = 0; n2b < N2; n2b += 8) {
            v2u rr[8], ii[8];
#pragma unroll
            for (int q = 0; q < 8; ++q) { rr[q] = pr[(size_t)(n2b + q) * 512]; ii[q] = pi[(size_t)(n2b + q) * 512]; }
#pragma unroll
            for (int q = 0; q < 8; ++q) { asm volatile("" ::: "memory"); const int n2 = n2b + q; const v2u r = rr[q], im = ii[q];
            const f32x4 xr = {bf_lo(r.x), bf_hi(r.x), bf_lo(r.y), bf_hi(r.y)}, xi = {bf_lo(im.x), bf_hi(im.x), bf_lo(im.y), bf_hi(im.y)};
#pragma unroll
            for (int k2 = 0; k2 < N2; ++k2) { const f32x2 cs = *(const LAS f32x2*)(tw + 2 * (n2 * N2 + k2)); acc[k2] += xr * cs.x + xi * cs.y; }
            }
        }
#pragma unroll
        for (int k2 = 0; k2 < N2; ++k2) { v2u w; w.x = pk2(acc[k2].x, acc[k2].y); w.y = pk2(acc[k2].z, acc[k2].w); *(GAS v2u*)(outb + (size_t)(k1 + 256 * k2) * D + col) = w; }
    }
    asm volatile("s_waitcnt lgkmcnt(0)" ::: "memory");
}

struct Args { const float* in[17]; float* out; unsigned char* ws; };
typedef const Args __attribute__((address_space(4)))* KArgs;
__device__ __forceinline__ KArgs kargs() { KArgs p = (KArgs)__builtin_amdgcn_kernarg_segment_ptr(); asm volatile("" : "+s"(p)); return p; }
__global__ void __launch_bounds__(NWAVES * 64, 2) fwd(Args args) {
    extern __shared__ __attribute__((aligned(16))) unsigned char lds_raw[];
    LAS unsigned char* lds = (LAS unsigned char*)lds_raw;
    const int wave = __builtin_amdgcn_readfirstlane((int)threadIdx.x >> 6), G = gridDim.x;
#define FRESH_TID(name) int name = threadIdx.x; asm volatile("" : "+v"(name))
    const int gw = blockIdx.x * NWAVES + wave, NGW = G * NWAVES;
    unsigned* ctl = (unsigned*)(kargs()->ws + WS_CTL);
    { FRESH_TID(tid); for (int u = tid; u < (LDS_BYTES - LDSCTL_OFF) / 4; u += NWAVES * 64) ((LAS unsigned*)(lds + LDSCTL_OFF))[u] = 0u; }
    __syncthreads();
    (void)xcd_barrier_post(ctl + CW_BAR, (volatile LAS unsigned*)(lds + MISC_OFF) + 8);
#ifdef PROBE_STAMP
    int stamp_idx = 0;
#define STAMPS() ((unsigned long long*)(kargs()->ws + WS_CTL + 524288))
#define GRID_BAR() do { if (blockIdx.x == 0 && threadIdx.x == 0) STAMPS()[2 * stamp_idx] = __builtin_amdgcn_s_memrealtime(); GRID_BAR_() ; if (blockIdx.x == 0 && threadIdx.x == 0) STAMPS()[2 * stamp_idx + 1] = __builtin_amdgcn_s_memrealtime(); ++stamp_idx; } while (0)
#elif defined(PROBE_DOUBLE_BAR)
#define GRID_BAR() do { GRID_BAR_(); GRID_BAR_(); } while (0)
#else
#define GRID_BAR() GRID_BAR_()
#endif
#define GRID_BAR_() do { XcdBarrier bar_; bar_.bar = (unsigned*)(kargs()->ws + WS_CTL) + CW_BAR; bar_.x = xb_xcc_id(); bar_.st = (volatile LAS unsigned*)(lds + MISC_OFF) + 8; xcd_barrier(bar_); } while (0)

#define KA() kargs()
#define WSP(off) (KA()->ws + (off))
    LAS float* scr = (LAS float*)(lds + wave * 16384);

    { FRESH_TID(tid); const float* c_p = KA()->in[2]; const float* c_s = KA()->in[3]; float* cact = (float*)WSP(WS_CACT);
    for (int idx = blockIdx.x * (NWAVES * 64) + tid; idx < D * 20; idx += G * NWAVES * 64) {
        const int k = idx / 20, b = idx - 20 * k; float v = 0.f;
        if (b < NBP) v = c_p[b * D + k]; else if (b < NB) v = c_s[(b - NBP) * D + k];
        cact[idx] = v / (1.0f + __expf(-v));
    } }
    GRID_BAR();

    {
        FRESH_TID(tid_); const int lane = tid_ & 63;
        const float* w_ada = KA()->in[4]; float* modp = (float*)WSP(WS_MODP); const float* cact = (const float*)WSP(WS_CACT);
        bf16* FC = (bf16*)WSP(WS_FC); bf16* GM = (bf16*)WSP(WS_G);
        constexpr int N_MOD = DEPTH * 48 * 8, N_G = 64, N_FC = 32, N_ALL = N_MOD + N_G + N_FC;
        for (int it = wave * G + (int)blockIdx.x; it < N_ALL; it += NGW) {
            if (it < N_MOD) {
#ifndef SKIP_MOD
                const int kseg = it & 7, cb = (it >> 3) % 48, layer = it / 384, col = cb * 256 + lane * 4;
                f32x4 acc[NB];
#pragma unroll
                for (int b = 0; b < NB; ++b) acc[b] = (f32x4){0.f, 0.f, 0.f, 0.f};
                const float* wp = w_ada + ((size_t)layer * D + kseg * 256) * (NMOD * D) + col;
                const float* cbase = cact + (kseg * 256) * 20;
#pragma unroll 1
                for (int k0 = 0; k0 < 256; k0 += 8) {
                    f32x4 wv8[8];
#pragma unroll
                    for (int q = 0; q < 8; ++q) wv8[q] = *(const GAS f32x4*)(wp + (size_t)(k0 + q) * (NMOD * D));
#pragma unroll
                    for (int q = 0; q < 8; ++q) { asm volatile("" ::: "memory");
                        const f32x4 wv = wv8[q]; const GAS f32x4* cp = (const GAS f32x4*)(cbase + (k0 + q) * 20);
                        const f32x4 c0 = cp[0], c1 = cp[1], c2 = cp[2], c3 = cp[3]; const f32x2 c4 = *(const GAS f32x2*)(cp + 4);
                        acc[0] += wv * c0.x; acc[1] += wv * c0.y; acc[2] += wv * c0.z; acc[3] += wv * c0.w;
                        acc[4] += wv * c1.x; acc[5] += wv * c1.y; acc[6] += wv * c1.z; acc[7] += wv * c1.w;
                        acc[8] += wv * c2.x; acc[9] += wv * c2.y; acc[10] += wv * c2.z; acc[11] += wv * c2.w;
                        acc[12] += wv * c3.x; acc[13] += wv * c3.y; acc[14] += wv * c3.z; acc[15] += wv * c3.w;
                        acc[16] += wv * c4.x; acc[17] += wv * c4.y; }
                }
#pragma unroll
                for (int b = 0; b < NB; ++b) *(GAS f32x4*)(modp + (((size_t)kseg * DEPTH + layer) * NB + b) * (NMOD * D) + col) = acc[b];
#endif
            } else if (it < N_MOD + N_G) {
                const int r = it - N_MOD;
#pragma unroll 2
                for (int i = 0; i < 8; ++i) { const int e0 = r * 4096 + i * 512 + lane * 8, row = e0 >> 9, c0 = e0 & 511, part = row >> 8, k1 = row & 255, cpart = c0 >> 8; float f[8];
#pragma unroll
                    for (int e = 0; e < 8; ++e) { const int n1 = (c0 + e) & 255; const float ph = (float)((k1 * n1) & 255) * (1.0f / 256.0f), cs = __builtin_amdgcn_cosf(ph), sn = __builtin_amdgcn_sinf(ph);
                        f[e] = (part == cpart ? cs : (part == 0 ? sn : -sn)) * 0.0625f; }
                    v4u o; o.x = pk2(f[0], f[1]); o.y = pk2(f[2], f[3]); o.z = pk2(f[4], f[5]); o.w = pk2(f[6], f[7]);
                    *(GAS v4u*)(GM + e0) = o; }
            } else {
                const int r = it - N_MOD - N_G;
#pragma unroll 2
                for (int i = 0; i < 8; ++i) { const int e0 = r * 4096 + i * 512 + lane * 8, row = e0 >> 8, c0 = e0 & 255, part = row >> 8, j = row & 255; float f[8];
#pragma unroll
                    for (int e = 0; e < 8; ++e) { const float ph = (float)((j * (c0 + e)) & 255) * (1.0f / 256.0f);
                        f[e] = (part ? -__builtin_amdgcn_sinf(ph) : __builtin_amdgcn_cosf(ph)) * 0.0625f; }
                    v4u o; o.x = pk2(f[0], f[1]); o.y = pk2(f[2], f[3]); o.z = pk2(f[4], f[5]); o.w = pk2(f[6], f[7]);
                    *(GAS v4u*)(FC + e0) = o; }
            }
        }
    }
    GRID_BAR();
    { FRESH_TID(tid); const float* b_ada = KA()->in[5]; float* mod = (float*)WSP(WS_MOD); const float* modp = (const float*)WSP(WS_MODP);
      constexpr int NV = DEPTH * NB * (NMOD * D) / 4;
      for (int i = blockIdx.x * (NWAVES * 64) + tid; i < NV; i += G * NWAVES * 64) {
          const int layer = i / (NB * (NMOD * D) / 4), col4 = i % ((NMOD * D) / 4);
          f32x4 v = ((const GAS f32x4*)(b_ada + (size_t)layer * (NMOD * D)))[col4];
#pragma unroll
          for (int ks = 0; ks < 8; ++ks) v += ((const GAS f32x4*)modp)[(size_t)ks * NV + i];
          ((GAS f32x4*)mod)[i] = v; } }
    GRID_BAR();

#define CONVERT_RANGE(lane_, lo_, hi_, first_, stride_) do { const float* w_o_ = KA()->in[9]; const float* w1_ = KA()->in[12]; const float* w2_ = KA()->in[14]; bf16* WO_ = (bf16*)WSP(WS_WO); bf16* W1_ = (bf16*)WSP(WS_W1); bf16* W2_ = (bf16*)WSP(WS_W2); \
        LAS float* scr2_ = (LAS float*)(lds + CONV_SCR_OFF); const int I_B_ = is_attn ? (AW / 64) * (D / 32) : 0, I_1_ = (D / 64) * (FF / 32), I_2_ = (FF / 64) * (D / 32); \
        const int hi__ = (hi_) < I_B_ + I_1_ + I_2_ ? (hi_) : I_B_ + I_1_ + I_2_; \
        for (int it_ = (lo_) + (first_); it_ < hi__; it_ += (stride_)) { int r_ = it_; \
            if (r_ < I_B_) { transpose_item(w_o_ + (size_t)l2 * AW * D, AW, D, WO_, scr2_, r_, lane_); continue; } r_ -= I_B_; \
            if (r_ < I_1_) { transpose_item(w1_ + (size_t)l * D * FF, D, FF, W1_, scr2_, r_, lane_); continue; } r_ -= I_1_; \
            transpose_item(w2_ + (size_t)l * FF * D, FF, D, W2_, scr2_, r_, lane_); } } while (0)
#ifndef QKV_TAIL_ITEMS
#define QKV_TAIL_ITEMS 12288
#endif
#ifndef REP_CV
#define REP_CV 1
#endif
#define CONVERT_REST(lane_) do { for (int rcv_ = 0; rcv_ < REP_CV; ++rcv_) CONVERT_RANGE(lane_, (is_attn ? QKV_TAIL_ITEMS : 0), 0x7fffffff, gw, NGW); } while (0)
#ifndef PG8_SP2_SHORT
#define PG8_SP2_SHORT false
#endif
#ifndef PG8_ALIGN_WIDE
#define PG8_ALIGN_WIDE PG8_ALIGN
#endif
#ifndef PG8_ALIGN_SHORT
#define PG8_ALIGN_SHORT false
#endif
#ifndef PG8_WGM_WIDE
#define PG8_WGM_WIDE 4
#endif
#ifndef REP_W1
#define REP_W1 1
#endif
#ifndef REP_QKV
#define REP_QKV 1
#endif
#ifndef REP_N
#define REP_N 1
#endif
#ifndef REP_AT
#define REP_AT 1
#endif
#ifndef REP_FB
#define REP_FB 1
#endif
#ifndef REP_F1A
#define REP_F1A 1
#endif
    for (int l = 0; l < DEPTH; ++l) {
        const bool is_attn = (l & 1) == 0; const int l2 = l >> 1;
#define MODL() ((const float*)WSP(WS_MOD) + (size_t)l * NB * (NMOD * D))
        for (int rep_ = 0; rep_ < REP_N; ++rep_) {
            FRESH_TID(tid_); const int lane = tid_ & 63;
            const float* w_qkv = KA()->in[8]; const float* w_f = KA()->in[10]; bf16* WQKV = (bf16*)WSP(WS_WQKV); bf16* WF = (bf16*)WSP(WS_WF);
            const int I_A = is_attn ? (D / 64) * (QKVW / 32) : (D / 64) * (D / 32);
            for (int rcv_ = 0; rcv_ < REP_CV; ++rcv_) for (int it = gw; it < I_A; it += NGW) { if (is_attn) transpose_item(w_qkv + (size_t)l2 * D * QKVW, D, QKVW, WQKV, scr, it, lane); else transpose_item(w_f + (size_t)l2 * D * D, D, D, WF, scr, it, lane); }
            const float* x_p = KA()->in[0]; const float* x_s = KA()->in[1]; const bf16* XB = (const bf16*)WSP(WS_XB); const float* norm1_g = KA()->in[6]; const float* modl = MODL(); bf16* HM = (bf16*)WSP(WS_HM);
            for (int it = gw; it < M / 8; it += NGW) {
                const int row0 = (M / 8 - 1 - it) * 8, b = batch_of_tile(row0 >> 8);
                const float* mb = modl + (size_t)b * (NMOD * D);
                if (l == 0) norm_chunk(row0 < MP ? x_p + (size_t)row0 * D : x_s + (size_t)(row0 - MP) * D, HM + (size_t)row0 * D, norm1_g + l * D, mb, mb + D, lane);
                else norm_chunk_b(XB + (size_t)row0 * D, HM + (size_t)row0 * D, norm1_g + l * D, mb, mb + D, lane);
            }
        }
        GRID_BAR();
        if (is_attn) {
            for (int rep_ = 0; rep_ < REP_QKV; ++rep_) { pg8::GemmDesc g = pg8::wtm_gemm(WSP(WS_HM), WSP(WS_WQKV), D, D, M / 256); pg8::StaticOrder S; S.init(M / 256, QKVW / 256, G, (int)blockIdx.x, PG8_WGM_WIDE);
              pg8::EpiQKV E{(bf16*)WSP(WS_R), 0.08838834764831845f * LOG2E};
              pg8::gemm_phase<pg8::EpiQKV, pg8::StaticOrder, PG8_ALIGN_WIDE, PG8_SP2>(lds, g, S, E); }
            {
                const int nfull = (M / 256) * (QKVW / 256) - ((M / 256) * (QKVW / 256) / G) * G;
                if ((int)blockIdx.x >= nfull && QKV_TAIL_ITEMS > 0) { FRESH_TID(tid_);
#define CONV_SCR_OFF (wave * 16384)
                    for (int rcv_ = 0; rcv_ < REP_CV; ++rcv_) CONVERT_RANGE(tid_ & 63, 0, QKV_TAIL_ITEMS, ((int)blockIdx.x - nfull) * NWAVES + wave, (G - nfull) * NWAVES);
#undef CONV_SCR_OFF
                } }
            GRID_BAR();
#ifndef SKIP_ATTN
            { FRESH_TID(tid_); const bf16* RB = (const bf16*)WSP(WS_R); bf16* HM = (bf16*)WSP(WS_HM); float* lse = (float*)WSP(WS_LSE);
              const int vcu = (G % 8 == 0) ? ((int)blockIdx.x % 8) * (G / 8) + (int)blockIdx.x / 8 : (int)blockIdx.x;
              for (int rep_ = 0; rep_ < REP_AT; ++rep_) attn_phase_coop(lds, RB, HM, lse, vcu, G, wave, tid_ & 63);
#define CONV_SCR_OFF (wave * 16384)
              CONVERT_REST(tid_ & 63);
#undef CONV_SCR_OFF
            }
#endif
            GRID_BAR();
            { FRESH_TID(tid_); const int lane = tid_ & 63; bf16* HM = (bf16*)WSP(WS_HM); const float* lse = (const float*)WSP(WS_LSE);
            for (int m = gw * 2; m < M; m += NGW * 2) {
                v4u vv[9]; float al[9];
#pragma unroll
                for (int i = 0; i < 9; ++i) { const int cc = lane + 64 * i, rr = cc >= AW / 8 ? 1 : 0, c = cc - rr * (AW / 8), head = c >> 4, hh = head % 6; const float* lr = lse + (size_t)(m + rr) * NH;
                    const float l0 = lr[hh], l1 = lr[6 + hh], l2v = lr[12 + hh], mxl = fmaxf(l0, fmaxf(l1, l2v));
                    const float e0 = __expf(l0 - mxl), e1 = __expf(l1 - mxl), e2 = __expf(l2v - mxl); al[i] = (head < 6 ? e0 : (head < 12 ? e1 : e2)) * __builtin_amdgcn_rcpf(e0 + e1 + e2);
                    vv[i] = *((const GAS v4u*)(HM + (size_t)m * AW) + cc); }
#pragma unroll
                for (int i = 0; i < 9; ++i) { const int cc = lane + 64 * i; const v4u v = vv[i]; const float a = al[i]; v4u o;
                    o.x = pk2(bf_lo(v.x) * a, bf_hi(v.x) * a); o.y = pk2(bf_lo(v.y) * a, bf_hi(v.y) * a); o.z = pk2(bf_lo(v.z) * a, bf_hi(v.z) * a); o.w = pk2(bf_lo(v.w) * a, bf_hi(v.w) * a);
                    *((GAS v4u*)(HM + (size_t)m * AW) + cc) = o; }
            } }
            GRID_BAR();
            if (l == 0) { pg8::GemmDesc g = pg8::wtm_gemm(WSP(WS_HM), WSP(WS_WO), AW, AW, M / 256); pg8::StaticOrder S; S.init(M / 256, D / 256, G, (int)blockIdx.x, PG8_WGM, 1);
              pg8::EpiRes<true> E{KA()->in[0], KA()->in[1], (bf16*)WSP(WS_XB), nullptr, MODL() + 2 * D};
              pg8::gemm_phase<pg8::EpiRes<true>, pg8::StaticOrder, PG8_ALIGN, PG8_SP2>(lds, g, S, E); }
            else { pg8::GemmDesc g = pg8::wtm_gemm(WSP(WS_HM), WSP(WS_WO), AW, AW, M / 256); pg8::StaticOrder S; S.init(M / 256, D / 256, G, (int)blockIdx.x, PG8_WGM, 1);
              pg8::EpiRes<false> E{nullptr, nullptr, (bf16*)WSP(WS_XB), nullptr, MODL() + 2 * D};
              pg8::gemm_phase<pg8::EpiRes<false>, pg8::StaticOrder, PG8_ALIGN, PG8_SP2>(lds, g, S, E); }
        } else {
            for (int rep_ = 0; rep_ < REP_F1A; ++rep_) { pg8::GemmDesc g{(const char*)WSP(WS_FC), (const char*)WSP(WS_HM), 256, (SEQP / 256) * D, 256, 2, 8, 1, 0, 0, (long long)SEQP * D * 2, 512, (long long)D * 2, 0, 128, 128}; pg8::StaticOrder S; S.init(NBP * 8 * 2, SEQP / 256, G, (int)blockIdx.x);
              pg8::EpiZT E{(bf16*)WSP(WS_R), 0, SEQP, SEQP / 256};
              pg8::gemm_phase<pg8::EpiZT, pg8::StaticOrder, PG8_ALIGN_SHORT, PG8_SP2_SHORT>(lds, g, S, E); }
            for (int rep_ = 0; rep_ < REP_F1A; ++rep_) { pg8::GemmDesc g{(const char*)WSP(WS_FC), (const char*)((bf16*)WSP(WS_HM) + (size_t)MP * D), 256, (SEQS / 256) * D, 256, 2, 8, 1, 0, 0, (long long)SEQS * D * 2, 512, (long long)D * 2, 0, 128, 128}; pg8::StaticOrder S; S.init(NBS * 8 * 2, SEQS / 256, G, (int)blockIdx.x);
              pg8::EpiZT E{(bf16*)WSP(WS_R), MP, SEQS, SEQS / 256};
              pg8::gemm_phase<pg8::EpiZT, pg8::StaticOrder, PG8_ALIGN_SHORT, PG8_SP2_SHORT>(lds, g, S, E); }
            GRID_BAR();
            for (int rep_ = 0; rep_ < REP_F1A; ++rep_) { constexpr int N2 = SEQP / 256; pg8::GemmDesc g{(const char*)WSP(WS_G), (const char*)WSP(WS_R), 512, N2 * 512, 512, 2, 1, 8, 0, 0, (long long)4096 * SEQP * 2, 0, 1024, (long long)256 * N2 * 1024, 128, 128};
              pg8::StaticOrder S; S.init(NBP * 2, N2 * 8, G, (int)blockIdx.x);
              pg8::EpiAO E{(bf16*)WSP(WS_AO), 0, SEQP, N2};
              pg8::gemm_phase<pg8::EpiAO, pg8::StaticOrder, PG8_ALIGN_SHORT, PG8_SP2_SHORT>(lds, g, S, E); }
            for (int rep_ = 0; rep_ < REP_F1A; ++rep_) { constexpr int N2 = SEQS / 256; pg8::GemmDesc g{(const char*)WSP(WS_G), (const char*)((bf16*)WSP(WS_R) + (size_t)4096 * MP), 512, N2 * 512, 512, 2, 1, 8, 0, 0, (long long)4096 * SEQS * 2, 0, 1024, (long long)256 * N2 * 1024, 128, 128};
              pg8::StaticOrder S; S.init(NBS * 2, N2 * 8, G, (int)blockIdx.x);
              pg8::EpiAO E{(bf16*)WSP(WS_AO), MP, SEQS, N2};
              pg8::gemm_phase<pg8::EpiAO, pg8::StaticOrder, PG8_ALIGN_SHORT, PG8_SP2_SHORT>(lds, g, S, E); }
            GRID_BAR();
            for (int rep_ = 0; rep_ < REP_FB; ++rep_) { FRESH_TID(tid_); const int lane = tid_ & 63; const bf16* AO = (const bf16*)WSP(WS_AO); bf16* HM = (bf16*)WSP(WS_HM); LAS float* tw = (LAS float*)(lds + wave * 8192);
              for (int it = gw; it < NBP * 256 * 4; it += NGW) { const int b = it >> 10, k1 = (it >> 2) & 255, cg = it & 3;
                  fbc_item<SEQP / 256>(AO + (size_t)4096 * (b * SEQP), HM + (size_t)(b * SEQP) * D, k1, cg, tw, lane); }
              for (int it = gw; it < NBS * 256 * 4; it += NGW) { const int b = it >> 10, k1 = (it >> 2) & 255, cg = it & 3;
                  fbc_item<SEQS / 256>(AO + (size_t)4096 * (MP + b * SEQS), HM + (size_t)(MP + b * SEQS) * D, k1, cg, tw, lane); }
#define CONV_SCR_OFF (SCR2_OFF + wave * SCR2_STRIDE)
              if (rep_ == 0) CONVERT_REST(lane);
#undef CONV_SCR_OFF
            }
            GRID_BAR();
            { pg8::GemmDesc g = pg8::wtm_gemm(WSP(WS_HM), WSP(WS_WF), D, D, M / 256); pg8::StaticOrder S; S.init(M / 256, D / 256, G, (int)blockIdx.x, PG8_WGM, 1);
              pg8::EpiRes<false> E{nullptr, nullptr, (bf16*)WSP(WS_XB), KA()->in[11] + (size_t)l2 * D, MODL() + 2 * D};
              pg8::gemm_phase<pg8::EpiRes<false>, pg8::StaticOrder, PG8_ALIGN, PG8_SP2>(lds, g, S, E); }
        }
        GRID_BAR();
        for (int rep_ = 0; rep_ < REP_N; ++rep_) { FRESH_TID(tid_); const int lane = tid_ & 63; const bf16* XB = (const bf16*)WSP(WS_XB); const float* norm2_g = KA()->in[7]; const float* modl = MODL(); bf16* HM = (bf16*)WSP(WS_HM);
        for (int it = gw; it < M / 8; it += NGW) {
            const int row0 = it * 8, b = batch_of_tile(row0 >> 8);
            const float* mb = modl + (size_t)b * (NMOD * D) + 3 * D;
            norm_chunk_b(XB + (size_t)row0 * D, HM + (size_t)row0 * D, norm2_g + l * D, mb, mb + D, lane);
        } }
        GRID_BAR();
        for (int rep_ = 0; rep_ < REP_W1; ++rep_) { pg8::GemmDesc g = pg8::wtm_gemm(WSP(WS_HM), WSP(WS_W1), D, D, M / 256); pg8::StaticOrder S; S.init(M / 256, FF / 256, G, (int)blockIdx.x, PG8_WGM_WIDE, 1);
          pg8::EpiBf16<1, true> E{(bf16*)WSP(WS_R), FF, KA()->in[13] + (size_t)l * FF, 0};
          pg8::gemm_phase<pg8::EpiBf16<1, true>, pg8::StaticOrder, PG8_ALIGN_WIDE, PG8_SP2>(lds, g, S, E); }
        GRID_BAR();
#ifdef PROBE_W1NULL
        { pg8::GemmDesc g = pg8::wtm_gemm(WSP(WS_HM), WSP(WS_W1), D, D, M / 256);
#if PROBE_W1NULL == 2
          g.nMb = 1; g.pB1 = 0;
#endif
 pg8::StaticOrder S; S.init(M / 256, FF / 256, G, (int)blockIdx.x, PG8_WGM_WIDE);
          pg8::EpiNull E{};
          pg8::gemm_phase<pg8::EpiNull, pg8::StaticOrder, PG8_ALIGN, PG8_SP2>(lds, g, S, E); }
#endif
#ifdef PROBE_W2
        { pg8::GemmDesc g = pg8::GemmDesc{(const char*)WSP(WS_R), (const char*)WSP(WS_W2), 64, 64, FF, 1, 1, 1, (long long)FF * 512, 0, 0, 0, 512ll * FF, 0, 32768, 32768};     pg8::StaticOrder S; S.init(M / 256, D / 256, G, (int)blockIdx.x);
          pg8::EpiBf16<0> E{(bf16*)WSP(WS_END), D, nullptr, 0};
          pg8::gemm_phase<pg8::EpiBf16<0>, pg8::StaticOrder, PG8_ALIGN, PG8_SP2>(lds, g, S, E); }
#endif
        { pg8::GemmDesc g = pg8::GemmDesc{(const char*)WSP(WS_R), (const char*)WSP(WS_W2), 64, 64, FF, 1, 1, 1, (long long)FF * 512, 0, 0, 0, 512ll * FF, 0, 32768, 32768};     pg8::StaticOrder S; S.init(M / 256, D / 256, G, (int)blockIdx.x);
          pg8::EpiRes<false> E{nullptr, nullptr, (bf16*)WSP(WS_XB), KA()->in[15] + (size_t)l * D, MODL() + 5 * D};
          pg8::gemm_phase<pg8::EpiRes<false>, pg8::StaticOrder, PG8_ALIGN, PG8_SP2>(lds, g, S, E); }
        GRID_BAR();
    }
#ifdef PROBE_STAMP
    {
        FRESH_TID(tid); float* yout = KA()->out; const unsigned long long* st = STAMPS();
        float va = 0.f, vb = 0.f;
        for (int k = 0; k < stamp_idx; ++k) { const float work = (k == 0) ? 0.f : (float)(st[2 * k] - st[2 * k - 1]) * 0.01f, wait = (float)(st[2 * k + 1] - st[2 * k]) * 0.01f;
            if (PROBE_SEL_A(k, 0)) va += work; if (PROBE_SEL_A(k, 1)) va += wait; if (PROBE_SEL_B(k, 0)) vb += work; if (PROBE_SEL_B(k, 1)) vb += wait; }
        va = __builtin_exp2f(rintf(__builtin_log2f(fmaxf(va, 1.f)) * 2.0600f) / 2.0600f); vb = __builtin_exp2f(rintf(__builtin_log2f(fmaxf(vb, 1.f)) * 2.0600f) / 2.0600f);
        const float cval = sqrtf(vb);
        for (size_t i = (size_t)blockIdx.x * (NWAVES * 64) + tid; i < (size_t)M * D; i += (size_t)G * NWAVES * 64) yout[i] = (i < (size_t)MP * D / 4) ? cval : (i == (size_t)MP * D ? va : 0.f);
        return;
    }
#endif
    FRESH_TID(tid_); const int lane = tid_ & 63; float* yout = KA()->out; const bf16* XB = (const bf16*)WSP(WS_XB); const float* final_g = KA()->in[16];
    for (int mf = gw; mf < M; mf += NGW) { const int m = M - 1 - mf;
        const GAS v4u* xr = (const GAS v4u*)(XB + (size_t)m * D) + lane;
        f32x4 v[4][2]; float ss = 0.f;
#pragma unroll
        for (int j = 0; j < 4; ++j) { const v4u w = xr[64 * j];
            v[j][0] = (f32x4){bf_lo(w.x), bf_hi(w.x), bf_lo(w.y), bf_hi(w.y)}; v[j][1] = (f32x4){bf_lo(w.z), bf_hi(w.z), bf_lo(w.w), bf_hi(w.w)};
#pragma unroll
            for (int e = 0; e < 2; ++e) ss += (v[j][e].x * v[j][e].x + v[j][e].y * v[j][e].y) + (v[j][e].z * v[j][e].z + v[j][e].w * v[j][e].w); }
        const float rstd = 1.0f / sqrtf(wave_sum(ss) * (1.0f / D) + RMS_EPS);
#pragma unroll
        for (int j = 0; j < 4; ++j)
#pragma unroll
            for (int e = 0; e < 2; ++e) { const int col = 8 * lane + 512 * j + 4 * e; *(GAS f32x4*)(yout + (size_t)m * D + col) = (v[j][e] * rstd) * *(const f32x4*)(final_g + col); }
    }
}

extern "C" void kernel_launch(void* const* d_in, const int* in_sizes, int n_in, void* d_out, int out_size, void* d_ws, size_t ws_size, hipStream_t stream) {
    static int grid = 0;
    if (grid == 0) {
        if (n_in != 17 || out_size != M * D || ws_size < WS_END) { fprintf(stderr, "kernel_launch: unexpected shapes (n_in %d, out %d, ws %zu < %zu); nothing launched\n", n_in, out_size, ws_size, (size_t)WS_END); grid = -1; return; }
        int dev = 0, cus = 0, per_cu = 0;
        if (hipGetDevice(&dev) != hipSuccess || hipDeviceGetAttribute(&cus, hipDeviceAttributeMultiprocessorCount, dev) != hipSuccess) { grid = -1; return; }
        if (hipFuncSetAttribute((const void*)fwd, hipFuncAttributeMaxDynamicSharedMemorySize, LDS_BYTES) != hipSuccess) { fprintf(stderr, "kernel_launch: hipFuncSetAttribute failed\n"); grid = -1; return; }
        if (hipOccupancyMaxActiveBlocksPerMultiprocessor(&per_cu, (const void*)fwd, NWAVES * 64, LDS_BYTES) != hipSuccess || per_cu < 1)
            fprintf(stderr, "kernel_launch: note: occupancy query reports %d workgroups per CU\n", per_cu);
        (void)hipGetLastError();
        grid = cus;
    }
    if (grid < 0) return;
    if (hipMemsetAsync((char*)d_ws + WS_CTL, 0, CTL_ZERO_BYTES, stream) != hipSuccess) { fprintf(stderr, "kernel_launch: hipMemsetAsync failed\n"); return; }
    Args a{};
    for (int i = 0; i < 17; ++i) a.in[i] = (const float*)d_in[i];
    a.out = (float*)d_out; a.ws = (unsigned char*)d_ws;
    hipLaunchKernelGGL(fwd, dim3(grid), dim3(NWAVES * 64), LDS_BYTES, stream, a);
    const hipError_t le = hipPeekAtLastError();
    if (le != hipSuccess) fprintf(stderr, "kernel_launch: launch failed: %s\n", hipGetErrorName(le));
}
```
